# Optimizing an MI355X kernel written in HIP

```python
import math
import jax, jax.numpy as jnp
from jax import lax
import numpy as np

D_MODEL = 1024
BATCH = 8
SEQ = 8192
DEPTH = 2

MIX_WIDTH = D_MODEL // 2
RET_HEAD_DIM = 128
RET_HEADS = MIX_WIDTH // RET_HEAD_DIM
RET_CHUNK = 128
ROPE_BASE = 10000.0
RWKV_HEAD_DIM = 64
RWKV_HEADS = MIX_WIDTH // RWKV_HEAD_DIM
DECAY_LORA = 64
AAA_LORA = 64
GATE_LORA = 128
CONV_WIDTH = 3
N_BRANCHES = 3
RET_COLS = 4 * MIX_WIDTH
RWKV_COLS = 3 * MIX_WIDTH + DECAY_LORA + AAA_LORA + GATE_LORA
CONV_COLS = 3 * MIX_WIDTH
IN_COLS = RET_COLS + RWKV_COLS + CONV_COLS
N_GROUPS = 4
EXPERTS_PER_GROUP = 8
N_EXPERTS = N_GROUPS * EXPERTS_PER_GROUP
EXPERT_FF = D_MODEL // 2
TOP_K = 2
MOE_BLOCK = 128
NORM_EPS = 1e-6
HEAD_NORM_EPS = 1e-5
RWKV_NORM_EPS = 64e-5

kernel_name = 'hybrid_retention_rwkv7_shortconv_hmoe_block'

F32 = jnp.float32


def rms_norm(x, g):
    xf = x.astype(F32)
    y = xf * lax.rsqrt(jnp.mean(xf * xf, axis=-1, keepdims=True) + NORM_EPS)
    return (y * g.astype(F32)).astype(x.dtype)


def modulate(h, shift, scale):
    return (h.astype(F32) * (1.0 + scale[:, None, :]) + shift[:, None, :]).astype(h.dtype)


def head_norm(y, g, eps):
    yf = y.astype(F32)
    mu = jnp.mean(yf, axis=-1, keepdims=True)
    var = jnp.mean(jnp.square(yf - mu), axis=-1, keepdims=True)
    return (yf - mu) * lax.rsqrt(var + eps) * g.astype(F32).reshape(y.shape[-2:])


def rotary(t, positions):
    half = t.shape[-1] // 2
    inv_freq = ROPE_BASE ** (-jnp.arange(half, dtype=F32) / half)
    ang = positions.astype(F32)[..., None] * inv_freq
    cos = jnp.cos(ang)[:, :, None, :]
    sin = jnp.sin(ang)[:, :, None, :]
    t1 = t[..., :half].astype(F32)
    t2 = t[..., half:].astype(F32)
    return jnp.concatenate([t1 * cos - t2 * sin, t1 * sin + t2 * cos], axis=-1)


def retention(q, k, v, g, positions, gn_g):
    bsz, seq, _ = q.shape
    split = lambda t: t.reshape(bsz, seq, RET_HEADS, RET_HEAD_DIM)
    qh = rotary(split(q), positions)
    kh = rotary(split(k), positions) * (RET_HEAD_DIM ** -0.5)
    vh = split(v).astype(F32)
    n_chunks = seq // RET_CHUNK

    def to_chunks(t):
        return t.reshape(bsz, n_chunks, RET_CHUNK, RET_HEADS, RET_HEAD_DIM).transpose(1, 0, 3, 2, 4)

    log_gamma = jnp.log1p(-jnp.exp2(-5.0 - jnp.arange(RET_HEADS, dtype=F32)))
    pos = jnp.arange(RET_CHUNK, dtype=F32)
    rel = pos[:, None] - pos[None, :]
    decay_in = jnp.where(rel >= 0, jnp.exp(log_gamma[:, None, None] * jnp.maximum(rel, 0.0)), 0.0)
    decay_k = jnp.exp(log_gamma[:, None] * (RET_CHUNK - 1 - pos))
    decay_q = jnp.exp(log_gamma[:, None] * (pos + 1.0))
    decay_chunk = jnp.exp(log_gamma * RET_CHUNK)

    def chunk_step(state, qkv):
        qc, kc, vc = qkv
        scores = jnp.einsum('bhid,bhjd->bhij', qc, kc) * decay_in
        inner = jnp.einsum('bhij,bhjv->bhiv', scores, vc)
        cross = jnp.einsum('bhid,bhdv->bhiv', qc, state) * decay_q[None, :, :, None]
        state = state * decay_chunk[None, :, None, None] + jnp.einsum(
            'bhjd,bhjv->bhdv', kc * decay_k[None, :, :, None], vc)
        return state, inner + cross

    state0 = jnp.zeros((bsz, RET_HEADS, RET_HEAD_DIM, RET_HEAD_DIM), F32)
    _, out = lax.scan(chunk_step, state0, (to_chunks(qh), to_chunks(kh), to_chunks(vh)))
    out = out.transpose(1, 0, 3, 2, 4).reshape(bsz, seq, RET_HEADS, RET_HEAD_DIM)
    out = head_norm(out, gn_g, HEAD_NORM_EPS).reshape(bsz, seq, MIX_WIDTH)
    return (jax.nn.silu(g.astype(F32)) * out).astype(q.dtype)


def rwkv7_time_mix(p, mu, w0, w_lora, a0, a_lora, g_lora, k_k, k_a, r_k, gn_g):
    bsz, seq, _ = p.shape
    mw = MIX_WIDTH
    pf = p.astype(F32)
    prev = jnp.pad(pf, ((0, 0), (1, 0), (0, 0)))[:, :-1]
    pf = pf + mu * (prev - pf)
    o_w = 3 * mw
    o_a = o_w + DECAY_LORA
    o_g = o_a + AAA_LORA
    r = pf[..., 0:mw]
    k = pf[..., mw:2 * mw]
    v = pf[..., 2 * mw:3 * mw]
    wd = pf[..., o_w:o_a]
    ad = pf[..., o_a:o_g]
    gd = pf[..., o_g:o_g + GATE_LORA]
    w = jnp.exp(-math.exp(-0.5) * jax.nn.sigmoid(w0 + jnp.tanh(wd) @ w_lora))
    a = jax.nn.sigmoid(a0 + ad @ a_lora)
    g = jax.nn.sigmoid(gd) @ g_lora
    heads = lambda t: t.reshape(bsz, seq, RWKV_HEADS, RWKV_HEAD_DIM)
    r, w, k, v, a = heads(r), heads(w), heads(k), heads(v), heads(a)
    kk = k * k_k.reshape(RWKV_HEADS, RWKV_HEAD_DIM)
    kh = kk * lax.rsqrt(jnp.maximum(jnp.sum(kk * kk, axis=-1, keepdims=True), 1e-12))
    kt = k * (1.0 + (a - 1.0) * k_a.reshape(RWKV_HEADS, RWKV_HEAD_DIM))

    def time_step(state, inp):
        rt, wt, ktt, vt, kht, at = inp
        sk = jnp.einsum('bhvk,bhk->bhv', state, kht)
        state = (state * wt[:, :, None, :]
                 - sk[..., None] * (at * kht)[:, :, None, :]
                 + vt[..., None] * ktt[:, :, None, :])
        return state, jnp.einsum('bhvk,bhk->bhv', state, rt)

    tm = lambda t: jnp.moveaxis(t, 1, 0)
    state0 = jnp.zeros((bsz, RWKV_HEADS, RWKV_HEAD_DIM, RWKV_HEAD_DIM), F32)
    _, y = lax.scan(time_step, state0, (tm(r), tm(w), tm(kt), tm(v), tm(kh), tm(a)))
    y = jnp.moveaxis(y, 0, 1)
    y = head_norm(y, gn_g, RWKV_NORM_EPS)
    y = y + jnp.sum(r * kt * r_k.astype(F32), axis=-1, keepdims=True) * v
    return (y.reshape(bsz, seq, mw) * g).astype(p.dtype)


def short_conv(p, conv_w):
    h, bgate, cgate = jnp.split(p, 3, axis=-1)
    u = cgate * h
    seq = u.shape[1]
    up = jnp.pad(u, ((0, 0), (CONV_WIDTH - 1, 0), (0, 0)))
    conv = conv_w[0] * up[:, 0:seq]
    for i in range(1, CONV_WIDTH):
        conv = conv + conv_w[i] * up[:, i:i + seq]
    return bgate * conv


def hier_moe(h, w_router_group, b_router_group, w_router_expert, b_router_expert,
             w_exp_gate, w_exp_up, w_exp_down):
    bsz, seq, d = h.shape
    n_tok = bsz * seq
    xf = h.reshape(n_tok, d)
    g_logits = (xf @ w_router_group + b_router_group).astype(F32)
    g_prob = jax.nn.softmax(g_logits, axis=-1)
    g_sel = jnp.argmax(g_logits, axis=-1).astype(jnp.int32)
    p_group = jnp.take_along_axis(g_prob, g_sel[:, None], axis=-1)
    e_logits = (xf @ w_router_expert + b_router_expert).astype(F32).reshape(n_tok, N_GROUPS, EXPERTS_PER_GROUP)
    e_logits = jnp.take_along_axis(e_logits, g_sel[:, None, None], axis=1)[:, 0]
    top_v, top_i = lax.top_k(e_logits, TOP_K)
    weights = (jax.nn.softmax(top_v, axis=-1) * p_group).reshape(-1)
    eid = (g_sel[:, None] * EXPERTS_PER_GROUP + top_i).reshape(-1).astype(jnp.int32)
    tok = jnp.repeat(jnp.arange(n_tok, dtype=jnp.int32), TOP_K)
    n_assign = n_tok * TOP_K
    order = jnp.argsort(eid)
    eid_s, tok_s, w_s = eid[order], tok[order], weights[order]
    counts = jnp.bincount(eid, length=N_EXPERTS).astype(jnp.int32)
    starts = jnp.cumsum(counts) - counts
    padded = (counts + MOE_BLOCK - 1) // MOE_BLOCK * MOE_BLOCK
    pends = jnp.cumsum(padded)
    pstarts = pends - padded
    dest = pstarts[eid_s] + jnp.arange(n_assign, dtype=jnp.int32) - starts[eid_s]
    n_rows = n_assign + N_EXPERTS * MOE_BLOCK
    n_blocks = n_rows // MOE_BLOCK
    row_tok = jnp.full((n_rows,), n_tok, jnp.int32).at[dest].set(tok_s)
    row_w = jnp.zeros((n_rows,), F32).at[dest].set(w_s)
    block_e = jnp.minimum(
        jnp.searchsorted(pends, jnp.arange(n_blocks, dtype=jnp.int32) * MOE_BLOCK, side='right'),
        N_EXPERTS - 1)
    x_rows = jnp.concatenate([xf, jnp.zeros((1, d), xf.dtype)], axis=0)[row_tok]
    x_rows = x_rows.reshape(n_blocks, MOE_BLOCK, d)

    def expert_block(args):
        xb, e = args
        return (jax.nn.silu(xb @ w_exp_gate[e]) * (xb @ w_exp_up[e])) @ w_exp_down[e]

    y_rows = lax.map(expert_block, (x_rows, block_e)).reshape(n_rows, d)
    y_rows = y_rows.astype(F32) * row_w[:, None]
    out = jax.ops.segment_sum(y_rows, row_tok, num_segments=n_tok + 1)[:n_tok]
    return out.reshape(bsz, seq, d).astype(h.dtype)


def decoder_layer(x, c, positions, norm1_g, norm2_g, w_ada, b_ada, w_in, w_gate, b_gate,
                  ret_gn_g, rwkv_mu, rwkv_w0, rwkv_w_lora, rwkv_a0, rwkv_a_lora, rwkv_g_lora,
                  rwkv_k_k, rwkv_k_a, rwkv_r_k, rwkv_gn_g, conv_w, w_branch, w_o,
                  w_router_group, b_router_group, w_router_expert, b_router_expert,
                  w_exp_gate, w_exp_up, w_exp_down):
    d = D_MODEL
    mod = jax.nn.silu(c.astype(F32)) @ w_ada + b_ada
    shift1, scale1, gate1, shift2, scale2, gate2 = jnp.split(mod, 6, axis=-1)

    h = modulate(rms_norm(x, norm1_g), shift1, scale1)
    p = h @ w_in
    p_ret = p[..., :RET_COLS]
    p_rwkv = p[..., RET_COLS:RET_COLS + RWKV_COLS]
    p_conv = p[..., RET_COLS + RWKV_COLS:]
    q, k, v, g = jnp.split(p_ret, 4, axis=-1)
    y_ret = retention(q, k, v, g, positions, ret_gn_g)
    y_rwkv = rwkv7_time_mix(p_rwkv, rwkv_mu, rwkv_w0, rwkv_w_lora, rwkv_a0, rwkv_a_lora,
                            rwkv_g_lora, rwkv_k_k, rwkv_k_a, rwkv_r_k, rwkv_gn_g)
    y_conv = short_conv(p_conv, conv_w)
    gates = jax.nn.sigmoid((h @ w_gate + b_gate).astype(F32))
    merged = jnp.zeros(x.shape, F32)
    for i, y in enumerate((y_ret, y_rwkv, y_conv)):
        merged = merged + gates[..., i * d:(i + 1) * d] * (y @ w_branch[i])
    x = x + (gate1[:, None, :] * (merged.astype(x.dtype) @ w_o)).astype(x.dtype)

    h2 = modulate(rms_norm(x, norm2_g), shift2, scale2)
    y_moe = hier_moe(h2, w_router_group, b_router_group, w_router_expert, b_router_expert,
                     w_exp_gate, w_exp_up, w_exp_down)
    x = x + (gate2[:, None, :] * y_moe).astype(x.dtype)
    return x


def setup_inputs(seed: int = 0) -> dict:
    key = jax.random.key(seed)
    k = jax.random.split(key, 32)
    L, D, MW = DEPTH, D_MODEL, MIX_WIDTH

    def nrm(kk, shape, scale):
        return scale * jax.random.normal(kk, shape, jnp.float32)

    return {
        'x': nrm(k[0], (BATCH, SEQ, D), 1.0),
        'c': nrm(k[1], (BATCH, D), 1.0),
        'positions': jnp.tile(jnp.arange(SEQ, dtype=jnp.int32)[None, :], (BATCH, 1)),
        'norm1_g': 1.0 + nrm(k[2], (L, D), 0.02),
        'norm2_g': 1.0 + nrm(k[3], (L, D), 0.02),
        'final_norm_g': 1.0 + nrm(k[4], (D,), 0.02),
        'w_ada': nrm(k[5], (L, D, 6 * D), 0.5 * D ** -0.5),
        'b_ada': nrm(k[6], (L, 6 * D), 0.01),
        'w_in': nrm(k[7], (L, D, IN_COLS), D ** -0.5),
        'w_gate': nrm(k[8], (L, D, N_BRANCHES * D), D ** -0.5),
        'b_gate': nrm(k[9], (L, N_BRANCHES * D), 0.01),
        'ret_gn_g': 1.0 + nrm(k[10], (L, MW), 0.02),
        'rwkv_mu': jax.random.uniform(k[11], (L, RWKV_COLS), jnp.float32),
        'rwkv_w0': nrm(k[12], (L, MW), 0.5),
        'rwkv_w_lora': nrm(k[13], (L, DECAY_LORA, MW), DECAY_LORA ** -0.5),
        'rwkv_a0': nrm(k[14], (L, MW), 0.5),
        'rwkv_a_lora': nrm(k[15], (L, AAA_LORA, MW), AAA_LORA ** -0.5),
        'rwkv_g_lora': nrm(k[16], (L, GATE_LORA, MW), GATE_LORA ** -0.5),
        'rwkv_k_k': 0.85 + nrm(k[17], (L, MW), 0.05),
        'rwkv_k_a': 1.0 + nrm(k[18], (L, MW), 0.05),
        'rwkv_r_k': nrm(k[19], (L, RWKV_HEADS, RWKV_HEAD_DIM), 0.1),
        'rwkv_gn_g': 1.0 + nrm(k[20], (L, MW), 0.02),
        'conv_w': nrm(k[21], (L, CONV_WIDTH, MW), CONV_WIDTH ** -0.5),
        'w_branch': nrm(k[22], (L, N_BRANCHES, MW, D), MW ** -0.5),
        'w_o': nrm(k[23], (L, D, D), D ** -0.5),
        'w_router_group': nrm(k[24], (L, D, N_GROUPS), D ** -0.5),
        'b_router_group': nrm(k[25], (L, N_GROUPS), 0.01),
        'w_router_expert': nrm(k[26], (L, D, N_EXPERTS), D ** -0.5),
        'b_router_expert': nrm(k[27], (L, N_EXPERTS), 0.01),
        'w_exp_gate': nrm(k[28], (L, N_EXPERTS, D, EXPERT_FF), D ** -0.5),
        'w_exp_up': nrm(k[29], (L, N_EXPERTS, D, EXPERT_FF), D ** -0.5),
        'w_exp_down': nrm(k[30], (L, N_EXPERTS, EXPERT_FF, D), EXPERT_FF ** -0.5),
    }


def reference(x, c, positions, norm1_g, norm2_g, final_norm_g, w_ada, b_ada, w_in, w_gate, b_gate,
              ret_gn_g, rwkv_mu, rwkv_w0, rwkv_w_lora, rwkv_a0, rwkv_a_lora, rwkv_g_lora,
              rwkv_k_k, rwkv_k_a, rwkv_r_k, rwkv_gn_g, conv_w, w_branch, w_o,
              w_router_group, b_router_group, w_router_expert, b_router_expert,
              w_exp_gate, w_exp_up, w_exp_down):
    for l in range(DEPTH):
        x = decoder_layer(
            x, c, positions, norm1_g[l], norm2_g[l], w_ada[l], b_ada[l], w_in[l], w_gate[l], b_gate[l],
            ret_gn_g[l], rwkv_mu[l], rwkv_w0[l], rwkv_w_lora[l], rwkv_a0[l], rwkv_a_lora[l],
            rwkv_g_lora[l], rwkv_k_k[l], rwkv_k_a[l], rwkv_r_k[l], rwkv_gn_g[l], conv_w[l],
            w_branch[l], w_o[l], w_router_group[l], b_router_group[l], w_router_expert[l],
            b_router_expert[l], w_exp_gate[l], w_exp_up[l], w_exp_down[l])
    return rms_norm(x, final_norm_g)
```

```cpp
#include <hip/hip_runtime.h>
#include <cstdio>
#include <cstdint>
namespace pg8 {
#define PG8_LAS __attribute__((address_space(3)))
typedef unsigned short bf16_t;
typedef short bf16x8 __attribute__((ext_vector_type(8)));
typedef float f32x4 __attribute__((ext_vector_type(4)));
typedef unsigned u32x4 __attribute__((ext_vector_type(4)));
constexpr int BM = 256, BK = 64, HALF = 128, HTB = HALF * BK * 2  , STAGE_BYTES = 8 * HTB, NXCD = 8, WGM = 8;

__host__ __device__ __forceinline__ int lds_byte(int r, int c) { const int st = (r >> 4) * 2 + (c >> 5), rr = r & 15, cc = c & 31, ob = rr * 64 + cc * 2; return st * 1024 + (ob ^ (((ob >> 9) & 1) << 5)); }
__host__ __device__ __forceinline__ void stage_rc(int b, int& R, int& C) { const int st = b / 1024, sb = b % 1024, swz = sb ^ (((sb >> 9) & 1) << 5); R = (st >> 1) * 16 + swz / 64; C = (st & 1) * 32 + (swz % 64) / 2; }
__host__ __device__ __forceinline__ int perm32(int rho) { const int n = rho >> 4, i = rho & 15; return 8 * (i >> 2) + 4 * n + (i & 3); }

struct Unit { int pm, pn; };
struct Gemm { const bf16_t* A; const bf16_t* Bt; int M, N, K; };

struct StaticOrder {
    int nM, nN, nwg, G, c;
    __host__ __device__ void init(int M, int N, int G_, int c_) { nM = M / BM; nN = N / BM; nwg = nM * nN; G = G_; c = c_; }
    __host__ __device__ bool next(int i, Unit& u) const {
        const long L = (long)i * G + c; if (L >= nwg) return false;
        int wgid = (int)L; { const int q = nwg / NXCD, r = nwg % NXCD, xcd = wgid % NXCD, off = wgid / NXCD; wgid = (xcd < r ? xcd * (q + 1) : r * (q + 1) + (xcd - r) * q) + off; }
        const int nig = WGM * nN, gid = wgid / nig, fm = gid * WGM, gsz = (nM - fm) < WGM ? (nM - fm) : WGM;
        u.pm = fm + ((wgid % nig) % gsz); u.pn = (wgid % nig) / gsz; return true;
    }
    __device__ __forceinline__ void a_ready(const Unit&) const {}
    __device__ __forceinline__ void done(const Unit&) const {}
};
typedef __bf16 bf16v2_t __attribute__((ext_vector_type(2)));
typedef float f32v2_t __attribute__((ext_vector_type(2)));
__device__ __forceinline__ unsigned cvt_pk_bf16(float lo, float hi) { const f32v2_t v = {lo, hi}; return __builtin_bit_cast(unsigned, __builtin_convertvector(v, bf16v2_t)); }
__device__ __forceinline__ float bflo(unsigned u) { return __uint_as_float(u << 16); }
__device__ __forceinline__ float bfhi(unsigned u) { return __uint_as_float(u & 0xffff0000u); }
__device__ __forceinline__ float sigmoidf_(float x) { return __builtin_amdgcn_rcpf(1.0f + __expf(-x)); }

struct EpiPlain {
    static constexpr bool PERM = true, AFTER_DRAIN = false;
    bf16_t* O; int ldc; int ntn;
    __device__ __forceinline__ void operator()(const f32x4 (&acc)[2][2][4][2], const Unit& u, int wr, int wc, int fr, int fq) const {
        const int row0 = u.pm * BM + wr * 64 + fr; const int col0 = (u.pn % ntn) * BM + wc * 32 + 8 * fq;
#pragma unroll
        for (int ai = 0; ai < 2; ++ai)
#pragma unroll
            for (int m = 0; m < 4; ++m) { bf16_t* rowp = O + (size_t)(row0 + ai * HALF + m * 16) * ldc + col0;
#pragma unroll
                for (int bj = 0; bj < 2; ++bj) { const f32x4 v0 = acc[ai][bj][m][0], v1 = acc[ai][bj][m][1];
                    u32x4 w; w.x = cvt_pk_bf16(v0[0], v0[1]); w.y = cvt_pk_bf16(v0[2], v0[3]); w.z = cvt_pk_bf16(v1[0], v1[1]); w.w = cvt_pk_bf16(v1[2], v1[3]);
                    *(u32x4*)(rowp + bj * HALF) = w; } }
    }
};
struct EpiB2 {
    static constexpr bool PERM = true, AFTER_DRAIN = false;
    bf16_t* P; int ldp; int npl; bf16_t* Gt; int ldg; const float* bias;
    __device__ __forceinline__ void operator()(const f32x4 (&acc)[2][2][4][2], const Unit& u, int wr, int wc, int fr, int fq) const {
        const int row0 = u.pm * BM + wr * 64 + fr;
        if (u.pn < npl) {
            const int col0 = u.pn * BM + wc * 32 + 8 * fq;
#pragma unroll
            for (int ai = 0; ai < 2; ++ai)
#pragma unroll
                for (int m = 0; m < 4; ++m) { bf16_t* rowp = P + (size_t)(row0 + ai * HALF + m * 16) * ldp + col0;
#pragma unroll
                    for (int bj = 0; bj < 2; ++bj) { const f32x4 v0 = acc[ai][bj][m][0], v1 = acc[ai][bj][m][1];
                        u32x4 w; w.x = cvt_pk_bf16(v0[0], v0[1]); w.y = cvt_pk_bf16(v0[2], v0[3]); w.z = cvt_pk_bf16(v1[0], v1[1]); w.w = cvt_pk_bf16(v1[2], v1[3]);
                        *(u32x4*)(rowp + bj * HALF) = w; } }
        } else {
            const int col0 = (u.pn - npl) * BM + wc * 32 + 8 * fq;
#pragma unroll
            for (int ai = 0; ai < 2; ++ai)
#pragma unroll
                for (int m = 0; m < 4; ++m) { bf16_t* rowp = Gt + (size_t)(row0 + ai * HALF + m * 16) * ldg + col0;
#pragma unroll
                    for (int bj = 0; bj < 2; ++bj) { f32x4 v0 = acc[ai][bj][m][0] + *(const f32x4*)(bias + col0 + bj * HALF), v1 = acc[ai][bj][m][1] + *(const f32x4*)(bias + col0 + bj * HALF + 4);
#pragma unroll
                        for (int j = 0; j < 4; ++j) { v0[j] = sigmoidf_(v0[j]); v1[j] = sigmoidf_(v1[j]); }
                        u32x4 w; w.x = cvt_pk_bf16(v0[0], v0[1]); w.y = cvt_pk_bf16(v0[2], v0[3]); w.z = cvt_pk_bf16(v1[0], v1[1]); w.w = cvt_pk_bf16(v1[2], v1[3]);
                        *(u32x4*)(rowp + bj * HALF) = w; } }
        }
    }
};
struct EpiMerge {
    static constexpr bool PERM = true, AFTER_DRAIN = false;
    bf16_t* Mg; const bf16_t* gate; int ldg; int first;
    __device__ __forceinline__ void operator()(const f32x4 (&acc)[2][2][4][2], const Unit& u, int wr, int wc, int fr, int fq) const {
        const int row0 = u.pm * BM + wr * 64 + fr; const int col0 = u.pn * BM + wc * 32 + 8 * fq;
#pragma unroll
        for (int ai = 0; ai < 2; ++ai)
#pragma unroll
            for (int m = 0; m < 4; ++m) { const size_t r = (size_t)(row0 + ai * HALF + m * 16);
#pragma unroll
                for (int bj = 0; bj < 2; ++bj) {
                    const u32x4 g = *(const u32x4*)(gate + r * ldg + col0 + bj * HALF);
                    bf16_t* mp = Mg + r * 1024 + col0 + bj * HALF;
                    f32x4 v0 = acc[ai][bj][m][0], v1 = acc[ai][bj][m][1];
                    v0[0] *= bflo(g.x); v0[1] *= bfhi(g.x); v0[2] *= bflo(g.y); v0[3] *= bfhi(g.y);
                    v1[0] *= bflo(g.z); v1[1] *= bfhi(g.z); v1[2] *= bflo(g.w); v1[3] *= bfhi(g.w);
                    if (!first) { const u32x4 o = *(const u32x4*)mp;
                        v0[0] += bflo(o.x); v0[1] += bfhi(o.x); v0[2] += bflo(o.y); v0[3] += bfhi(o.y);
                        v1[0] += bflo(o.z); v1[1] += bfhi(o.z); v1[2] += bflo(o.w); v1[3] += bfhi(o.w); }
                    u32x4 w; w.x = cvt_pk_bf16(v0[0], v0[1]); w.y = cvt_pk_bf16(v0[2], v0[3]); w.z = cvt_pk_bf16(v1[0], v1[1]); w.w = cvt_pk_bf16(v1[2], v1[3]);
                    *(u32x4*)mp = w; } }
    }
};
struct EpiWo {
    static constexpr bool PERM = false, AFTER_DRAIN = false;
    const float* xin; float* xout; const float* gate1; int gstride; int row_g0; int seq;
    __device__ __forceinline__ void operator()(const f32x4 (&acc)[2][2][4][2], const Unit& u, int wr, int wc, int fr, int fq) const {
        const int row0 = u.pm * BM + wr * 64 + fr, col0 = u.pn * BM + wc * 32 + 4 * fq;
        const int b = (row_g0 + u.pm * BM) / seq;
        const float* g1 = gate1 + (size_t)b * gstride + col0;
#pragma unroll
        for (int ai = 0; ai < 2; ++ai)
#pragma unroll
            for (int m = 0; m < 4; ++m) { const size_t off = (size_t)(row0 + ai * HALF + m * 16) * 1024 + col0;
#pragma unroll
                for (int bj = 0; bj < 2; ++bj)
#pragma unroll
                    for (int n = 0; n < 2; ++n) { const f32x4 xv = *(const f32x4*)(xin + off + bj * HALF + n * 16);
                        *(f32x4*)(xout + off + bj * HALF + n * 16) = xv + *(const f32x4*)(g1 + bj * HALF + n * 16) * acc[ai][bj][m][n]; } }
    }
};
struct EpiGLU {
    static constexpr bool PERM = true, AFTER_DRAIN = false;
    bf16_t* Gb;
    __device__ __forceinline__ void operator()(const f32x4 (&acc)[2][2][4][2], const Unit& u, int wr, int wc, int fr, int fq) const {
        const int row0 = u.pm * BM + wr * 64 + fr; const int col0 = (u.pn & 3) * HALF + wc * 32 + 8 * fq;
#pragma unroll
        for (int ai = 0; ai < 2; ++ai)
#pragma unroll
            for (int m = 0; m < 4; ++m) { bf16_t* rowp = Gb + (size_t)(row0 + ai * HALF + m * 16) * 512 + col0;
                f32x4 v0, v1;
#pragma unroll
                for (int j = 0; j < 4; ++j) { const float g0 = acc[ai][0][m][0][j], g1 = acc[ai][0][m][1][j];
                    v0[j] = g0 * sigmoidf_(g0) * acc[ai][1][m][0][j]; v1[j] = g1 * sigmoidf_(g1) * acc[ai][1][m][1][j]; }
                u32x4 w; w.x = cvt_pk_bf16(v0[0], v0[1]); w.y = cvt_pk_bf16(v0[2], v0[3]); w.z = cvt_pk_bf16(v1[0], v1[1]); w.w = cvt_pk_bf16(v1[2], v1[3]);
                *(u32x4*)rowp = w; }
    }
};
struct MoeOrder {
    const int* tile_e; int ntiles, G, c;
    __device__ __forceinline__ bool next(int i, Unit& u) const {
        const int L = i * G + c; const int r = L >> 2; if (r >= ntiles) return false;
        u.pm = r; u.pn = tile_e[r] * 4 + (L & 3); return true; }
    __device__ __forceinline__ void a_ready(const Unit&) const {}
    __device__ __forceinline__ void done(const Unit&) const {}
};

template <class Epi, class Sched, bool STAMP = false>
__device__ __forceinline__ void gemm_phase(PG8_LAS unsigned char* lds, const Gemm g, const Sched& S, const Epi& E, unsigned long long* stamps) {
    int tid = threadIdx.x; asm volatile("" : "+v"(tid));
    const int wid = __builtin_amdgcn_readfirstlane(tid >> 6), lane = tid & 63, wr = wid >> 2, wc = wid & 3, fr = lane & 15, fq = lane >> 4;
    const int K = g.K, nt = K / BK;
    int ts_lo = 0, ts_hi = 0, nts = 0; const unsigned long long rt_entry = STAMP ? (unsigned long long)wall_clock64() : 0ull;
#define PG8_STAMP() do { if (STAMP && wid == 0 && nts < 64) { const unsigned long long _c = (unsigned long long)clock64(); \
        ts_lo = (lane == nts) ? (int)(unsigned)_c : ts_lo; ts_hi = (lane == nts) ? (int)(unsigned)(_c >> 32) : ts_hi; ++nts; } } while (0)
    PG8_STAMP();
    unsigned voffA[2], voffB[2];
#pragma unroll
    for (int i = 0; i < 2; ++i) { int R, C; stage_rc(tid * 16 + i * 8192, R, C); const int Rb = Epi::PERM ? ((R & ~31) + perm32(R & 31)) : R;
        voffA[i] = (unsigned)(R * K + C) * 2u; voffB[i] = (unsigned)(Rb * K + C) * 2u; }
    const size_t kstep = (size_t)(BK * 2);
    const size_t hstep = (size_t)HALF * K * 2;
    const size_t tstep = 2 * hstep;
    const unsigned ldsw = (unsigned)wid * 1024u;
    const int aoff = lds_byte(wr * 64 + fr, fq * 8), boff = lds_byte(wc * 32 + fr, fq * 8);
#define PG8_SA(b, h) (((b) * 2 + (h)) * HTB)
#define PG8_SB(b, h) ((4 + (b) * 2 + (h)) * HTB)
#define PG8_STAGE(bufoff, gbase, voff) do { _Pragma("unroll") for (int _i = 0; _i < 2; ++_i) \
        __builtin_amdgcn_global_load_lds((const unsigned*)((const char*)(gbase) + (voff)[_i]), (PG8_LAS unsigned*)(lds + (bufoff) + ldsw + _i * 8192), 16, 0, 0); } while (0)
#define PG8_LDA(dst, b, h) do { _Pragma("unroll") for (int m = 0; m < 4; ++m) _Pragma("unroll") for (int k = 0; k < 2; ++k) dst[m][k] = *(const PG8_LAS bf16x8*)(lds + PG8_SA(b, h) + aoff + m * 2048 + k * 1024); } while (0)
#define PG8_LDB(dst, b, h) do { _Pragma("unroll") for (int n = 0; n < 2; ++n) _Pragma("unroll") for (int k = 0; k < 2; ++k) dst[n][k] = *(const PG8_LAS bf16x8*)(lds + PG8_SB(b, h) + boff + n * 2048 + k * 1024); } while (0)
#define PG8_MMA(ai, bj, At, Bt) do { __builtin_amdgcn_s_setprio(1); _Pragma("unroll") for (int m = 0; m < 4; ++m) _Pragma("unroll") for (int n = 0; n < 2; ++n) _Pragma("unroll") for (int k = 0; k < 2; ++k) \
        acc[ai][bj][m][n] = __builtin_amdgcn_mfma_f32_16x16x32_bf16(Bt[n][k], At[m][k], acc[ai][bj][m][n], 0, 0, 0); __builtin_amdgcn_s_setprio(0); } while (0)
#define PG8_WAIT_V(n) asm volatile("s_waitcnt vmcnt(" #n ")" ::: "memory")
#define PG8_WAIT_L(n) asm volatile("s_waitcnt lgkmcnt(" #n ")" ::: "memory")
#define PG8_BAR __builtin_amdgcn_s_barrier()
#define PG8_SCHED __builtin_amdgcn_sched_barrier(0)
    Unit cur, nxt; int ui = 0;
    if (!S.next(0, cur)) return;
    f32x4 acc[2][2][4][2];
#pragma unroll
    for (int a = 0; a < 2; ++a)
#pragma unroll
        for (int b = 0; b < 2; ++b)
#pragma unroll
            for (int m = 0; m < 4; ++m)
#pragma unroll
                for (int n = 0; n < 2; ++n) acc[a][b][m][n] = (f32x4){0.f, 0.f, 0.f, 0.f};
    bf16x8 At[4][2], B0[2][2], B1[2][2];
    const char* cA = (const char*)g.A + (size_t)cur.pm * tstep; const char* cB = (const char*)g.Bt + (size_t)cur.pn * tstep;
    S.a_ready(cur);
    PG8_STAGE(PG8_SB(0, 0), cB, voffB); PG8_STAGE(PG8_SA(0, 0), cA, voffA); PG8_STAGE(PG8_SB(0, 1), cB + hstep, voffB); PG8_STAGE(PG8_SA(0, 1), cA + hstep, voffA);
    if (wr == 1) PG8_BAR;
    PG8_WAIT_V(4); PG8_BAR;
    PG8_STAGE(PG8_SB(1, 0), cB + kstep, voffB); PG8_STAGE(PG8_SA(1, 0), cA + kstep, voffA); PG8_STAGE(PG8_SB(1, 1), cB + hstep + kstep, voffB);
    PG8_WAIT_V(6); PG8_BAR;
    PG8_STAMP();
    for (;;) {
        const bool has_next = S.next(ui + 1, nxt);
        const char* nA = has_next ? (const char*)g.A + (size_t)nxt.pm * tstep : cA; const char* nB = has_next ? (const char*)g.Bt + (size_t)nxt.pn * tstep : cB;
        for (int t = 0; t < nt; t += 2) {
            const bool last = (t == nt - 2);
            const char* a1 = cA + (size_t)(t + 1) * kstep;
            const char* a2 = last ? nA : cA + (size_t)(t + 2) * kstep; const char* b2 = last ? nB : cB + (size_t)(t + 2) * kstep;
            const char* a3 = a2 + kstep; const char* b3 = b2 + kstep;
            if (last && has_next) S.a_ready(nxt);
            PG8_LDB(B0, 0, 0); PG8_SCHED; PG8_LDA(At, 0, 0); PG8_STAGE(PG8_SA(1, 1), a1 + hstep, voffA);
            PG8_WAIT_L(8); PG8_BAR; PG8_WAIT_L(0); PG8_MMA(0, 0, At, B0); PG8_BAR; PG8_SCHED;
            PG8_LDB(B1, 0, 1); PG8_STAGE(PG8_SB(0, 0), b2, voffB);
            PG8_BAR; PG8_WAIT_L(0); PG8_MMA(0, 1, At, B1); PG8_BAR;
            PG8_LDA(At, 0, 1); PG8_STAGE(PG8_SA(0, 0), a2, voffA);
            PG8_BAR; PG8_WAIT_L(0); PG8_MMA(1, 0, At, B0); PG8_BAR; PG8_SCHED;
            PG8_STAGE(PG8_SB(0, 1), b2 + hstep, voffB);
            PG8_WAIT_V(6); PG8_BAR; PG8_MMA(1, 1, At, B1); PG8_BAR;
            PG8_LDB(B0, 1, 0); PG8_SCHED; PG8_LDA(At, 1, 0); PG8_STAGE(PG8_SA(0, 1), a2 + hstep, voffA);
            PG8_WAIT_L(8); PG8_BAR; PG8_WAIT_L(0); PG8_MMA(0, 0, At, B0); PG8_BAR; PG8_SCHED;
            PG8_LDB(B1, 1, 1); PG8_STAGE(PG8_SB(1, 0), b3, voffB);
            PG8_BAR; PG8_WAIT_L(0); PG8_MMA(0, 1, At, B1); PG8_BAR;
            PG8_LDA(At, 1, 1); PG8_STAGE(PG8_SA(1, 0), a3, voffA);
            PG8_BAR; PG8_WAIT_L(0); PG8_MMA(1, 0, At, B0); PG8_BAR; PG8_SCHED;
            PG8_STAGE(PG8_SB(1, 1), b3 + hstep, voffB);
            PG8_WAIT_V(6); PG8_BAR; PG8_MMA(1, 1, At, B1); PG8_BAR;
        }
        PG8_STAMP();
        if constexpr (!Epi::AFTER_DRAIN) { E(acc, cur, wr, wc, fr, fq); S.done(cur); }
        PG8_STAMP();
        if (!has_next) break;
#pragma unroll
        for (int a = 0; a < 2; ++a)
#pragma unroll
            for (int b = 0; b < 2; ++b)
#pragma unroll
                for (int m = 0; m < 4; ++m)
#pragma unroll
                    for (int n = 0; n < 2; ++n) acc[a][b][m][n] = (f32x4){0.f, 0.f, 0.f, 0.f};
        cur = nxt; cA = nA; cB = nB; ++ui;
    }
    PG8_WAIT_V(0);
    if (wr == 0) PG8_BAR;
    PG8_BAR;
    if constexpr (Epi::AFTER_DRAIN) { E.fused(acc, cur, wr, wc, fr, fq, lds, wid, lane); S.done(cur); }
    PG8_STAMP();
    if (STAMP && wid == 0) { stamps[lane] = lane < nts ? (((unsigned long long)(unsigned)ts_hi << 32) | (unsigned)ts_lo) : 0ull;
        if (lane == 62) stamps[62] = rt_entry; if (lane == 63) stamps[63] = (unsigned long long)wall_clock64(); }
#undef PG8_STAMP
#undef PG8_SA
#undef PG8_SB
#undef PG8_STAGE
#undef PG8_LDA
#undef PG8_LDB
#undef PG8_MMA
#undef PG8_WAIT_V
#undef PG8_WAIT_L
#undef PG8_BAR
#undef PG8_SCHED
}
}

#define GAS __attribute__((address_space(1)))
#define LAS __attribute__((address_space(3)))
typedef unsigned short bf16;
typedef unsigned v4u __attribute__((ext_vector_type(4)));
typedef unsigned v2u __attribute__((ext_vector_type(2)));
typedef float f32x4 __attribute__((ext_vector_type(4)));
typedef float f32x16 __attribute__((ext_vector_type(16)));
typedef short bf16x8 __attribute__((ext_vector_type(8)));
typedef short bf16x4 __attribute__((ext_vector_type(4)));

constexpr int NB = 8, SEQ = 8192, T = NB * SEQ, D = 1024, MW = 512, NL = 2;
constexpr int HT = T / 2;
constexpr int N_RWKV = 1792, N_REST = 3584, N_GATE = 3072, N1 = N_RWKV + N_REST + N_GATE;
constexpr int NSLOT_MAX = 2 * T + 32 * 256;
constexpr int NWAVES = 8, NTHR = 512;

constexpr size_t MiB = (size_t)1 << 20;
constexpr size_t WS_CTL = 0, CTL_ZERO_BYTES = 2 * MiB;
constexpr size_t WS_MOD = 1 * MiB;
constexpr size_t WS_WT1 = 2 * MiB;
constexpr size_t WS_WBR = 35 * MiB;
constexpr size_t WS_WO = 41 * MiB;
constexpr size_t WS_LOT = 45 * MiB;
constexpr size_t WS_H = 48 * MiB;
constexpr size_t WS_YRWKV = 176 * MiB;
constexpr size_t WS_R = 240 * MiB;
constexpr size_t WS_PRW = WS_R;
constexpr size_t WS_SI = 464 * MiB;
constexpr size_t WS_E1 = 848 * MiB;
constexpr size_t WS_GT = 912 * MiB;
constexpr size_t WS_PREST = WS_R;
constexpr size_t WS_GATES = 464 * MiB;
constexpr size_t WS_YRET = 656 * MiB;
constexpr size_t WS_YCONV = 688 * MiB;
constexpr size_t WS_MERGED = 720 * MiB;
constexpr size_t WS_KV = 784 * MiB;
constexpr size_t WS_SST = 848 * MiB;
constexpr size_t WS_WGU = WS_R;
constexpr size_t WS_WD = 304 * MiB;
constexpr size_t WS_XROWS = 336 * MiB;
constexpr size_t WS_GB = 608 * MiB;
constexpr size_t WS_YM = 744 * MiB;
constexpr size_t WS_TAB = 1016 * MiB;
constexpr size_t TAB_ROWTOK = 0, TAB_SLOTOF = 1 * MiB, TAB_RW = 2 * MiB, TAB_EID = 3 * MiB, TAB_CNT = 4 * MiB, TAB_TILEE = 4 * MiB + 512 * 1024, TAB_NT = TAB_TILEE + 4096;
constexpr size_t WS_END = 1024 * MiB;
constexpr int CW_BAR = 4096;

constexpr int LDS_BYTES = 163840;
constexpr int LDS_MISC = LDS_BYTES - 256;

#define LDS_WAIT() asm volatile("s_waitcnt lgkmcnt(0)" ::: "memory")
#define VM_WAIT() asm volatile("s_waitcnt vmcnt(0)" ::: "memory")

#define XB_TMO      128
#define XB_XCNT(j)  (256  + 64 * (j))
#define XB_XSUB(j)  (1280 + 64 * (j))
#define XB_XGEN(j)  (2304 + 64 * (j))
#define XB_TOP      3328
#define XB_TOPGEN   3392
#define XCD_BAR_WORDS 3456
#define XB_SPIN_CAP (1u << 20)

__device__ __forceinline__ unsigned xb_ld(unsigned* p)              { return __hip_atomic_load(p, __ATOMIC_RELAXED, __HIP_MEMORY_SCOPE_AGENT); }
__device__ __forceinline__ unsigned xb_add(unsigned* p, unsigned v) { return __hip_atomic_fetch_add(p, v, __ATOMIC_RELAXED, __HIP_MEMORY_SCOPE_AGENT); }
__device__ __forceinline__ unsigned xb_xcc_id() { return (unsigned)__builtin_amdgcn_s_getreg((3 << 11) | 20) & 0xFu; }
#define XB_SPIN(cond, bar) do { unsigned _sp = 0; while (cond) { __builtin_amdgcn_s_sleep(1); \
    if ((++_sp & 255u) == 0u) { if (xb_ld(&(bar)[XB_TMO])) break; if (_sp > XB_SPIN_CAP) { atomicAdd(&(bar)[XB_TMO], 1u); break; } } } } while (0)

struct XcdBarrier {
    unsigned* bar; unsigned x;
    volatile LAS unsigned* st;
};
__device__ __forceinline__ XcdBarrier xcd_barrier_post(unsigned* bar, volatile LAS unsigned* st) {
    XcdBarrier b; b.bar = bar; b.x = xb_xcc_id(); b.st = st;
    if (threadIdx.x == 0) (void)xb_add(&bar[XB_XCNT(b.x)], 1u);
    return b;
}
__device__ __forceinline__ void xcd_barrier_complete(unsigned* bar, unsigned x, unsigned& nloc, unsigned& nx) {
    const unsigned G = gridDim.x * gridDim.y * gridDim.z;
    unsigned sum, cnt, mine, sp = 0u;
    for (;;) {
        sum = 0u; cnt = 0u; mine = 0u;
#pragma unroll
        for (unsigned j = 0; j < 16; ++j) { const unsigned c = xb_ld(&bar[XB_XCNT(j)]); sum += c; cnt += (c > 0u) ? 1u : 0u; mine = (j == x) ? c : mine; }
        if (sum == G) break;
        __builtin_amdgcn_s_sleep(1);
        if ((++sp & 255u) == 0u) { if (xb_ld(&bar[XB_TMO])) break; if (sp > XB_SPIN_CAP) { atomicAdd(&bar[XB_TMO], 1u); break; } }
    }
    nloc = mine > 0u ? mine : 1u; nx = cnt > 0u ? cnt : 1u;
}
__device__ __forceinline__ void xcd_barrier(const XcdBarrier& b) {
    asm volatile("s_waitcnt vmcnt(0)" ::: "memory");
    __syncthreads();
    if (threadIdx.x == 0) {
        unsigned* bar = b.bar;
        __builtin_amdgcn_s_waitcnt(0);
        unsigned nloc = b.st[0], nx = b.st[1];
        if (nloc == 0u) { xcd_barrier_complete(bar, b.x, nloc, nx); b.st[0] = nloc; b.st[1] = nx; }
        const unsigned old = xb_add(&bar[XB_XSUB(b.x)], 1u);
        const unsigned gen = old / nloc;
        if (old + 1u == (gen + 1u) * nloc) {
            __builtin_amdgcn_fence(__ATOMIC_RELEASE, "agent");
            asm volatile("s_waitcnt vmcnt(0)" ::: "memory");
            const unsigned og = xb_add(&bar[XB_TOP], 1u);
            const unsigned tg = og / nx;
            if (og + 1u == (tg + 1u) * nx) xb_add(&bar[XB_TOPGEN], 1u);
            else XB_SPIN(xb_ld(&bar[XB_TOPGEN]) == tg, bar);
            __builtin_amdgcn_fence(__ATOMIC_ACQUIRE, "agent");
            xb_add(&bar[XB_XGEN(b.x)], 1u);
            asm volatile("s_waitcnt vmcnt(0)" ::: "memory");
        } else {
            XB_SPIN(xb_ld(&bar[XB_XGEN(b.x)]) == gen, bar);
            __builtin_amdgcn_fence(__ATOMIC_ACQUIRE, "agent");
            asm volatile("s_waitcnt vmcnt(0)" ::: "memory");
        }
    }
    __syncthreads();
}

__device__ __forceinline__ float bflo(unsigned u) { return __uint_as_float(u << 16); }
__device__ __forceinline__ float bfhi(unsigned u) { return __uint_as_float(u & 0xffff0000u); }
__device__ __forceinline__ unsigned pk2(float lo, float hi) { return pg8::cvt_pk_bf16(lo, hi); }
__device__ __forceinline__ float sigm(float x) { return __builtin_amdgcn_rcpf(1.0f + __expf(-x)); }
__device__ __forceinline__ float dppf(float x, const int ctrl) { return x; }
#define DPP_F(x, ctrl, rm, bm, bc) __builtin_bit_cast(float, __builtin_amdgcn_update_dpp(0, __builtin_bit_cast(int, (x)), (ctrl), (rm), (bm), (bc)))
__device__ __forceinline__ float sum16(float x) {
    x += DPP_F(x, 0xB1, 0xf, 0xf, false);
    x += DPP_F(x, 0x4E, 0xf, 0xf, false);
    x += DPP_F(x, 0x141, 0xf, 0xf, false);
    x += DPP_F(x, 0x140, 0xf, 0xf, false);
    return x;
}
__device__ __forceinline__ float wave_sum(float x) {
    x = sum16(x);
    x += DPP_F(x, 0x142, 0xa, 0xf, false);
    x += DPP_F(x, 0x143, 0xc, 0xf, false);
    return __builtin_bit_cast(float, __builtin_amdgcn_readlane(__builtin_bit_cast(int, x), 63));
}
__device__ __forceinline__ float sum8(float x) {
    x += DPP_F(x, 0xB1, 0xf, 0xf, false);
    x += DPP_F(x, 0x4E, 0xf, 0xf, false);
    x += DPP_F(x, 0x141, 0xf, 0xf, false);
    return x;
}

struct Params {
    const void* in[32];
    float* out;
    unsigned char* ws;
    int lo, hi;
};

__device__ __forceinline__ void tr_block(const float* W, int ldsrc, bf16* WT, int ldt, int k0, LAS float* scr, int lane) {
#pragma unroll 8
    for (int i = 0; i < 32; ++i) { const int kk = 2 * i + (lane >> 5); scr[kk * 33 + (lane & 31)] = W[(size_t)(k0 + kk) * ldsrc + (lane & 31)]; }
    LDS_WAIT(); asm volatile("" ::: "memory");
    const int c = lane & 7;
#pragma unroll
    for (int j = 0; j < 4; ++j) { const int n = (lane >> 3) + 8 * j; const LAS float* s = scr + (8 * c) * 33 + n;
        v4u o; o.x = pk2(s[0 * 33], s[1 * 33]); o.y = pk2(s[2 * 33], s[3 * 33]); o.z = pk2(s[4 * 33], s[5 * 33]); o.w = pk2(s[6 * 33], s[7 * 33]);
        *(v4u*)(WT + (size_t)n * ldt + k0 + 8 * c) = o; }
    LDS_WAIT(); asm volatile("" ::: "memory");
}
__device__ __forceinline__ void tr_job(const float* W, int ldsrc, int K, int N, bf16* WT, int ldt, LAS float* scr, int lane, int gw, int NGW, int& base) {
    const int nblk = N / 32, items = (K / 64) * nblk;
    int start = (gw - (base % NGW) + NGW) % NGW;
    for (int it = start; it < items; it += NGW) { const int kb = it / nblk, nb = it % nblk;
        tr_block(W + nb * 32, ldsrc, WT + (size_t)nb * 32 * ldt, ldt, kb * 64, scr, lane); }
    base += items;
}
__device__ __forceinline__ void p0_mixer_weights(const Params& P, LAS float* scr, int lane, int gw, int NGW) {
    unsigned char* ws = P.ws; asm volatile("" : "+s"(ws)); int base = 0;
    for (int l = 0; l < NL; ++l) {
        const float* w_in = (const float*)P.in[8] + (size_t)l * D * 5376;
        const float* w_gate = (const float*)P.in[9] + (size_t)l * D * N_GATE;
        bf16* wt1 = (bf16*)(ws + WS_WT1) + (size_t)l * N1 * D;
        tr_job(w_in + 2048, 5376, D, N_RWKV, wt1, D, scr, lane, gw, NGW, base);
        tr_job(w_in, 5376, D, 2048, wt1 + (size_t)N_RWKV * D, D, scr, lane, gw, NGW, base);
        tr_job(w_in + 3840, 5376, D, 1536, wt1 + (size_t)(N_RWKV + 2048) * D, D, scr, lane, gw, NGW, base);
        tr_job(w_gate, N_GATE, D, N_GATE, wt1 + (size_t)(N_RWKV + N_REST) * D, D, scr, lane, gw, NGW, base);
        for (int i = 0; i < 3; ++i)
            tr_job((const float*)P.in[23] + (size_t)(l * 3 + i) * MW * D, D, MW, D, (bf16*)(ws + WS_WBR) + (size_t)(l * 3 + i) * D * MW, MW, scr, lane, gw, NGW, base);
        tr_job((const float*)P.in[24] + (size_t)l * D * D, D, D, D, (bf16*)(ws + WS_WO) + (size_t)l * D * D, D, scr, lane, gw, NGW, base);
        bf16* lot = (bf16*)(ws + WS_LOT) + (size_t)l * 131072;
        tr_job((const float*)P.in[14] + (size_t)l * 64 * MW, MW, 64, MW, lot, 64, scr, lane, gw, NGW, base);
        tr_job((const float*)P.in[16] + (size_t)l * 64 * MW, MW, 64, MW, lot + 32768, 64, scr, lane, gw, NGW, base);
        tr_job((const float*)P.in[17] + (size_t)l * 128 * MW, MW, 128, MW, lot + 65536, 128, scr, lane, gw, NGW, base);
    }
}
__device__ __forceinline__ void p_expert_weights(const Params& P, int l, LAS float* scr, int lane, int gw, int NGW) {
    unsigned char* ws = P.ws; asm volatile("" : "+s"(ws));
    const float* wg = (const float*)P.in[29] + (size_t)l * 32 * D * MW;
    const float* wu = (const float*)P.in[30] + (size_t)l * 32 * D * MW;
    const float* wd = (const float*)P.in[31] + (size_t)l * 32 * MW * D;
    bf16* Wgu = (bf16*)(ws + WS_WGU); bf16* Wd = (bf16*)(ws + WS_WD);
    for (int it = gw; it < 3 * 8192; it += NGW) {
        const int which = it / 8192, r = it % 8192, e = r / 256, q = r % 256;
        if (which < 2) {
            const int kb = q / 16, nb = q % 16, n0 = nb * 32;
            const float* src = (which == 0 ? wg : wu) + (size_t)e * D * MW + n0;
            bf16* dst = Wgu + (size_t)e * D * D + (size_t)((n0 / 128) * 256 + (n0 % 128) + (which == 1 ? 128 : 0)) * D;
            tr_block(src, MW, dst, D, kb * 64, scr, lane);
        } else {
            const int kb = q / 32, nb = q % 32, n0 = nb * 32;
            tr_block(wd + (size_t)e * MW * D + n0, D, Wd + (size_t)e * D * MW + (size_t)n0 * MW, MW, kb * 64, scr, lane);
        }
    }
}
__device__ __forceinline__ void p0_mod(const Params& P, LAS unsigned char* lds, int tid, int c, int G) {
    LAS float* sc = (LAS float*)lds;
    LAS float* red = sc + 8192;
    const float* cin = (const float*)P.in[1]; const float* w_ada = (const float*)P.in[6]; const float* b_ada = (const float*)P.in[7];
    float* mod = (float*)(P.ws + WS_MOD);
    __syncthreads();
    for (int i = tid; i < 8192; i += NTHR) { const float cv = cin[i]; sc[i] = cv * sigm(cv); }
    __syncthreads();
    for (int it = c; it < 192; it += G) {
        const int l = it / 96, nb = it % 96;
        const int colL = tid & 63, ks = tid >> 6, col = nb * 64 + colL;
        const float* wp = w_ada + ((size_t)l * D + ks * 128) * 6144 + col;
        float a0 = 0.f, a1 = 0.f, a2 = 0.f, a3 = 0.f, a4 = 0.f, a5 = 0.f, a6 = 0.f, a7 = 0.f;
#pragma unroll 8
        for (int k = 0; k < 128; ++k) { const float wv = wp[(size_t)k * 6144]; const LAS float* s = sc + ks * 128 + k;
            a0 += s[0] * wv; a1 += s[1024] * wv; a2 += s[2048] * wv; a3 += s[3072] * wv; a4 += s[4096] * wv; a5 += s[5120] * wv; a6 += s[6144] * wv; a7 += s[7168] * wv; }
        LAS float* rp = red + ks * 512 + colL;
        rp[0] = a0; rp[64] = a1; rp[128] = a2; rp[192] = a3; rp[256] = a4; rp[320] = a5; rp[384] = a6; rp[448] = a7;
        __syncthreads();
        { const int b = tid >> 6; float s = b_ada[l * 6144 + col];
#pragma unroll
          for (int q = 0; q < 8; ++q) s += red[q * 512 + b * 64 + colL];
          mod[((size_t)l * NB + b) * 6144 + col] = s; }
        __syncthreads();
    }
    __syncthreads();
}

template <int MODE>
__device__ __forceinline__ void row_phase(const Params& P, int l, LAS unsigned char* lds, int tid, int lane, int wave, int c, int G) {
    unsigned char* ws = P.ws; asm volatile("" : "+s"(ws));
    const float* mod = (const float*)(ws + WS_MOD);
    bf16* H = (bf16*)(ws + WS_H);
    const bool combine = (MODE == 2) || (MODE == 0 && l > 0);
    const int lprev = (MODE == 2) ? NL - 1 : l - 1;
    const float* src = (MODE == 0 && l == 0) ? (const float*)P.in[0] : P.out;
    const int* slot_of = (const int*)(ws + WS_TAB + TAB_SLOTOF);
    const float* rwt = (const float*)(ws + WS_TAB + TAB_RW);
    const bf16* YM = (const bf16*)(ws + WS_YM);
    LAS float* Wr = (LAS float*)lds;
    LAS int* hist = (LAS int*)(lds + 36 * 1024 * 4);
    if (MODE == 1) {
        const float* wg = (const float*)P.in[25] + (size_t)l * D * 4; const float* we = (const float*)P.in[27] + (size_t)l * D * 32;
        for (int i = tid; i < D * 4; i += NTHR) Wr[(i & 3) * 1024 + (i >> 2)] = wg[i];
        for (int i = tid; i < D * 32; i += NTHR) Wr[(4 + (i & 31)) * 1024 + (i >> 5)] = we[i];
        int* row_tok = (int*)(ws + WS_TAB + TAB_ROWTOK);
        for (int i = c * NTHR + tid; i < NSLOT_MAX; i += G * NTHR) row_tok[i] = 0;
        __syncthreads();
    }
    const float* gam = (MODE == 0) ? (const float*)P.in[3] + l * D : (MODE == 1) ? (const float*)P.in[4] + l * D : (const float*)P.in[5];
    for (int ck = c; ck < T / 256; ck += G) {
        if (MODE == 1) { __syncthreads(); if (tid < 32) hist[tid] = 0; __syncthreads(); }
        for (int i = 0; i < 32; ++i) {
            const int row = ck * 256 + wave + 8 * i, b = row / SEQ;
            const f32x4* xr = (const f32x4*)(src + (size_t)row * D) + lane;
            f32x4 v[4];
#pragma unroll
            for (int j = 0; j < 4; ++j) v[j] = xr[64 * j];
            if (combine) {
                const int s0 = slot_of[row * 2], s1 = slot_of[row * 2 + 1]; const float w0 = rwt[row * 2], w1 = rwt[row * 2 + 1];
                const float* g2 = mod + ((size_t)lprev * NB + b) * 6144 + 5120;
                const v2u* y0 = (const v2u*)(YM + (size_t)s0 * D) + lane; const v2u* y1 = (const v2u*)(YM + (size_t)s1 * D) + lane;
#pragma unroll
                for (int j = 0; j < 4; ++j) { const v2u a = y0[64 * j], bb = y1[64 * j]; const f32x4 gg = *((const f32x4*)g2 + lane + 64 * j);
                    v[j][0] += gg[0] * (w0 * bflo(a.x) + w1 * bflo(bb.x)); v[j][1] += gg[1] * (w0 * bfhi(a.x) + w1 * bfhi(bb.x));
                    v[j][2] += gg[2] * (w0 * bflo(a.y) + w1 * bflo(bb.y)); v[j][3] += gg[3] * (w0 * bfhi(a.y) + w1 * bfhi(bb.y)); }
                if (MODE == 0) { f32x4* xo = (f32x4*)(P.out + (size_t)row * D) + lane;
#pragma unroll
                    for (int j = 0; j < 4; ++j) xo[64 * j] = v[j]; }
            }
            float ss = 0.f;
#pragma unroll
            for (int j = 0; j < 4; ++j) ss += (v[j][0] * v[j][0] + v[j][1] * v[j][1]) + (v[j][2] * v[j][2] + v[j][3] * v[j][3]);
            ss = wave_sum(ss);
            const float rstd = rsqrtf(ss * (1.0f / D) + 1e-6f);
            if (MODE == 2) {
                f32x4* xo = (f32x4*)(P.out + (size_t)row * D) + lane;
#pragma unroll
                for (int j = 0; j < 4; ++j) { const f32x4 g = *((const f32x4*)gam + lane + 64 * j); xo[64 * j] = v[j] * rstd * g; }
            } else {
                const float* mb = mod + ((size_t)l * NB + b) * 6144 + (MODE == 0 ? 0 : 3072);
                f32x4 h[4];
#pragma unroll
                for (int j = 0; j < 4; ++j) { const f32x4 g = *((const f32x4*)gam + lane + 64 * j), sh = *((const f32x4*)mb + lane + 64 * j), scl = *((const f32x4*)(mb + 1024) + lane + 64 * j);
                    h[j] = v[j] * rstd * g * (1.0f + scl) + sh; }
                v2u* ho = (v2u*)(H + (size_t)row * D) + lane;
#pragma unroll
                for (int j = 0; j < 4; ++j) { v2u o; o.x = pk2(h[j][0], h[j][1]); o.y = pk2(h[j][2], h[j][3]); ho[64 * j] = o; }
                if (MODE == 1) {
                    float lg[36];
#pragma unroll
                    for (int e = 0; e < 36; ++e) { float p = 0.f;
#pragma unroll
                        for (int j = 0; j < 4; ++j) { const f32x4 w = *((const LAS f32x4*)(Wr + e * 1024) + lane + 64 * j);
                            p += (h[j][0] * w[0] + h[j][1] * w[1]) + (h[j][2] * w[2] + h[j][3] * w[3]); }
                        lg[e] = wave_sum(p); }
                    const float* bg = (const float*)P.in[26] + l * 4; const float* be = (const float*)P.in[28] + l * 32;
                    const float g0 = lg[0] + bg[0], g1 = lg[1] + bg[1], g2 = lg[2] + bg[2], g3 = lg[3] + bg[3];
                    int gsel = 0; float gm = g0;
                    if (g1 > gm) { gm = g1; gsel = 1; } if (g2 > gm) { gm = g2; gsel = 2; } if (g3 > gm) { gm = g3; gsel = 3; }
                    const float den = __expf(g0 - gm) + __expf(g1 - gm) + __expf(g2 - gm) + __expf(g3 - gm);
                    const float pgrp = 1.0f / den;
                    float el[8];
#pragma unroll
                    for (int j = 0; j < 8; ++j) { const float a = gsel == 0 ? lg[4 + j] : gsel == 1 ? lg[12 + j] : gsel == 2 ? lg[20 + j] : lg[28 + j]; el[j] = a + be[gsel * 8 + j]; }
                    int i1 = 0; float v1 = el[0];
#pragma unroll
                    for (int j = 1; j < 8; ++j) if (el[j] > v1) { v1 = el[j]; i1 = j; }
                    int i2 = -1; float v2 = -3.0e38f;
#pragma unroll
                    for (int j = 0; j < 8; ++j) if (j != i1 && el[j] > v2) { v2 = el[j]; i2 = j; }
                    const float e2 = __expf(v2 - v1), p1 = 1.0f / (1.0f + e2), p2 = e2 * p1;
                    if (lane == 0) {
                        int* eid = (int*)(ws + WS_TAB + TAB_EID); float* rwo = (float*)(ws + WS_TAB + TAB_RW);
                        const int e0 = gsel * 8 + i1, e1 = gsel * 8 + i2;
                        eid[row * 2] = e0; eid[row * 2 + 1] = e1; rwo[row * 2] = p1 * pgrp; rwo[row * 2 + 1] = p2 * pgrp;
                        __hip_atomic_fetch_add(&hist[e0], 1, __ATOMIC_RELAXED, __HIP_MEMORY_SCOPE_WORKGROUP); __hip_atomic_fetch_add(&hist[e1], 1, __ATOMIC_RELAXED, __HIP_MEMORY_SCOPE_WORKGROUP);
                    }
                }
            }
        }
        if (MODE == 1) { __syncthreads(); if (tid < 32) ((int*)(ws + WS_TAB + TAB_CNT))[ck * 32 + tid] = hist[tid]; }
    }
    __syncthreads();
}

__device__ __forceinline__ void moe_slots(const Params& P, LAS unsigned char* lds, int tid, int c, int G) {
    unsigned char* ws = P.ws; asm volatile("" : "+s"(ws));
    const int* cnt = (const int*)(ws + WS_TAB + TAB_CNT); const int* eid = (const int*)(ws + WS_TAB + TAB_EID);
    int* row_tok = (int*)(ws + WS_TAB + TAB_ROWTOK); int* slot_of = (int*)(ws + WS_TAB + TAB_SLOTOF);
    LAS int* tot = (LAS int*)lds; LAS int* bef = tot + 32; LAS int* ps = bef + 32; LAS int* eb = ps + 64;
    for (int ck = c; ck < T / 256; ck += G) {
        __syncthreads();
        if (tid < 32) { int t = 0, b = 0; for (int k = 0; k < T / 256; ++k) { const int v = cnt[k * 32 + tid]; t += v; b += (k < ck) ? v : 0; } tot[tid] = t; bef[tid] = b; }
        eb[tid] = eid[ck * 512 + tid];
        __syncthreads();
        if (tid == 0) { int s = 0; for (int e = 0; e < 32; ++e) { ps[e] = s; s += (tot[e] + 255) & ~255; } ps[32] = s; }
        __syncthreads();
        const int e = eb[tid]; int rank = 0;
        for (int j = 0; j < tid; ++j) rank += (eb[j] == e) ? 1 : 0;
        const int slot = ps[e] + bef[e] + rank;
        row_tok[slot] = (ck * 512 + tid) >> 1; slot_of[ck * 512 + tid] = slot;
        if (ck == 0) {
            int* tile_e = (int*)(ws + WS_TAB + TAB_TILEE);
            if (tid < 32) { const int t0 = ps[tid] >> 8, t1 = (ps[tid] + ((tot[tid] + 255) & ~255)) >> 8; for (int t = t0; t < t1; ++t) tile_e[t] = tid; }
            if (tid == 0) *(int*)(ws + WS_TAB + TAB_NT) = ps[32] >> 8;
        }
    }
    __syncthreads();
}
__device__ __forceinline__ void moe_gather(const Params& P, int lane, int gw, int NGW) {
    unsigned char* ws = P.ws; asm volatile("" : "+s"(ws));
    const int nslots = *(const int*)(ws + WS_TAB + TAB_NT) * 256; const int* row_tok = (const int*)(ws + WS_TAB + TAB_ROWTOK);
    const bf16* H = (const bf16*)(ws + WS_H); bf16* X = (bf16*)(ws + WS_XROWS);
    for (int s = gw; s < nslots; s += NGW) { const int t = row_tok[s];
        const v4u* sp = (const v4u*)(H + (size_t)t * D) + lane; v4u* dp = (v4u*)(X + (size_t)s * D) + lane;
        const v4u a = sp[0], b = sp[64]; dp[0] = a; dp[64] = b; }
}

constexpr int R1_AW = 0, R1_AA = 4608, R1_AG = 9216, R1_LW = 17920, R1_LSTR = 1040, R1_LA = R1_LW + 32 * R1_LSTR, R1_LG = R1_LA + 32 * R1_LSTR;
__device__ __forceinline__ void rwkv_prep(const Params& P, int l, LAS unsigned char* lds, int tid, int lane, int wave, int c, int G) {
    unsigned char* ws = P.ws; asm volatile("" : "+s"(ws));
    const bf16* PR = (const bf16*)(ws + WS_PRW);
    bf16* SI = (bf16*)(ws + WS_SI); bf16* E1 = (bf16*)(ws + WS_E1); bf16* GT = (bf16*)(ws + WS_GT);
    const bf16* lot = (const bf16*)(ws + WS_LOT) + (size_t)l * 131072;
    const float* mu = (const float*)P.in[12] + l * N_RWKV;
    const float* w0 = (const float*)P.in[13] + l * MW; const float* a0 = (const float*)P.in[15] + l * MW;
    const float* k_k = (const float*)P.in[18] + l * MW; const float* k_a = (const float*)P.in[19] + l * MW; const float* r_k = (const float*)P.in[20] + l * MW;
    for (int it = c; it < NB * (SEQ / 32); it += G) {
        const int b = it / (SEQ / 32), t0 = (it % (SEQ / 32)) * 32;
        __syncthreads();
        {
            const int tok = tid >> 4, cg = tid & 15, t = t0 + tok;
            const bf16* cur = PR + ((size_t)(b * SEQ + t)) * N_RWKV + 1536 + cg * 16;
            const v4u c0 = *(const v4u*)cur, c1 = *(const v4u*)(cur + 8);
            v4u p0 = (v4u){0u, 0u, 0u, 0u}, p1 = p0;
            if (t > 0) { p0 = *(const v4u*)(cur - N_RWKV); p1 = *(const v4u*)(cur - N_RWKV + 8); }
            const float* mp = mu + 1536 + cg * 16;
            float x[16];
            const unsigned cw[8] = {c0.x, c0.y, c0.z, c0.w, c1.x, c1.y, c1.z, c1.w}, pw[8] = {p0.x, p0.y, p0.z, p0.w, p1.x, p1.y, p1.z, p1.w};
#pragma unroll
            for (int j = 0; j < 8; ++j) { const float a = bflo(cw[j]), bq = bfhi(cw[j]), pa = bflo(pw[j]), pb = bfhi(pw[j]);
                x[2 * j] = a + mp[2 * j] * (pa - a); x[2 * j + 1] = bq + mp[2 * j + 1] * (pb - bq); }
            LAS unsigned char* dst;
            if (cg < 4) {
#pragma unroll
                for (int j = 0; j < 16; ++j) { const float e = __expf(2.0f * x[j]); x[j] = 1.0f - 2.0f * __builtin_amdgcn_rcpf(e + 1.0f); }
                dst = lds + R1_AW + tok * 144 + cg * 32;
            } else if (cg < 8) { dst = lds + R1_AA + tok * 144 + (cg - 4) * 32;
            } else {
#pragma unroll
                for (int j = 0; j < 16; ++j) x[j] = sigm(x[j]);
                dst = lds + R1_AG + tok * 272 + (cg - 8) * 32;
            }
            v4u o0, o1; o0.x = pk2(x[0], x[1]); o0.y = pk2(x[2], x[3]); o0.z = pk2(x[4], x[5]); o0.w = pk2(x[6], x[7]);
            o1.x = pk2(x[8], x[9]); o1.y = pk2(x[10], x[11]); o1.z = pk2(x[12], x[13]); o1.w = pk2(x[14], x[15]);
            *(LAS v4u*)dst = o0; *(LAS v4u*)(dst + 16) = o1;
        }
        __syncthreads();
        {
            const int r = lane & 31, hh = lane >> 5;
#pragma unroll
            for (int which = 0; which < 3; ++which) {
                const int KL = (which == 2) ? 128 : 64;
                const bf16* lo = lot + (which == 0 ? 0 : which == 1 ? 32768 : 65536);
                const LAS unsigned char* at = lds + (which == 0 ? R1_AW : which == 1 ? R1_AA : R1_AG) + r * (which == 2 ? 272 : 144) + hh * 16;
                LAS unsigned char* outp = lds + (which == 0 ? R1_LW : which == 1 ? R1_LA : R1_LG);
#pragma unroll
                for (int blk = 0; blk < 2; ++blk) {
                    f32x16 acc;
#pragma unroll
                    for (int q = 0; q < 16; ++q) acc[q] = 0.f;
                    const bf16* arow = lo + (size_t)(wave * 64 + blk * 32 + r) * KL + hh * 8;
#pragma unroll
                    for (int s = 0; s < KL / 16; ++s) {
                        const bf16x8 af = *(const bf16x8*)(arow + s * 16);
                        const bf16x8 bfr = *(const LAS bf16x8*)(at + s * 32);
                        acc = __builtin_amdgcn_mfma_f32_32x32x16_bf16(af, bfr, acc, 0, 0, 0);
                    }
#pragma unroll
                    for (int q4 = 0; q4 < 4; ++q4) { v2u o; o.x = pk2(acc[4 * q4], acc[4 * q4 + 1]); o.y = pk2(acc[4 * q4 + 2], acc[4 * q4 + 3]);
                        *(LAS v2u*)(outp + r * R1_LSTR + (wave * 64 + blk * 32 + 8 * q4 + 4 * hh) * 2) = o; }
                }
            }
        }
        __syncthreads();
#pragma unroll 1
        for (int q = 0; q < 4; ++q) {
            const int tok = wave + 8 * q, t = t0 + tok, c0 = lane * 8, head = lane >> 3;
            const bf16* cur = PR + ((size_t)(b * SEQ + t)) * N_RWKV + c0;
            v4u cr = *(const v4u*)cur, ck = *(const v4u*)(cur + 512), cv = *(const v4u*)(cur + 1024);
            v4u pr = (v4u){0u, 0u, 0u, 0u}, pk = pr, pv = pr;
            if (t > 0) { pr = *(const v4u*)(cur - N_RWKV); pk = *(const v4u*)(cur - N_RWKV + 512); pv = *(const v4u*)(cur - N_RWKV + 1024); }
            const v4u lw = *(const LAS v4u*)(lds + R1_LW + tok * R1_LSTR + c0 * 2), la = *(const LAS v4u*)(lds + R1_LA + tok * R1_LSTR + c0 * 2), lg = *(const LAS v4u*)(lds + R1_LG + tok * R1_LSTR + c0 * 2);
            const unsigned crw[4] = {cr.x, cr.y, cr.z, cr.w}, ckw[4] = {ck.x, ck.y, ck.z, ck.w}, cvw[4] = {cv.x, cv.y, cv.z, cv.w};
            const unsigned prw[4] = {pr.x, pr.y, pr.z, pr.w}, pkw[4] = {pk.x, pk.y, pk.z, pk.w}, pvw[4] = {pv.x, pv.y, pv.z, pv.w};
            const unsigned lww[4] = {lw.x, lw.y, lw.z, lw.w}, law[4] = {la.x, la.y, la.z, la.w}, lgw[4] = {lg.x, lg.y, lg.z, lg.w};
            float rr[8], ww[8], kt[8], vv[8], kk[8], aa[8], gg[8];
            float skk = 0.f, bon = 0.f;
#pragma unroll
            for (int j = 0; j < 8; ++j) {
                const int ch = c0 + j; const int wi = j >> 1; const bool hi = j & 1;
                const float r_c = hi ? bfhi(crw[wi]) : bflo(crw[wi]), r_p = hi ? bfhi(prw[wi]) : bflo(prw[wi]);
                const float k_c = hi ? bfhi(ckw[wi]) : bflo(ckw[wi]), k_p = hi ? bfhi(pkw[wi]) : bflo(pkw[wi]);
                const float v_c = hi ? bfhi(cvw[wi]) : bflo(cvw[wi]), v_p = hi ? bfhi(pvw[wi]) : bflo(pvw[wi]);
                const float r = r_c + mu[ch] * (r_p - r_c), k = k_c + mu[512 + ch] * (k_p - k_c), v = v_c + mu[1024 + ch] * (v_p - v_c);
                const float lwv = hi ? bfhi(lww[wi]) : bflo(lww[wi]), lav = hi ? bfhi(law[wi]) : bflo(law[wi]), lgv = hi ? bfhi(lgw[wi]) : bflo(lgw[wi]);
                const float w = __expf(-0.6065306597126334f * sigm(w0[ch] + lwv));
                const float a = sigm(a0[ch] + lav);
                const float kkv = k * k_k[ch];
                const float ktv = k * (1.0f + (a - 1.0f) * k_a[ch]);
                skk += kkv * kkv; bon += r * ktv * r_k[ch];
                rr[j] = r; ww[j] = w; kt[j] = ktv; vv[j] = v; kk[j] = kkv; aa[j] = a; gg[j] = lgv;
            }
            skk = sum8(skk); bon = sum8(bon);
            const float inv = rsqrtf(fmaxf(skk, 1e-12f));
            bf16* so = SI + (((size_t)(b * 8 + head)) * SEQ + t) * 384 + (lane & 7) * 8;
            v4u o;
            o.x = pk2(rr[0], rr[1]); o.y = pk2(rr[2], rr[3]); o.z = pk2(rr[4], rr[5]); o.w = pk2(rr[6], rr[7]); *(v4u*)(so) = o;
            o.x = pk2(ww[0], ww[1]); o.y = pk2(ww[2], ww[3]); o.z = pk2(ww[4], ww[5]); o.w = pk2(ww[6], ww[7]); *(v4u*)(so + 64) = o;
            o.x = pk2(kt[0], kt[1]); o.y = pk2(kt[2], kt[3]); o.z = pk2(kt[4], kt[5]); o.w = pk2(kt[6], kt[7]); *(v4u*)(so + 128) = o;
            o.x = pk2(vv[0], vv[1]); o.y = pk2(vv[2], vv[3]); o.z = pk2(vv[4], vv[5]); o.w = pk2(vv[6], vv[7]); *(v4u*)(so + 192) = o;
#pragma unroll
            for (int j = 0; j < 8; ++j) { kk[j] *= inv; aa[j] *= kk[j]; }
            o.x = pk2(kk[0], kk[1]); o.y = pk2(kk[2], kk[3]); o.z = pk2(kk[4], kk[5]); o.w = pk2(kk[6], kk[7]); *(v4u*)(so + 256) = o;
            o.x = pk2(aa[0], aa[1]); o.y = pk2(aa[2], aa[3]); o.z = pk2(aa[4], aa[5]); o.w = pk2(aa[6], aa[7]); *(v4u*)(so + 320) = o;
            const size_t eo = ((size_t)(b * SEQ + t)) * MW + c0;
            o.x = pk2(bon * vv[0], bon * vv[1]); o.y = pk2(bon * vv[2], bon * vv[3]); o.z = pk2(bon * vv[4], bon * vv[5]); o.w = pk2(bon * vv[6], bon * vv[7]); *(v4u*)(E1 + eo) = o;
            o.x = pk2(gg[0], gg[1]); o.y = pk2(gg[2], gg[3]); o.z = pk2(gg[4], gg[5]); o.w = pk2(gg[6], gg[7]); *(v4u*)(GT + eo) = o;
        }
    }
    __syncthreads();
}

constexpr int SC_TB = 32, SC_STEP = 336  , SC_BUF = SC_TB * SC_STEP * 4  , SC_NBUF = 3;
__device__ __forceinline__ void sc_load(const bf16* blk, int tl, v4u (&rg)[6]) {
#pragma unroll
    for (int p = 0; p < 6; ++p) rg[p] = *(const v4u*)(blk + (size_t)(tl + 256 * p) * 8);
}
__device__ __forceinline__ void sc_store(LAS float* buf, int tl, int quarter, const v4u (&rg)[6]) {
#pragma unroll
    for (int p = 0; p < 6; ++p) {
        const int ck = tl + 256 * p, step = ck / 48, cw = ck % 48, q = cw >> 3, j0 = (cw & 7) * 8;
        int off;
        if (q == 3) { const int jj = j0 - 16 * quarter; if (jj < 0 || jj >= 16) continue; off = 320 + jj; }
        else { const int slot = (q == 0) ? 4 : (q == 1) ? 1 : (q == 2) ? 3 : (q == 4) ? 0 : 2; off = slot * 64 + j0; }
        LAS float* d = buf + step * SC_STEP + off;
        const v4u w = rg[p];
        *(LAS f32x4*)d = (f32x4){bflo(w.x), bfhi(w.x), bflo(w.y), bfhi(w.y)};
        *(LAS f32x4*)(d + 4) = (f32x4){bflo(w.z), bfhi(w.z), bflo(w.w), bfhi(w.w)};
    }
}
__device__ __forceinline__ void rwkv_scan(const Params& P, LAS unsigned char* lds, int tid, int lane, int wave, int c, int G) {
    unsigned char* ws = P.ws; asm volatile("" : "+s"(ws));
    const bf16* SI = (const bf16*)(ws + WS_SI); bf16* O = (bf16*)(ws + WS_YRWKV);
    constexpr int NBLK = SEQ / SC_TB;
    for (int it = c; it < 256; it += G) {
        const int x = it & 7, y = it >> 3, bh = x * 8 + (y >> 2), quarter = y & 3;
        const bf16* sib = SI + (size_t)bh * SEQ * 384;
        const int b = bh >> 3, h = bh & 7;
        __syncthreads();
        if (wave >= 4) {
            const int tl = tid - 256; v4u rg[6];
            sc_load(sib, tl, rg); sc_store((LAS float*)(lds), tl, quarter, rg);
            sc_load(sib + (size_t)SC_TB * 384, tl, rg); sc_store((LAS float*)(lds + SC_BUF), tl, quarter, rg);
            sc_load(sib + (size_t)2 * SC_TB * 384, tl, rg);
            __syncthreads();
            for (int n = 0; n < NBLK; ++n) {
                if (n + 2 < NBLK) { sc_store((LAS float*)(lds + ((n + 2) % SC_NBUF) * SC_BUF), tl, quarter, rg);
                    if (n + 3 < NBLK) sc_load(sib + (size_t)(n + 3) * SC_TB * 384, tl, rg); }
                __syncthreads();
            }
        } else {
            const int kq = lane & 15, rg_ = lane >> 4, row = quarter * 16 + wave * 4 + rg_;
            float s0 = 0.f, s1 = 0.f, s2 = 0.f, s3 = 0.f, yk = 0.f;
            __syncthreads();
            for (int n = 0; n < NBLK; ++n) {
                const LAS float* buf = (const LAS float*)(lds + (n % SC_NBUF) * SC_BUF);
#pragma unroll 4
                for (int st = 0; st < SC_TB; ++st) {
                    const LAS float* sp = buf + st * SC_STEP;
                    const f32x4 kh = *(const LAS f32x4*)(sp + 4 * kq), w = *(const LAS f32x4*)(sp + 64 + 4 * kq), bb = *(const LAS f32x4*)(sp + 128 + 4 * kq);
                    const f32x4 kt = *(const LAS f32x4*)(sp + 192 + 4 * kq), r = *(const LAS f32x4*)(sp + 256 + 4 * kq);
                    const float v = sp[320 + wave * 4 + rg_];
                    float sk = (s0 * kh[0] + s1 * kh[1]) + (s2 * kh[2] + s3 * kh[3]);
                    sk = sum16(sk);
                    s0 = s0 * w[0] + (v * kt[0] - sk * bb[0]); s1 = s1 * w[1] + (v * kt[1] - sk * bb[1]);
                    s2 = s2 * w[2] + (v * kt[2] - sk * bb[2]); s3 = s3 * w[3] + (v * kt[3] - sk * bb[3]);
                    float y = (s0 * r[0] + s1 * r[1]) + (s2 * r[2] + s3 * r[3]);
                    y = sum16(y);
                    yk = ((st & 15) == kq) ? y : yk;
                    if ((st & 15) == 15) {
                        const int t = n * SC_TB + (st & 16) + kq;
                        O[((size_t)(b * SEQ + t)) * MW + h * 64 + row] = (bf16)(pk2(yk, 0.f) & 0xffffu);
                    }
                }
                __syncthreads();
            }
        }
    }
    __syncthreads();
}

__device__ __forceinline__ void rwkv_post(const Params& P, int l, int tid, int c, int G) {
    unsigned char* ws = P.ws; asm volatile("" : "+s"(ws));
    bf16* O = (bf16*)(ws + WS_YRWKV); const bf16* E1 = (const bf16*)(ws + WS_E1); const bf16* GT = (const bf16*)(ws + WS_GT);
    const float* gn = (const float*)P.in[21] + l * MW;
    for (size_t i = (size_t)c * NTHR + tid; i < (size_t)T * 64; i += (size_t)G * NTHR) {
        const int c0 = (int)(i & 63) * 8; const size_t off = (i >> 6) * MW + c0;
        const v4u ov = *(const v4u*)(O + off), ev = *(const v4u*)(E1 + off), gv = *(const v4u*)(GT + off);
        float o[8] = {bflo(ov.x), bfhi(ov.x), bflo(ov.y), bfhi(ov.y), bflo(ov.z), bfhi(ov.z), bflo(ov.w), bfhi(ov.w)};
        const float e[8] = {bflo(ev.x), bfhi(ev.x), bflo(ev.y), bfhi(ev.y), bflo(ev.z), bfhi(ev.z), bflo(ev.w), bfhi(ev.w)};
        const float g[8] = {bflo(gv.x), bfhi(gv.x), bflo(gv.y), bfhi(gv.y), bflo(gv.z), bfhi(gv.z), bflo(gv.w), bfhi(gv.w)};
        float s = 0.f;
#pragma unroll
        for (int j = 0; j < 8; ++j) s += o[j];
        const float mean = sum8(s) * (1.0f / 64.0f);
        float q = 0.f;
#pragma unroll
        for (int j = 0; j < 8; ++j) { o[j] -= mean; q += o[j] * o[j]; }
        const float rstd = rsqrtf(sum8(q) * (1.0f / 64.0f) + 64e-5f);
#pragma unroll
        for (int j = 0; j < 8; ++j) o[j] = (o[j] * rstd * gn[c0 + j] + e[j]) * g[j];
        v4u w; w.x = pk2(o[0], o[1]); w.y = pk2(o[2], o[3]); w.z = pk2(o[4], o[5]); w.w = pk2(o[6], o[7]);
        *(v4u*)(O + off) = w;
    }
}

constexpr int RT_STR = 272;
constexpr int RT_TILE = 128 * RT_STR;
__device__ __forceinline__ float ret_log2gamma(int h) { return __log2f(1.0f - exp2f(-5.0f - (float)h)); }
__device__ __forceinline__ void rot8(const v4u a, const v4u b, float pos, int d0, float scale, float (&o1)[8], float (&o2)[8]) {
    const unsigned aw[4] = {a.x, a.y, a.z, a.w}, bw[4] = {b.x, b.y, b.z, b.w};
#pragma unroll
    for (int j = 0; j < 8; ++j) {
        const float f = exp2f(-(float)(d0 + j) * (13.287712379549449f / 64.0f)) * 0.15915494309189535f;
        float rev = pos * f; rev = rev - floorf(rev);
        const float sn = __builtin_amdgcn_sinf(rev), cs = __builtin_amdgcn_cosf(rev);
        const float x1 = (j & 1) ? bfhi(aw[j >> 1]) : bflo(aw[j >> 1]), x2 = (j & 1) ? bfhi(bw[j >> 1]) : bflo(bw[j >> 1]);
        o1[j] = (x1 * cs - x2 * sn) * scale; o2[j] = (x1 * sn + x2 * cs) * scale;
    }
}
__device__ __forceinline__ void ret_stage_rot(const bf16* src  , const int* pos, float scale, LAS unsigned char* dst, int tid) {
#pragma unroll 1
    for (int p = tid; p < 1024; p += NTHR) { const int j = p >> 3, d0 = (p & 7) * 8;
        const bf16* rp = src + (size_t)j * N_REST + d0;
        const v4u a = *(const v4u*)rp, b = *(const v4u*)(rp + 64);
        float o1[8], o2[8]; rot8(a, b, (float)pos[j], d0, scale, o1, o2);
        v4u w1, w2; w1.x = pk2(o1[0], o1[1]); w1.y = pk2(o1[2], o1[3]); w1.z = pk2(o1[4], o1[5]); w1.w = pk2(o1[6], o1[7]);
        w2.x = pk2(o2[0], o2[1]); w2.y = pk2(o2[2], o2[3]); w2.z = pk2(o2[4], o2[5]); w2.w = pk2(o2[6], o2[7]);
        *(LAS v4u*)(dst + j * RT_STR + d0 * 2) = w1; *(LAS v4u*)(dst + j * RT_STR + (64 + d0) * 2) = w2; }
}
__device__ __forceinline__ void ret_stage_vt(const bf16* src, LAS unsigned char* dst, int tid) {
#pragma unroll 1
    for (int p = tid; p < 2048; p += NTHR) { const int j = p & 127, v0 = (p >> 7) * 8;
        const v4u a = *(const v4u*)(src + (size_t)j * N_REST + v0);
        const unsigned aw[4] = {a.x, a.y, a.z, a.w};
#pragma unroll
        for (int i = 0; i < 8; ++i) *(LAS bf16*)(dst + (v0 + i) * RT_STR + j * 2) = (bf16)((i & 1) ? (aw[i >> 1] >> 16) : (aw[i >> 1] & 0xffffu)); }
}
__device__ __forceinline__ void ret_kv(const Params& P, int half, LAS unsigned char* lds, int tid, int lane, int wave, int c, int G) {
    unsigned char* ws = P.ws; asm volatile("" : "+s"(ws));
    const bf16* PR = (const bf16*)(ws + WS_PREST); float* KV = (float*)(ws + WS_KV);
    const int* positions = (const int*)P.in[2];
    LAS unsigned char* KT = lds; LAS unsigned char* VT = lds + RT_TILE;
    for (int it = c; it < 1024; it += G) {
        const int bl = it >> 8, h = (it >> 6) & 3, ch = it & 63;
        const size_t row0 = (size_t)bl * SEQ + ch * 128;
        const int* pos = positions + (size_t)(half * 4 + bl) * SEQ + ch * 128;
        const float l2g = ret_log2gamma(h);
        __syncthreads();
#pragma unroll 1
        for (int p = tid; p < 1024; p += NTHR) { const int j = p & 127, d0 = (p >> 7) * 8;
            const bf16* rp = PR + (row0 + j) * N_REST + 512 + h * 128 + d0;
            const v4u a = *(const v4u*)rp, b = *(const v4u*)(rp + 64);
            float o1[8], o2[8]; rot8(a, b, (float)pos[j], d0, 0.08838834764831845f * exp2f(l2g * (float)(127 - j)), o1, o2);
#pragma unroll
            for (int i = 0; i < 8; ++i) { *(LAS bf16*)(KT + (d0 + i) * RT_STR + j * 2) = (bf16)(pk2(o1[i], 0.f) & 0xffffu); *(LAS bf16*)(KT + (64 + d0 + i) * RT_STR + j * 2) = (bf16)(pk2(o2[i], 0.f) & 0xffffu); } }
        ret_stage_vt(PR + row0 * N_REST + 1024 + h * 128, VT, tid);
        __syncthreads();
        const int fr = lane & 15, g = lane >> 4;
        bf16x8 af[4];
#pragma unroll
        for (int s = 0; s < 4; ++s) af[s] = *(const LAS bf16x8*)(VT + (wave * 16 + fr) * RT_STR + (32 * s + 8 * g) * 2);
        float* kvo = KV + (size_t)it * 16384 + (size_t)(wave * 16 + 4 * g) * 128 + fr;
#pragma unroll
        for (int db = 0; db < 8; ++db) {
            f32x4 acc = (f32x4){0.f, 0.f, 0.f, 0.f};
#pragma unroll
            for (int s = 0; s < 4; ++s) { const bf16x8 bfr = *(const LAS bf16x8*)(KT + (db * 16 + fr) * RT_STR + (32 * s + 8 * g) * 2);
                acc = __builtin_amdgcn_mfma_f32_16x16x32_bf16(af[s], bfr, acc, 0, 0, 0); }
#pragma unroll
            for (int r = 0; r < 4; ++r) kvo[r * 128 + db * 16] = acc[r];
        }
    }
    __syncthreads();
}
__device__ __forceinline__ void ret_state(const Params& P, int tid, int c, int G) {
    unsigned char* ws = P.ws; asm volatile("" : "+s"(ws));
    const float* KV = (const float*)(ws + WS_KV); bf16* SST = (bf16*)(ws + WS_SST);
    for (int gid = c * NTHR + tid; gid < 16 * 8192; gid += G * NTHR) {
        const int chain = gid >> 13, e = (gid & 8191) * 2, h = chain & 3;
        const float dc = exp2f(128.0f * ret_log2gamma(h));
        float s0 = 0.f, s1 = 0.f;
#pragma unroll 8
        for (int ch = 0; ch < 64; ++ch) {
            const size_t off = ((size_t)chain * 64 + ch) * 16384 + e;
            *(unsigned*)(SST + off) = pk2(s0, s1);
            const float2 kv = *(const float2*)(KV + off);
            s0 = s0 * dc + kv.x; s1 = s1 * dc + kv.y;
        }
    }
}
__device__ __forceinline__ void ret_out(const Params& P, int l, int half, LAS unsigned char* lds, int tid, int lane, int wave, int c, int G) {
    unsigned char* ws = P.ws; asm volatile("" : "+s"(ws));
    const bf16* PR = (const bf16*)(ws + WS_PREST); const bf16* SST = (const bf16*)(ws + WS_SST); bf16* YR = (bf16*)(ws + WS_YRET);
    const int* positions = (const int*)P.in[2];
    const float* gn = (const float*)P.in[11] + l * MW;
    LAS unsigned char* QL = lds; LAS unsigned char* KL = lds + RT_TILE; LAS unsigned char* VT = lds + 2 * RT_TILE; LAS unsigned char* ST = lds + 3 * RT_TILE;
    for (int it = c; it < 1024; it += G) {
        const int bl = it >> 8, h = (it >> 6) & 3, ch = it & 63;
        const size_t row0 = (size_t)bl * SEQ + ch * 128;
        const int* pos = positions + (size_t)(half * 4 + bl) * SEQ + ch * 128;
        const float l2g = ret_log2gamma(h);
        __syncthreads();
        ret_stage_rot(PR + row0 * N_REST + h * 128, pos, 1.0f, QL, tid);
        ret_stage_rot(PR + row0 * N_REST + 512 + h * 128, pos, 0.08838834764831845f, KL, tid);
        ret_stage_vt(PR + row0 * N_REST + 1024 + h * 128, VT, tid);
#pragma unroll 1
        for (int p = tid; p < 2048; p += NTHR) { const int v = p >> 4, d0 = (p & 15) * 8;
            *(LAS v4u*)(ST + v * RT_STR + d0 * 2) = *(const v4u*)(SST + (size_t)it * 16384 + v * 128 + d0); }
        __syncthreads();
        const int fr = lane & 15, g = lane >> 4;
        bf16x8 qf[4];
#pragma unroll
        for (int s = 0; s < 4; ++s) qf[s] = *(const LAS bf16x8*)(QL + (wave * 16 + fr) * RT_STR + (32 * s + 8 * g) * 2);
        f32x4 acc[8];
#pragma unroll
        for (int vb = 0; vb < 8; ++vb) { acc[vb] = (f32x4){0.f, 0.f, 0.f, 0.f};
#pragma unroll
            for (int s = 0; s < 4; ++s) { const bf16x8 a = *(const LAS bf16x8*)(ST + (vb * 16 + fr) * RT_STR + (32 * s + 8 * g) * 2);
                acc[vb] = __builtin_amdgcn_mfma_f32_16x16x32_bf16(a, qf[s], acc[vb], 0, 0, 0); } }
        const int il = wave * 16 + fr;
        const float xi = exp2f(l2g * (float)(il + 1));
#pragma unroll
        for (int vb = 0; vb < 8; ++vb) acc[vb] *= xi;
        for (int s2 = 0; s2 <= (wave >> 1); ++s2) {
            f32x4 p0 = (f32x4){0.f, 0.f, 0.f, 0.f}, p1 = p0;
            const int jb0 = 2 * s2, jb1 = 2 * s2 + 1;
#pragma unroll
            for (int s = 0; s < 4; ++s) { const bf16x8 a = *(const LAS bf16x8*)(KL + (jb0 * 16 + fr) * RT_STR + (32 * s + 8 * g) * 2);
                p0 = __builtin_amdgcn_mfma_f32_16x16x32_bf16(a, qf[s], p0, 0, 0, 0); }
            if (jb1 <= wave) {
#pragma unroll
                for (int s = 0; s < 4; ++s) { const bf16x8 a = *(const LAS bf16x8*)(KL + (jb1 * 16 + fr) * RT_STR + (32 * s + 8 * g) * 2);
                    p1 = __builtin_amdgcn_mfma_f32_16x16x32_bf16(a, qf[s], p1, 0, 0, 0); }
            }
#pragma unroll
            for (int r = 0; r < 4; ++r) { const int d0 = il - (jb0 * 16 + 4 * g + r), d1 = il - (jb1 * 16 + 4 * g + r);
                p0[r] = d0 >= 0 ? p0[r] * exp2f(l2g * (float)d0) : 0.f; p1[r] = d1 >= 0 ? p1[r] * exp2f(l2g * (float)d1) : 0.f; }
            v4u pw; pw.x = pk2(p0[0], p0[1]); pw.y = pk2(p0[2], p0[3]); pw.z = pk2(p1[0], p1[1]); pw.w = pk2(p1[2], p1[3]);
            const bf16x8 pf = __builtin_bit_cast(bf16x8, pw);
#pragma unroll
            for (int vb = 0; vb < 8; ++vb) {
                const LAS unsigned char* vp = VT + (vb * 16 + fr) * RT_STR + (32 * s2 + 4 * g) * 2;
                const v2u lo = *(const LAS v2u*)vp, hi = *(const LAS v2u*)(vp + 32);
                const v4u aw = (v4u){lo.x, lo.y, hi.x, hi.y};
                acc[vb] = __builtin_amdgcn_mfma_f32_16x16x32_bf16(__builtin_bit_cast(bf16x8, aw), pf, acc[vb], 0, 0, 0);
            }
        }
        float s = 0.f;
#pragma unroll
        for (int vb = 0; vb < 8; ++vb) s += (acc[vb][0] + acc[vb][1]) + (acc[vb][2] + acc[vb][3]);
        s += __shfl_xor(s, 16); s += __shfl_xor(s, 32);
        const float mean = s * (1.0f / 128.0f);
        float q = 0.f;
#pragma unroll
        for (int vb = 0; vb < 8; ++vb) { acc[vb] -= mean; q += (acc[vb][0] * acc[vb][0] + acc[vb][1] * acc[vb][1]) + (acc[vb][2] * acc[vb][2] + acc[vb][3] * acc[vb][3]); }
        q += __shfl_xor(q, 16); q += __shfl_xor(q, 32);
        const float rstd = rsqrtf(q * (1.0f / 128.0f) + 1e-5f);
        const bf16* gp = PR + (row0 + il) * N_REST + 1536 + h * 128 + 4 * g;
        bf16* yp = YR + (row0 + il) * MW + h * 128 + 4 * g;
        const float* gnp = gn + h * 128 + 4 * g;
#pragma unroll
        for (int vb = 0; vb < 8; ++vb) { const v2u gv = *(const v2u*)(gp + vb * 16); const f32x4 gm = *(const f32x4*)(gnp + vb * 16);
            const float g0 = bflo(gv.x), g1 = bfhi(gv.x), g2 = bflo(gv.y), g3 = bfhi(gv.y);
            const float y0 = acc[vb][0] * rstd * gm[0] * (g0 * sigm(g0)), y1 = acc[vb][1] * rstd * gm[1] * (g1 * sigm(g1));
            const float y2 = acc[vb][2] * rstd * gm[2] * (g2 * sigm(g2)), y3 = acc[vb][3] * rstd * gm[3] * (g3 * sigm(g3));
            v2u o; o.x = pk2(y0, y1); o.y = pk2(y2, y3); *(v2u*)(yp + vb * 16) = o; }
    }
    __syncthreads();
}
__device__ __forceinline__ void conv_phase(const Params& P, int l, int tid, int c, int G) {
    unsigned char* ws = P.ws; asm volatile("" : "+s"(ws));
    const bf16* PR = (const bf16*)(ws + WS_PREST); bf16* YC = (bf16*)(ws + WS_YCONV);
    const float* cw = (const float*)P.in[22] + l * 3 * MW;
    for (size_t i = (size_t)c * NTHR + tid; i < (size_t)HT * 64; i += (size_t)G * NTHR) {
        const int c0 = (int)(i & 63) * 8; const size_t row = i >> 6; const int t = (int)(row & (SEQ - 1));
        const bf16* rp = PR + row * N_REST + 2048 + c0;
        float u[3][8];
#pragma unroll
        for (int k = 0; k < 3; ++k) {
            if (t - 2 + k >= 0) { const bf16* q = rp - (size_t)(2 - k) * N_REST; const v4u hv = *(const v4u*)q, cv = *(const v4u*)(q + 1024);
                u[k][0] = bflo(hv.x) * bflo(cv.x); u[k][1] = bfhi(hv.x) * bfhi(cv.x); u[k][2] = bflo(hv.y) * bflo(cv.y); u[k][3] = bfhi(hv.y) * bfhi(cv.y);
                u[k][4] = bflo(hv.z) * bflo(cv.z); u[k][5] = bfhi(hv.z) * bfhi(cv.z); u[k][6] = bflo(hv.w) * bflo(cv.w); u[k][7] = bfhi(hv.w) * bfhi(cv.w);
            } else {
#pragma unroll
                for (int j = 0; j < 8; ++j) u[k][j] = 0.f; }
        }
        const v4u bv = *(const v4u*)(rp + 512);
        const float bg[8] = {bflo(bv.x), bfhi(bv.x), bflo(bv.y), bfhi(bv.y), bflo(bv.z), bfhi(bv.z), bflo(bv.w), bfhi(bv.w)};
        float y[8];
#pragma unroll
        for (int j = 0; j < 8; ++j) y[j] = bg[j] * (cw[c0 + j] * u[0][j] + cw[MW + c0 + j] * u[1][j] + cw[2 * MW + c0 + j] * u[2][j]);
        v4u o; o.x = pk2(y[0], y[1]); o.y = pk2(y[2], y[3]); o.z = pk2(y[4], y[5]); o.w = pk2(y[6], y[7]);
        *(v4u*)(YC + row * MW + c0) = o;
    }
}

#ifndef MK_MULTI
#define MK_MULTI 0
#endif
#ifndef ONLYMASK
#define ONLYMASK 0x1ffff
#endif
#define EN(k) (((ONLYMASK) >> (k)) & 1)
constexpr int N_PHASES = 1 + NL * (4 + 2 * 6 + 5) + 1;

__global__ void __launch_bounds__(NTHR, 2) fwd_kernel(Params P) {
    extern __shared__ __attribute__((aligned(16))) unsigned char lds_raw[];
    LAS unsigned char* lds = (LAS unsigned char*)lds_raw;
    const int G0 = gridDim.x, c0 = blockIdx.x;
    unsigned char* ws0 = P.ws;
    if (threadIdx.x < 64) ((LAS unsigned*)(lds + LDS_MISC))[threadIdx.x] = 0u;
    __syncthreads();
    XcdBarrier bar = xcd_barrier_post((unsigned*)(ws0 + WS_CTL) + CW_BAR, (volatile LAS unsigned*)(lds + LDS_MISC));
    int ph = 0; const int lo = P.lo, hi = P.hi; bool run;
#define PH_BEGIN (run = (ph >= lo && ph < hi), ++ph, run)
#define PH_LOCALS int tid = threadIdx.x; asm volatile("" : "+v"(tid)); const int lane = tid & 63, wave = __builtin_amdgcn_readfirstlane(tid >> 6); \
    int G = G0, c = c0; asm volatile("" : "+s"(G), "+s"(c)); const int gw = c * NWAVES + wave, NGW = G * NWAVES; unsigned char* ws = ws0; asm volatile("" : "+s"(ws)); (void)lane; (void)gw; (void)NGW; (void)ws;
#define PH_END do { if (run && ph < hi) xcd_barrier(bar); } while (0)

    if (PH_BEGIN) if constexpr (EN(0)) { PH_LOCALS p0_mixer_weights(P, (LAS float*)(lds + wave * 8448), lane, gw, NGW); p0_mod(P, lds, tid, c, G); } PH_END;

    for (int l = 0; l < NL; ++l) {
        if (PH_BEGIN) if constexpr (EN(1)) { PH_LOCALS row_phase<0>(P, l, lds, tid, lane, wave, c, G); } PH_END;
        if (PH_BEGIN) if constexpr (EN(2)) { PH_LOCALS
            const bf16* wt1 = (const bf16*)(ws + WS_WT1) + (size_t)l * N1 * D;
            pg8::Gemm g{(const bf16*)(ws + WS_H), wt1, T, N_RWKV, D}; pg8::StaticOrder S; S.init(T, N_RWKV, G, c);
            pg8::EpiPlain E{(bf16*)(ws + WS_PRW), N_RWKV, N_RWKV / 256};
            pg8::gemm_phase<pg8::EpiPlain, pg8::StaticOrder>(lds, g, S, E, nullptr);
        } PH_END;
        if (PH_BEGIN) if constexpr (EN(3)) { PH_LOCALS rwkv_prep(P, l, lds, tid, lane, wave, c, G); } PH_END;
        if (PH_BEGIN) if constexpr (EN(4)) { PH_LOCALS rwkv_scan(P, lds, tid, lane, wave, c, G); } PH_END;

        for (int half = 0; half < 2; ++half) {
            if (PH_BEGIN) if constexpr (EN(5)) { PH_LOCALS
                if (half == 0) rwkv_post(P, l, tid, c, G);
                const bf16* wt1 = (const bf16*)(ws + WS_WT1) + (size_t)l * N1 * D;
                pg8::Gemm g{(const bf16*)(ws + WS_H) + (size_t)half * HT * D, wt1 + (size_t)N_RWKV * D, HT, N_REST + N_GATE, D};
                pg8::StaticOrder S; S.init(HT, N_REST + N_GATE, G, c);
                pg8::EpiB2 E{(bf16*)(ws + WS_PREST), N_REST, N_REST / 256, (bf16*)(ws + WS_GATES), N_GATE, (const float*)P.in[10] + (size_t)l * N_GATE};
                pg8::gemm_phase<pg8::EpiB2, pg8::StaticOrder>(lds, g, S, E, nullptr);
            } PH_END;
            if (PH_BEGIN) if constexpr (EN(6)) { PH_LOCALS ret_kv(P, half, lds, tid, lane, wave, c, G); conv_phase(P, l, tid, c, G); } PH_END;
            if (PH_BEGIN) if constexpr (EN(7)) { PH_LOCALS ret_state(P, tid, c, G); } PH_END;
            if (PH_BEGIN) if constexpr (EN(8)) { PH_LOCALS ret_out(P, l, half, lds, tid, lane, wave, c, G); } PH_END;
            if (PH_BEGIN) if constexpr (EN(9)) { PH_LOCALS
                for (int i = 0; i < 3; ++i) {
                    const bf16* Y = (i == 0) ? (const bf16*)(ws + WS_YRET) : (i == 1) ? (const bf16*)(ws + WS_YRWKV) + (size_t)half * HT * MW : (const bf16*)(ws + WS_YCONV);
                    pg8::Gemm g{Y, (const bf16*)(ws + WS_WBR) + (size_t)(l * 3 + i) * D * MW, HT, D, MW}; pg8::StaticOrder S; S.init(HT, D, G, c);
                    pg8::EpiMerge E{(bf16*)(ws + WS_MERGED), (const bf16*)(ws + WS_GATES) + i * D, N_GATE, i == 0 ? 1 : 0};
                    pg8::gemm_phase<pg8::EpiMerge, pg8::StaticOrder>(lds, g, S, E, nullptr);
                    __builtin_amdgcn_fence(__ATOMIC_ACQUIRE, "agent"); VM_WAIT();
                    __syncthreads();
                }
            } PH_END;
            if (PH_BEGIN) if constexpr (EN(10)) { PH_LOCALS
                pg8::Gemm g{(const bf16*)(ws + WS_MERGED), (const bf16*)(ws + WS_WO) + (size_t)l * D * D, HT, D, D}; pg8::StaticOrder S; S.init(HT, D, G, c);
                const float* xin = (l == 0 ? (const float*)P.in[0] : (const float*)P.out) + (size_t)half * HT * D;
                pg8::EpiWo E{xin, P.out + (size_t)half * HT * D, (const float*)(ws + WS_MOD) + (size_t)l * NB * 6144 + 2048, 6144, half * HT, SEQ};
                pg8::gemm_phase<pg8::EpiWo, pg8::StaticOrder>(lds, g, S, E, nullptr);
            } PH_END;
        }
        if (PH_BEGIN) if constexpr (EN(11)) { PH_LOCALS row_phase<1>(P, l, lds, tid, lane, wave, c, G); p_expert_weights(P, l, (LAS float*)(lds + wave * 8448), lane, gw, NGW); } PH_END;
        if (PH_BEGIN) if constexpr (EN(12)) { PH_LOCALS moe_slots(P, lds, tid, c, G); } PH_END;
        if (PH_BEGIN) if constexpr (EN(13)) { PH_LOCALS moe_gather(P, lane, gw, NGW); } PH_END;
        if (PH_BEGIN) if constexpr (EN(14)) { PH_LOCALS
            pg8::Gemm g{(const bf16*)(ws + WS_XROWS), (const bf16*)(ws + WS_WGU), 0, 0, D};
            pg8::MoeOrder S{(const int*)(ws + WS_TAB + TAB_TILEE), *(const int*)(ws + WS_TAB + TAB_NT), G, c};
            pg8::EpiGLU E{(bf16*)(ws + WS_GB)};
            pg8::gemm_phase<pg8::EpiGLU, pg8::MoeOrder>(lds, g, S, E, nullptr);
        } PH_END;
        if (PH_BEGIN) if constexpr (EN(15)) { PH_LOCALS
            pg8::Gemm g{(const bf16*)(ws + WS_GB), (const bf16*)(ws + WS_WD), 0, 0, MW};
            pg8::MoeOrder S{(const int*)(ws + WS_TAB + TAB_TILEE), *(const int*)(ws + WS_TAB + TAB_NT), G, c};
            pg8::EpiPlain E{(bf16*)(ws + WS_YM), D, 4};
            pg8::gemm_phase<pg8::EpiPlain, pg8::MoeOrder>(lds, g, S, E, nullptr);
        } PH_END;
    }
    if (PH_BEGIN) if constexpr (EN(16)) { PH_LOCALS row_phase<2>(P, 0, lds, tid, lane, wave, c, G); }
}

#ifdef DBG_SRC
#ifndef DBG_N
#define DBG_N (T * D)
#endif
__global__ void dbg_dump(const unsigned short* src, float* out) {
    for (size_t i = (size_t)blockIdx.x * blockDim.x + threadIdx.x; i < (size_t)T * D; i += (size_t)gridDim.x * blockDim.x) { float v = 0.f; if (i < (size_t)(DBG_N)) { v = __uint_as_float(((unsigned)src[i]) << 16); v = (v - v == 0.f) ? v : 10000.0f; } out[i] = v; }
}
#endif
extern "C" void kernel_launch(void* const* d_in, const int* in_sizes, int n_in, void* d_out, int out_size, void* d_ws, size_t ws_size, hipStream_t stream) {
    static int grid = 0;
    if (grid == 0) {
        if (n_in != 32 || out_size != T * D || ws_size < WS_END) { fprintf(stderr, "kernel_launch: unexpected problem (n_in %d out %d ws %zu)\n", n_in, out_size, ws_size); grid = -1; return; }
        int dev = 0, cus = 0, per_cu = 0;
        if (hipGetDevice(&dev) != hipSuccess || hipDeviceGetAttribute(&cus, hipDeviceAttributeMultiprocessorCount, dev) != hipSuccess) { grid = -1; return; }
        if (hipFuncSetAttribute((const void*)fwd_kernel, hipFuncAttributeMaxDynamicSharedMemorySize, LDS_BYTES) != hipSuccess) { fprintf(stderr, "kernel_launch: hipFuncSetAttribute failed\n"); grid = -1; return; }
        if (hipOccupancyMaxActiveBlocksPerMultiprocessor(&per_cu, (const void*)fwd_kernel, NTHR, LDS_BYTES) != hipSuccess || per_cu < 1) { fprintf(stderr, "kernel_launch: occupancy query says %d\n", per_cu); }
        grid = cus > 0 ? cus : 256;
    }
    if (grid < 0) return;
    if (hipMemsetAsync((char*)d_ws + WS_CTL, 0, CTL_ZERO_BYTES, stream) != hipSuccess) return;
    Params p{};
    for (int i = 0; i < 32; ++i) p.in[i] = d_in[i];
    p.out = (float*)d_out; p.ws = (unsigned char*)d_ws;
#if MK_MULTI
    for (int ph = 0; ph < N_PHASES; ++ph) { p.lo = ph; p.hi = ph + 1; hipLaunchKernelGGL(fwd_kernel, dim3(grid), dim3(NTHR), LDS_BYTES, stream, p); }
#else
    p.lo = 0; p.hi = N_PHASES;
#ifdef DBG_STOP
    p.hi = DBG_STOP;
#endif
#ifdef DBG_SPLIT
    p.hi = DBG_SPLIT;
    hipLaunchKernelGGL(fwd_kernel, dim3(grid), dim3(NTHR), LDS_BYTES, stream, p);
    hipMemsetAsync((char*)d_ws + WS_CTL, 0, 65536, stream);
    p.lo = DBG_SPLIT; p.hi = DBG_STOP;
#endif
    hipLaunchKernelGGL(fwd_kernel, dim3(grid), dim3(NTHR), LDS_BYTES, stream, p);
#ifdef DBG_SRC
    hipLaunchKernelGGL(dbg_dump, dim3(2048), dim3(256), 0, stream, (const unsigned short*)((const char*)d_ws + (size_t)(DBG_SRC) * MiB), (float*)d_out);
#endif
#endif
}
```

```cpp
#include <hip/hip_runtime.h>
#include <cstdio>
#include <cstdint>
#include <type_traits>
namespace pg8 {
#define PG8_LAS __attribute__((address_space(3)))
typedef unsigned short bf16_t;
typedef short bf16x8 __attribute__((ext_vector_type(8)));
typedef float f32x4 __attribute__((ext_vector_type(4)));
typedef unsigned u32x4 __attribute__((ext_vector_type(4)));
constexpr int BM = 256, BK = 64, HALF = 128, HTB = HALF * BK * 2  , STAGE_BYTES = 8 * HTB, NXCD = 8, WGM = 8;

__host__ __device__ __forceinline__ int lds_byte(int r, int c) { const int st = (r >> 4) * 2 + (c >> 5), rr = r & 15, cc = c & 31, ob = rr * 64 + cc * 2; return st * 1024 + (ob ^ (((ob >> 9) & 1) << 5)); }
__host__ __device__ __forceinline__ void stage_rc(int b, int& R, int& C) { const int st = b / 1024, sb = b % 1024, swz = sb ^ (((sb >> 9) & 1) << 5); R = (st >> 1) * 16 + swz / 64; C = (st & 1) * 32 + (swz % 64) / 2; }
__host__ __device__ __forceinline__ int perm32(int rho) { const int n = rho >> 4, i = rho & 15; return 8 * (i >> 2) + 4 * n + (i & 3); }

struct Unit { int pm, pn; };
struct Gemm { const bf16_t* A; const bf16_t* Bt; int M, N, K; };

struct StaticOrder {
    static constexpr bool GATHER = false;
    int nM, nN, nwg, G, c;
    __host__ __device__ void init(int M, int N, int G_, int c_) { nM = M / BM; nN = N / BM; nwg = nM * nN; G = G_; c = c_; }
    __host__ __device__ bool next(int i, Unit& u) const {
        const long L = (long)i * G + c; if (L >= nwg) return false;
        int wgid = (int)L; { const int q = nwg / NXCD, r = nwg % NXCD, xcd = wgid % NXCD, off = wgid / NXCD; wgid = (xcd < r ? xcd * (q + 1) : r * (q + 1) + (xcd - r) * q) + off; }
        const int nig = WGM * nN, gid = wgid / nig, fm = gid * WGM, gsz = (nM - fm) < WGM ? (nM - fm) : WGM;
        u.pm = fm + ((wgid % nig) % gsz); u.pn = (wgid % nig) / gsz; return true;
    }
    __device__ __forceinline__ void a_ready(const Unit&) const {}
    __device__ __forceinline__ void done(const Unit&) const {}
    __device__ __forceinline__ const char* baseA(const Gemm& g, const Unit& u, size_t tstep) const { return (const char*)g.A + (size_t)u.pm * tstep; }
    __device__ __forceinline__ const char* baseB(const Gemm& g, const Unit& u, size_t tstep) const { return (const char*)g.Bt + (size_t)u.pn * tstep; }
};
typedef __bf16 bf16v2_t __attribute__((ext_vector_type(2)));
typedef float f32v2_t __attribute__((ext_vector_type(2)));
__device__ __forceinline__ unsigned cvt_pk_bf16(float lo, float hi) { const f32v2_t v = {lo, hi}; return __builtin_bit_cast(unsigned, __builtin_convertvector(v, bf16v2_t)); }
__device__ __forceinline__ float bflo(unsigned u) { return __uint_as_float(u << 16); }
__device__ __forceinline__ float bfhi(unsigned u) { return __uint_as_float(u & 0xffff0000u); }
__device__ __forceinline__ float sigmoidf_(float x) { return __builtin_amdgcn_rcpf(1.0f + __expf(-x)); }

struct EpiPlain {
    static constexpr bool PERM = true, AFTER_DRAIN = false, PREF = false;
    bf16_t* O; int ldc; int ntn;
    __device__ __forceinline__ void operator()(const f32x4 (&acc)[2][2][4][2], const Unit& u, int wr, int wc, int fr, int fq) const {
        const int row0 = u.pm * BM + wr * 64 + fr; const int col0 = (u.pn % ntn) * BM + wc * 32 + 8 * fq;
#pragma unroll
        for (int ai = 0; ai < 2; ++ai)
#pragma unroll
            for (int m = 0; m < 4; ++m) { bf16_t* rowp = O + (size_t)(row0 + ai * HALF + m * 16) * ldc + col0;
#pragma unroll
                for (int bj = 0; bj < 2; ++bj) { const f32x4 v0 = acc[ai][bj][m][0], v1 = acc[ai][bj][m][1];
                    u32x4 w; w.x = cvt_pk_bf16(v0[0], v0[1]); w.y = cvt_pk_bf16(v0[2], v0[3]); w.z = cvt_pk_bf16(v1[0], v1[1]); w.w = cvt_pk_bf16(v1[2], v1[3]);
                    *(u32x4*)(rowp + bj * HALF) = w; } }
    }
};
struct EpiB2 {
    static constexpr bool PERM = true, AFTER_DRAIN = false, PREF = false;
    bf16_t* P; int ldp; int npl; bf16_t* Gt; int ldg; const float* bias;
    __device__ __forceinline__ void operator()(const f32x4 (&acc)[2][2][4][2], const Unit& u, int wr, int wc, int fr, int fq) const {
        const int row0 = u.pm * BM + wr * 64 + fr;
        if (u.pn < npl) {
            const int col0 = u.pn * BM + wc * 32 + 8 * fq;
#pragma unroll
            for (int ai = 0; ai < 2; ++ai)
#pragma unroll
                for (int m = 0; m < 4; ++m) { bf16_t* rowp = P + (size_t)(row0 + ai * HALF + m * 16) * ldp + col0;
#pragma unroll
                    for (int bj = 0; bj < 2; ++bj) { const f32x4 v0 = acc[ai][bj][m][0], v1 = acc[ai][bj][m][1];
                        u32x4 w; w.x = cvt_pk_bf16(v0[0], v0[1]); w.y = cvt_pk_bf16(v0[2], v0[3]); w.z = cvt_pk_bf16(v1[0], v1[1]); w.w = cvt_pk_bf16(v1[2], v1[3]);
                        *(u32x4*)(rowp + bj * HALF) = w; } }
        } else {
            const int col0 = (u.pn - npl) * BM + wc * 32 + 8 * fq;
#pragma unroll
            for (int ai = 0; ai < 2; ++ai)
#pragma unroll
                for (int m = 0; m < 4; ++m) { bf16_t* rowp = Gt + (size_t)(row0 + ai * HALF + m * 16) * ldg + col0;
#pragma unroll
                    for (int bj = 0; bj < 2; ++bj) { f32x4 v0 = acc[ai][bj][m][0] + *(const f32x4*)(bias + col0 + bj * HALF), v1 = acc[ai][bj][m][1] + *(const f32x4*)(bias + col0 + bj * HALF + 4);
#pragma unroll
                        for (int j = 0; j < 4; ++j) { v0[j] = sigmoidf_(v0[j]); v1[j] = sigmoidf_(v1[j]); }
                        u32x4 w; w.x = cvt_pk_bf16(v0[0], v0[1]); w.y = cvt_pk_bf16(v0[2], v0[3]); w.z = cvt_pk_bf16(v1[0], v1[1]); w.w = cvt_pk_bf16(v1[2], v1[3]);
                        *(u32x4*)(rowp + bj * HALF) = w; } }
        }
    }
};
__device__ __forceinline__ float ubf0(unsigned x) { return (float)(x & 0xffu); }
__device__ __forceinline__ float ubf1(unsigned x) { return (float)((x >> 8) & 0xffu); }
__device__ __forceinline__ float ubf2(unsigned x) { return (float)((x >> 16) & 0xffu); }
__device__ __forceinline__ float ubf3(unsigned x) { return (float)(x >> 24); }
struct EpiMerge {
    static constexpr bool PERM = true, AFTER_DRAIN = false, PREF = false;
    bf16_t* Mg; const bf16_t* gate; int ldg; unsigned mg_bytes;
    __device__ __forceinline__ void operator()(const f32x4 (&acc)[2][2][4][2], const Unit& u, int wr, int wc, int fr, int fq) const {
        const int br = u.pn >> 2, pn = u.pn & 3;
        const int row0 = u.pm * BM + wr * 64 + fr; const int col0 = pn * BM + wc * 32 + 8 * fq;
        const unsigned char* gp = (const unsigned char*)gate + br * 1024;
        const __amdgpu_buffer_rsrc_t rs = __builtin_amdgcn_make_buffer_rsrc((void*)Mg, 0, mg_bytes, 0x00020000);
        typedef unsigned u32x2 __attribute__((ext_vector_type(2))); u32x2 g[2][4][2];
#pragma unroll
        for (int ai = 0; ai < 2; ++ai)
#pragma unroll
            for (int m = 0; m < 4; ++m)
#pragma unroll
                for (int bj = 0; bj < 2; ++bj) { const size_t r = (size_t)(row0 + ai * HALF + m * 16); g[ai][m][bj] = *(const u32x2*)(gp + r * ldg + col0 + bj * HALF); }
        asm volatile("" ::: "memory");
#pragma unroll
        for (int ai = 0; ai < 2; ++ai) {
            u32x4 o[4][2];
#pragma unroll
            for (int m = 0; m < 4; ++m)
#pragma unroll
                for (int bj = 0; bj < 2; ++bj) { const size_t r = (size_t)(row0 + ai * HALF + m * 16);
                    o[m][bj] = (br == 0) ? (u32x4){0u, 0u, 0u, 0u} : __builtin_amdgcn_raw_buffer_load_b128(rs, (unsigned)((r * 1024 + col0 + bj * HALF) * 2), 0, 16); }
            asm volatile("" ::: "memory");
#pragma unroll
            for (int m = 0; m < 4; ++m)
#pragma unroll
                for (int bj = 0; bj < 2; ++bj) { asm volatile("" : "+v"(g[ai][m][bj])); asm volatile("" : "+v"(o[m][bj])); }
#pragma unroll
            for (int m = 0; m < 4; ++m)
#pragma unroll
                for (int bj = 0; bj < 2; ++bj) { const size_t r = (size_t)(row0 + ai * HALF + m * 16);
                    f32x4 v0 = acc[ai][bj][m][0] * (1.0f / 255.0f), v1 = acc[ai][bj][m][1] * (1.0f / 255.0f); const u32x2 gg = g[ai][m][bj]; const u32x4 oo = o[m][bj];
                    v0[0] = v0[0] * ubf0(gg.x) + bflo(oo.x); v0[1] = v0[1] * ubf1(gg.x) + bfhi(oo.x); v0[2] = v0[2] * ubf2(gg.x) + bflo(oo.y); v0[3] = v0[3] * ubf3(gg.x) + bfhi(oo.y);
                    v1[0] = v1[0] * ubf0(gg.y) + bflo(oo.z); v1[1] = v1[1] * ubf1(gg.y) + bfhi(oo.z); v1[2] = v1[2] * ubf2(gg.y) + bflo(oo.w); v1[3] = v1[3] * ubf3(gg.y) + bfhi(oo.w);
                    u32x4 w; w.x = cvt_pk_bf16(v0[0], v0[1]); w.y = cvt_pk_bf16(v0[2], v0[3]); w.z = cvt_pk_bf16(v1[0], v1[1]); w.w = cvt_pk_bf16(v1[2], v1[3]);
                    *(u32x4*)(Mg + r * 1024 + col0 + bj * HALF) = w; }
        }
    }
};
struct MergeOrder {
    static constexpr bool GATHER = false;
    StaticOrder T; const bf16_t* Y0; const bf16_t* Y1; const bf16_t* Y2; const bf16_t* W;
    __device__ __forceinline__ bool next(int i, Unit& u) const { const int ti = i / 3, br = i - 3 * ti; Unit t; if (!T.next(ti, t)) return false; u.pm = t.pm; u.pn = t.pn + 4 * br; return true; }
    __device__ __forceinline__ void a_ready(const Unit&) const {}
    __device__ __forceinline__ void done(const Unit&) const {}
    __device__ __forceinline__ const char* baseA(const Gemm&, const Unit& u, size_t tstep) const { const int br = u.pn >> 2;
        unsigned long long a0 = (unsigned long long)Y0, a1 = (unsigned long long)Y1, a2 = (unsigned long long)Y2; asm volatile("" : "+s"(a0), "+s"(a1), "+s"(a2));
        const unsigned long long a = br == 0 ? a0 : br == 1 ? a1 : a2; return (const char*)a + (size_t)u.pm * tstep; }
    __device__ __forceinline__ const char* baseB(const Gemm&, const Unit& u, size_t tstep) const { return (const char*)W + (size_t)(u.pn >> 2) * (1024 * 512 * 2) + (size_t)(u.pn & 3) * tstep; }
};
struct EpiWo {
    static constexpr bool PERM = true, AFTER_DRAIN = false, PREF = false;
    const void* xin; bf16_t* xout; const float* gate1; int gstride; int row_g0; int seq; bool xf32;
    __device__ __forceinline__ void operator()(const f32x4 (&acc)[2][2][4][2], const Unit& u, int wr, int wc, int fr, int fq) const {
        const int row0 = u.pm * BM + wr * 64 + fr, col0 = u.pn * BM + wc * 32 + 8 * fq;
        const int b = (row_g0 + u.pm * BM) / seq;
        const float* g1 = gate1 + (size_t)b * gstride + col0;
        f32x4 gv[2][2];
#pragma unroll
        for (int bj = 0; bj < 2; ++bj)
#pragma unroll
            for (int n = 0; n < 2; ++n) gv[bj][n] = *(const f32x4*)(g1 + bj * HALF + n * 4);
        if (xf32) {
            const float* xf = (const float*)xin;
#pragma unroll
            for (int ai = 0; ai < 2; ++ai) {
                f32x4 xv[4][2][2];
#pragma unroll
                for (int m = 0; m < 4; ++m)
#pragma unroll
                    for (int bj = 0; bj < 2; ++bj)
#pragma unroll
                        for (int n = 0; n < 2; ++n) xv[m][bj][n] = *(const f32x4*)(xf + (size_t)(row0 + ai * HALF + m * 16) * 1024 + col0 + bj * HALF + n * 4);
                asm volatile("" ::: "memory");
#pragma unroll
                for (int m = 0; m < 4; ++m)
#pragma unroll
                    for (int bj = 0; bj < 2; ++bj) { asm volatile("" : "+v"(xv[m][bj][0])); asm volatile("" : "+v"(xv[m][bj][1])); }
#pragma unroll
                for (int m = 0; m < 4; ++m)
#pragma unroll
                    for (int bj = 0; bj < 2; ++bj) { const f32x4 v0 = xv[m][bj][0] + gv[bj][0] * acc[ai][bj][m][0], v1 = xv[m][bj][1] + gv[bj][1] * acc[ai][bj][m][1];
                        u32x4 w; w.x = cvt_pk_bf16(v0[0], v0[1]); w.y = cvt_pk_bf16(v0[2], v0[3]); w.z = cvt_pk_bf16(v1[0], v1[1]); w.w = cvt_pk_bf16(v1[2], v1[3]);
                        *(u32x4*)(xout + (size_t)(row0 + ai * HALF + m * 16) * 1024 + col0 + bj * HALF) = w; }
            }
        } else {
            const bf16_t* xb = (const bf16_t*)xin;
            u32x4 xv[2][4][2];
#pragma unroll
            for (int ai = 0; ai < 2; ++ai)
#pragma unroll
                for (int m = 0; m < 4; ++m)
#pragma unroll
                    for (int bj = 0; bj < 2; ++bj) xv[ai][m][bj] = *(const u32x4*)(xb + (size_t)(row0 + ai * HALF + m * 16) * 1024 + col0 + bj * HALF);
            asm volatile("" ::: "memory");
#pragma unroll
            for (int ai = 0; ai < 2; ++ai)
#pragma unroll
                for (int m = 0; m < 4; ++m)
#pragma unroll
                    for (int bj = 0; bj < 2; ++bj) asm volatile("" : "+v"(xv[ai][m][bj]));
#pragma unroll
            for (int ai = 0; ai < 2; ++ai)
#pragma unroll
                for (int m = 0; m < 4; ++m)
#pragma unroll
                    for (int bj = 0; bj < 2; ++bj) { const u32x4 o = xv[ai][m][bj]; f32x4 v0 = gv[bj][0] * acc[ai][bj][m][0], v1 = gv[bj][1] * acc[ai][bj][m][1];
                        v0[0] += bflo(o.x); v0[1] += bfhi(o.x); v0[2] += bflo(o.y); v0[3] += bfhi(o.y); v1[0] += bflo(o.z); v1[1] += bfhi(o.z); v1[2] += bflo(o.w); v1[3] += bfhi(o.w);
                        u32x4 w; w.x = cvt_pk_bf16(v0[0], v0[1]); w.y = cvt_pk_bf16(v0[2], v0[3]); w.z = cvt_pk_bf16(v1[0], v1[1]); w.w = cvt_pk_bf16(v1[2], v1[3]);
                        *(u32x4*)(xout + (size_t)(row0 + ai * HALF + m * 16) * 1024 + col0 + bj * HALF) = w; }
        }
    }
};
struct EpiGLU {
    static constexpr bool PERM = true, AFTER_DRAIN = false, PREF = false;
    bf16_t* Gb;
    __device__ __forceinline__ void operator()(const f32x4 (&acc)[2][2][4][2], const Unit& u, int wr, int wc, int fr, int fq) const {
        const int row0 = u.pm * BM + wr * 64 + fr; const int col0 = (u.pn & 3) * HALF + wc * 32 + 8 * fq;
#pragma unroll
        for (int ai = 0; ai < 2; ++ai)
#pragma unroll
            for (int m = 0; m < 4; ++m) { bf16_t* rowp = Gb + (size_t)(row0 + ai * HALF + m * 16) * 512 + col0;
                f32x4 v0, v1;
#pragma unroll
                for (int j = 0; j < 4; ++j) { const float g0 = acc[ai][0][m][0][j], g1 = acc[ai][0][m][1][j];
                    v0[j] = g0 * sigmoidf_(g0) * acc[ai][1][m][0][j]; v1[j] = g1 * sigmoidf_(g1) * acc[ai][1][m][1][j]; }
                u32x4 w; w.x = cvt_pk_bf16(v0[0], v0[1]); w.y = cvt_pk_bf16(v0[2], v0[3]); w.z = cvt_pk_bf16(v1[0], v1[1]); w.w = cvt_pk_bf16(v1[2], v1[3]);
                *(u32x4*)rowp = w; }
    }
};
constexpr int MOE_MAXU = 72;
struct MoeOrder {
    static constexpr bool GATHER = false;
    const PG8_LAS int* tab;
    __device__ __forceinline__ bool next(int i, Unit& u) const {
        if (i >= MOE_MAXU) return false;
        const int v = __builtin_amdgcn_readfirstlane(tab[i]); if (v < 0) return false;
        u.pm = v & 0xffff; u.pn = v >> 16; return true;
    }
    __device__ __forceinline__ void a_ready(const Unit&) const {}
    __device__ __forceinline__ void done(const Unit&) const {}
    __device__ __forceinline__ const char* baseA(const Gemm& g, const Unit& u, size_t tstep) const { return (const char*)g.A + (size_t)u.pm * tstep; }
    __device__ __forceinline__ const char* baseB(const Gemm& g, const Unit& u, size_t tstep) const { return (const char*)g.Bt + (size_t)u.pn * tstep; }
};
__device__ __forceinline__ void moe_build_units(PG8_LAS int* tab, const int* tile_start_g, int G, int c, int tid) {
    PG8_LAS int* tile_start = tab + MOE_MAXU;
    if (tid < 33) tile_start[tid] = tile_start_g[tid];
    __syncthreads();
    if (tid < MOE_MAXU) {
        const int i = tid; int v = -1;
        if ((G & 7) == 0) {
            const int xcd = c & 7, W = G >> 3, U = 4 * tile_start[32];
            const int lo = ((U * xcd) >> 3) & ~3, hi = (xcd == 7) ? U : (((U * (xcd + 1)) >> 3) & ~3);
            const int u = lo + i * W + (c >> 3);
            if (u < hi) { const int r = u >> 2; int e = 0;
#pragma unroll 1
                for (int k = 1; k < 32; ++k) e = (r >= tile_start[k]) ? k : e;
                v = r | ((e * 4 + (u & 3)) << 16); }
        } else {
            const int L = i * G + c, r = L >> 2;
            if (r < tile_start[32]) { int e = 0;
#pragma unroll 1
                for (int k = 1; k < 32; ++k) e = (r >= tile_start[k]) ? k : e;
                v = r | ((e * 4 + (L & 3)) << 16); }
        }
        tab[i] = v;
    }
}

struct EpiRouter {
    static constexpr bool PERM = false, AFTER_DRAIN = true, PREF = false;
    __device__ __forceinline__ void operator()(const f32x4 (&)[2][2][4][2], const Unit&, int, int, int, int) const {}
    __device__ __forceinline__ void fused(const f32x4 (&acc)[2][2][4][2], const Unit&, int wr, int wc, int fr, int fq, PG8_LAS unsigned char* lds, int, int) const {
        PG8_LAS float* tab = (PG8_LAS float*)lds + ((wc >= 2) ? 256 * 36 : 0);
        const int cb = 32 * (wc & 1) + 4 * fq;
#pragma unroll
        for (int ai = 0; ai < 2; ++ai)
#pragma unroll
            for (int m = 0; m < 4; ++m) { const int row = 128 * ai + 64 * wr + 16 * m + fr;
#pragma unroll
                for (int n = 0; n < 2; ++n) { const int col = cb + 16 * n;
                    if (col < 36) *(PG8_LAS f32x4*)(tab + row * 36 + col) = acc[ai][0][m][n]; } }
    }
};
struct OneUnitOrder {
    static constexpr bool GATHER = false;
    int pm;
    __device__ __forceinline__ bool next(int i, Unit& u) const { if (i != 0) return false; u.pm = pm; u.pn = 0; return true; }
    __device__ __forceinline__ void a_ready(const Unit&) const {}
    __device__ __forceinline__ void done(const Unit&) const {}
    __device__ __forceinline__ const char* baseA(const Gemm& g, const Unit& u, size_t tstep) const { return (const char*)g.A + (size_t)u.pm * tstep; }
    __device__ __forceinline__ const char* baseB(const Gemm& g, const Unit& u, size_t tstep) const { return (const char*)g.Bt + (size_t)u.pn * tstep; }
};


typedef int i32x4 __attribute__((ext_vector_type(4)));
__device__ __forceinline__ f32x4 i2f(const i32x4 v) { return __builtin_convertvector(v, f32x4); }
struct EpiPlainI8 {
    static constexpr bool PERM = true, AFTER_DRAIN = false, PREF = true;
    bf16_t* O; int ldc; const float* sa; const float* sw;
    __device__ __forceinline__ void prefetch(const Unit& u, int par, PG8_LAS unsigned char* lds, int wid, int lane) const {
        const float* src = (wid < 4) ? sa + u.pm * BM + wid * 64 + lane : sw + u.pn * BM + (wid - 4) * 64 + lane;
        __builtin_amdgcn_global_load_lds((const unsigned*)src, (PG8_LAS unsigned*)(lds + STAGE_BYTES + par * 3072 + wid * 256), 4, 0, 0);
    }
    __device__ __forceinline__ void operator()(const i32x4 (&acc)[2][2][4][2], const Unit& u, int wr, int wc, int fr, int fq, PG8_LAS unsigned char* lds, int par) const {
        const int row0 = u.pm * BM + wr * 64 + fr; const int col0 = u.pn * BM + wc * 32 + 8 * fq;
        const PG8_LAS float* sal = (const PG8_LAS float*)(lds + STAGE_BYTES + par * 3072); const PG8_LAS float* swl = sal + 256 + wc * 32 + 8 * fq;
        f32x4 s0[2], s1[2];
#pragma unroll
        for (int bj = 0; bj < 2; ++bj) { s0[bj] = *(const PG8_LAS f32x4*)(swl + bj * HALF); s1[bj] = *(const PG8_LAS f32x4*)(swl + bj * HALF + 4); }
#pragma unroll
        for (int ai = 0; ai < 2; ++ai)
#pragma unroll
            for (int m = 0; m < 4; ++m) { const int r = row0 + ai * HALF + m * 16; const float a = sal[wr * 64 + fr + ai * HALF + m * 16]; bf16_t* rowp = O + (size_t)r * ldc + col0;
#pragma unroll
                for (int bj = 0; bj < 2; ++bj) { const f32x4 v0 = i2f(acc[ai][bj][m][0]) * (s0[bj] * a), v1 = i2f(acc[ai][bj][m][1]) * (s1[bj] * a);
                    u32x4 w; w.x = cvt_pk_bf16(v0[0], v0[1]); w.y = cvt_pk_bf16(v0[2], v0[3]); w.z = cvt_pk_bf16(v1[0], v1[1]); w.w = cvt_pk_bf16(v1[2], v1[3]);
                    *(u32x4*)(rowp + bj * HALF) = w; } }
    }
};
#ifndef EPIREP
#define EPIREP 0
#endif
struct EpiB2I8 {
    static constexpr bool PERM = true, AFTER_DRAIN = false, PREF = true;
    bf16_t* P; int ldp; int npl; bf16_t* Gt; int ldg; const float* bias; const float* sa; const float* sw;
    __device__ __forceinline__ void prefetch(const Unit& u, int par, PG8_LAS unsigned char* lds, int wid, int lane) const {
        const float* src = (wid < 4) ? sa + u.pm * BM + wid * 64 + lane : sw + u.pn * BM + (wid - 4) * 64 + lane;
        __builtin_amdgcn_global_load_lds((const unsigned*)src, (PG8_LAS unsigned*)(lds + STAGE_BYTES + par * 3072 + wid * 256), 4, 0, 0);
        if (wid >= 4 && u.pn >= npl) __builtin_amdgcn_global_load_lds((const unsigned*)(bias + (u.pn - npl) * BM + (wid - 4) * 64 + lane), (PG8_LAS unsigned*)(lds + STAGE_BYTES + par * 3072 + 1024 + wid * 256), 4, 0, 0);
    }
    __device__ __forceinline__ void operator()(const i32x4 (&acc)[2][2][4][2], const Unit& u, int wr, int wc, int fr, int fq, PG8_LAS unsigned char* lds, int par) const {
      for (int rep_ = 0; rep_ < 1 + EPIREP; ++rep_) {
        asm volatile("" ::: "memory");
        const int row0 = u.pm * BM + wr * 64 + fr; const int colw = u.pn * BM + wc * 32 + 8 * fq;
        const PG8_LAS float* sal = (const PG8_LAS float*)(lds + STAGE_BYTES + par * 3072); const PG8_LAS float* swl = sal + 256 + wc * 32 + 8 * fq;
        f32x4 s0[2], s1[2];
#pragma unroll
        for (int bj = 0; bj < 2; ++bj) { s0[bj] = *(const PG8_LAS f32x4*)(swl + bj * HALF); s1[bj] = *(const PG8_LAS f32x4*)(swl + bj * HALF + 4); }
        if (u.pn < npl) {
#pragma unroll
            for (int ai = 0; ai < 2; ++ai)
#pragma unroll
                for (int m = 0; m < 4; ++m) { const int r = row0 + ai * HALF + m * 16; const float a = sal[wr * 64 + fr + ai * HALF + m * 16]; bf16_t* rowp = P + (size_t)r * ldp + colw;
#pragma unroll
                    for (int bj = 0; bj < 2; ++bj) { const f32x4 v0 = i2f(acc[ai][bj][m][0]) * (s0[bj] * a), v1 = i2f(acc[ai][bj][m][1]) * (s1[bj] * a);
                        u32x4 w; w.x = cvt_pk_bf16(v0[0], v0[1]); w.y = cvt_pk_bf16(v0[2], v0[3]); w.z = cvt_pk_bf16(v1[0], v1[1]); w.w = cvt_pk_bf16(v1[2], v1[3]);
                        *(u32x4*)(rowp + bj * HALF) = w; } }
        } else {
            const int col0 = (u.pn - npl) * BM + wc * 32 + 8 * fq; const float NL2E = -1.4426950408889634f;
            f32x4 b0[2], b1[2];
#pragma unroll
            for (int bj = 0; bj < 2; ++bj) { b0[bj] = *(const PG8_LAS f32x4*)(swl + 256 + bj * HALF) * NL2E; b1[bj] = *(const PG8_LAS f32x4*)(swl + 256 + bj * HALF + 4) * NL2E; }
#pragma unroll
            for (int ai = 0; ai < 2; ++ai)
#pragma unroll
                for (int m = 0; m < 4; ++m) { const int r = row0 + ai * HALF + m * 16; const float a = sal[wr * 64 + fr + ai * HALF + m * 16] * NL2E; unsigned char* rowp = (unsigned char*)Gt + (size_t)r * ldg + col0;
#pragma unroll
                    for (int bj = 0; bj < 2; ++bj) { f32x4 v0 = i2f(acc[ai][bj][m][0]) * (s0[bj] * a) + b0[bj], v1 = i2f(acc[ai][bj][m][1]) * (s1[bj] * a) + b1[bj];
#pragma unroll
                        for (int j = 0; j < 4; ++j) { v0[j] = __builtin_amdgcn_rcpf(__builtin_fmaf(__builtin_amdgcn_exp2f(v0[j]), 1.0f / 255.0f, 1.0f / 255.0f)); v1[j] = __builtin_amdgcn_rcpf(__builtin_fmaf(__builtin_amdgcn_exp2f(v1[j]), 1.0f / 255.0f, 1.0f / 255.0f)); }
                        typedef unsigned u32x2 __attribute__((ext_vector_type(2))); u32x2 w; w.x = 0u; w.y = 0u;
                        w.x = __builtin_amdgcn_cvt_pk_u8_f32(v0[0], 0, w.x); w.x = __builtin_amdgcn_cvt_pk_u8_f32(v0[1], 1, w.x); w.x = __builtin_amdgcn_cvt_pk_u8_f32(v0[2], 2, w.x); w.x = __builtin_amdgcn_cvt_pk_u8_f32(v0[3], 3, w.x);
                        w.y = __builtin_amdgcn_cvt_pk_u8_f32(v1[0], 0, w.y); w.y = __builtin_amdgcn_cvt_pk_u8_f32(v1[1], 1, w.y); w.y = __builtin_amdgcn_cvt_pk_u8_f32(v1[2], 2, w.y); w.y = __builtin_amdgcn_cvt_pk_u8_f32(v1[3], 3, w.y);
                        *(u32x2*)(rowp + bj * HALF) = w; } }
        }
      }
    }
};
struct EpiGLUI8 {
    static constexpr bool PERM = true, AFTER_DRAIN = false, PREF = true;
    bf16_t* Gb; const float* sa; const float* sw;
    __device__ __forceinline__ void prefetch(const Unit& u, int par, PG8_LAS unsigned char* lds, int wid, int lane) const {
        const float* src = (wid < 4) ? sa + u.pm * BM + wid * 64 + lane : sw + (size_t)(u.pn >> 2) * 1024 + (u.pn & 3) * BM + (wid - 4) * 64 + lane;
        __builtin_amdgcn_global_load_lds((const unsigned*)src, (PG8_LAS unsigned*)(lds + STAGE_BYTES + par * 3072 + wid * 256), 4, 0, 0);
    }
    __device__ __forceinline__ void operator()(const i32x4 (&acc)[2][2][4][2], const Unit& u, int wr, int wc, int fr, int fq, PG8_LAS unsigned char* lds, int par) const {
        const int row0 = u.pm * BM + wr * 64 + fr; const int col0 = (u.pn & 3) * HALF + wc * 32 + 8 * fq;
        const PG8_LAS float* sal = (const PG8_LAS float*)(lds + STAGE_BYTES + par * 3072); const PG8_LAS float* swp = sal + 256 + wc * 32 + 8 * fq;
        const f32x4 g0 = *(const PG8_LAS f32x4*)swp, g1 = *(const PG8_LAS f32x4*)(swp + 4), u0 = *(const PG8_LAS f32x4*)(swp + HALF), u1 = *(const PG8_LAS f32x4*)(swp + HALF + 4);
#pragma unroll
        for (int ai = 0; ai < 2; ++ai)
#pragma unroll
            for (int m = 0; m < 4; ++m) { const int r = row0 + ai * HALF + m * 16; const float a = sal[wr * 64 + fr + ai * HALF + m * 16]; bf16_t* rowp = Gb + (size_t)r * 512 + col0;
                const f32x4 ga = i2f(acc[ai][0][m][0]) * (g0 * a), gb = i2f(acc[ai][0][m][1]) * (g1 * a), ua = i2f(acc[ai][1][m][0]) * (u0 * a), ub = i2f(acc[ai][1][m][1]) * (u1 * a);
                f32x4 v0, v1;
#pragma unroll
                for (int j = 0; j < 4; ++j) { v0[j] = ga[j] * sigmoidf_(ga[j]) * ua[j]; v1[j] = gb[j] * sigmoidf_(gb[j]) * ub[j]; }
                u32x4 w; w.x = cvt_pk_bf16(v0[0], v0[1]); w.y = cvt_pk_bf16(v0[2], v0[3]); w.z = cvt_pk_bf16(v1[0], v1[1]); w.w = cvt_pk_bf16(v1[2], v1[3]);
                *(u32x4*)rowp = w; }
    }
};

template <class Epi, class Sched, bool STAMP = false, bool I8 = false>
__device__ __forceinline__ void gemm_phase(PG8_LAS unsigned char* lds, const Gemm g, const Sched& S, const Epi& E, unsigned long long* stamps, int tid) {
    asm volatile("" : "+v"(tid));
    const int wid = __builtin_amdgcn_readfirstlane(tid >> 6), lane = tid & 63, wr = wid >> 2, wc = wid & 3, fr = lane & 15, fq = lane >> 4;
    const int K = g.K, nt = K / BK;
    int ts_lo = 0, ts_hi = 0, nts = 0; const unsigned long long rt_entry = STAMP ? (unsigned long long)wall_clock64() : 0ull;
#define PG8_STAMP() do { if (STAMP && wid == 0 && nts < 64) { const unsigned long long _c = (unsigned long long)clock64(); \
        ts_lo = (lane == nts) ? (int)(unsigned)_c : ts_lo; ts_hi = (lane == nts) ? (int)(unsigned)(_c >> 32) : ts_hi; ++nts; } } while (0)
    PG8_STAMP();
    unsigned voffA[2], voffB[2];
#pragma unroll
    for (int i = 0; i < 2; ++i) { int R, C; stage_rc(tid * 16 + i * 8192, R, C); const int Rb = Epi::PERM ? ((R & ~31) + perm32(R & 31)) : R;
        voffA[i] = (unsigned)(R * K + C) * 2u; voffB[i] = (unsigned)(Rb * K + C) * 2u; }
    const size_t kstep = (size_t)(BK * 2);
    const size_t hstep = (size_t)HALF * K * 2;
    const size_t tstep = 2 * hstep;
    const unsigned ldsw = (unsigned)wid * 1024u;
    const int aoff = lds_byte(wr * 64 + fr, fq * 8), boff = lds_byte(wc * 32 + fr, fq * 8);
#define PG8_SA(b, h) (((b) * 2 + (h)) * HTB)
#define PG8_SB(b, h) ((4 + (b) * 2 + (h)) * HTB)
#define PG8_STAGE(bufoff, gbase, voff) do { _Pragma("unroll") for (int _i = 0; _i < 2; ++_i) \
        __builtin_amdgcn_global_load_lds((const unsigned*)((const char*)(gbase) + (voff)[_i]), (PG8_LAS unsigned*)(lds + (bufoff) + ldsw + _i * 8192), 16, 0, 0); } while (0)
#define PG8_LDA(dst, b, h) do { _Pragma("unroll") for (int m = 0; m < 4; ++m) _Pragma("unroll") for (int k = 0; k < 2; ++k) dst[m][k] = *(const PG8_LAS bf16x8*)(lds + PG8_SA(b, h) + aoff + m * 2048 + k * 1024); } while (0)
#define PG8_LDB(dst, b, h) do { _Pragma("unroll") for (int n = 0; n < 2; ++n) _Pragma("unroll") for (int k = 0; k < 2; ++k) dst[n][k] = *(const PG8_LAS bf16x8*)(lds + PG8_SB(b, h) + boff + n * 2048 + k * 1024); } while (0)
#define PG8_MMA(ai, bj, At, Bt) do { __builtin_amdgcn_s_setprio(1); _Pragma("unroll") for (int m = 0; m < 4; ++m) _Pragma("unroll") for (int n = 0; n < 2; ++n) _Pragma("unroll") for (int k = 0; k < 2; ++k) \
        { if constexpr (I8) acc[ai][bj][m][n] = __builtin_bit_cast(AccT, __builtin_amdgcn_mfma_i32_16x16x64_i8(__builtin_bit_cast(i32x4_t, Bt[n][k]), __builtin_bit_cast(i32x4_t, At[m][k]), __builtin_bit_cast(i32x4_t, acc[ai][bj][m][n]), 0, 0, 0)); \
          else acc[ai][bj][m][n] = __builtin_bit_cast(AccT, __builtin_amdgcn_mfma_f32_16x16x32_bf16(Bt[n][k], At[m][k], __builtin_bit_cast(f32x4, acc[ai][bj][m][n]), 0, 0, 0)); } __builtin_amdgcn_s_setprio(0); } while (0)
#define PG8_WAIT_V(n) asm volatile("s_waitcnt vmcnt(" #n ")" ::: "memory")
#define PG8_WAIT_L(n) asm volatile("s_waitcnt lgkmcnt(" #n ")" ::: "memory")
#define PG8_BAR __builtin_amdgcn_s_barrier()
#define PG8_SCHED __builtin_amdgcn_sched_barrier(0)
    Unit cur, nxt; int ui = 0;
    if (!S.next(0, cur)) return;
    typedef int i32x4_t __attribute__((ext_vector_type(4)));
    typedef typename std::conditional<I8, i32x4_t, f32x4>::type AccT;
    AccT acc[2][2][4][2];
#pragma unroll
    for (int a = 0; a < 2; ++a)
#pragma unroll
        for (int b = 0; b < 2; ++b)
#pragma unroll
            for (int m = 0; m < 4; ++m)
#pragma unroll
                for (int n = 0; n < 2; ++n) acc[a][b][m][n] = (AccT){0, 0, 0, 0};
    bf16x8 At[4][2], B0[2][2], B1[2][2];
    const char* cA = S.baseA(g, cur, tstep); const char* cB = S.baseB(g, cur, tstep);
    S.a_ready(cur);
    PG8_STAGE(PG8_SB(0, 0), cB, voffB); PG8_STAGE(PG8_SA(0, 0), cA, voffA); PG8_STAGE(PG8_SB(0, 1), cB + hstep, voffB); PG8_STAGE(PG8_SA(0, 1), cA + hstep, voffA);
    if (wr == 1) PG8_BAR;
    PG8_WAIT_V(4); PG8_BAR;
    PG8_STAGE(PG8_SB(1, 0), cB + kstep, voffB); PG8_STAGE(PG8_SA(1, 0), cA + kstep, voffA); PG8_STAGE(PG8_SB(1, 1), cB + hstep + kstep, voffB);
    PG8_WAIT_V(6); PG8_BAR;
    PG8_STAMP();
    for (;;) {
        if constexpr (Epi::PREF) E.prefetch(cur, ui & 1, lds, wid, lane);
        const bool has_next = S.next(ui + 1, nxt);
        const char* nA = has_next ? S.baseA(g, nxt, tstep) : cA; const char* nB = has_next ? S.baseB(g, nxt, tstep) : cB;
        for (int t = 0; t < nt; t += 2) {
            const bool last = (t == nt - 2);
            const char* a1 = cA + (size_t)(t + 1) * kstep;
            const char* a2 = last ? nA : cA + (size_t)(t + 2) * kstep; const char* b2 = last ? nB : cB + (size_t)(t + 2) * kstep;
            const char* a3 = a2 + kstep; const char* b3 = b2 + kstep;
            if (last && has_next) S.a_ready(nxt);
            PG8_LDB(B0, 0, 0); PG8_SCHED; PG8_LDA(At, 0, 0); PG8_STAGE(PG8_SA(1, 1), a1 + hstep, voffA);
            PG8_WAIT_L(8); PG8_BAR; PG8_WAIT_L(0); PG8_MMA(0, 0, At, B0); PG8_BAR; PG8_SCHED;
            PG8_LDB(B1, 0, 1); PG8_STAGE(PG8_SB(0, 0), b2, voffB);
            PG8_BAR; PG8_WAIT_L(0); PG8_MMA(0, 1, At, B1); PG8_BAR;
            PG8_LDA(At, 0, 1); PG8_STAGE(PG8_SA(0, 0), a2, voffA);
            PG8_BAR; PG8_WAIT_L(0); PG8_MMA(1, 0, At, B0); PG8_BAR; PG8_SCHED;
            PG8_STAGE(PG8_SB(0, 1), b2 + hstep, voffB);
            PG8_WAIT_V(6); PG8_BAR; PG8_MMA(1, 1, At, B1); PG8_BAR;
            PG8_LDB(B0, 1, 0); PG8_SCHED; PG8_LDA(At, 1, 0); PG8_STAGE(PG8_SA(0, 1), a2 + hstep, voffA);
            PG8_WAIT_L(8); PG8_BAR; PG8_WAIT_L(0); PG8_MMA(0, 0, At, B0); PG8_BAR; PG8_SCHED;
            PG8_LDB(B1, 1, 1); PG8_STAGE(PG8_SB(1, 0), b3, voffB);
            PG8_BAR; PG8_WAIT_L(0); PG8_MMA(0, 1, At, B1); PG8_BAR;
            PG8_LDA(At, 1, 1); PG8_STAGE(PG8_SA(1, 0), a3, voffA);
            PG8_BAR; PG8_WAIT_L(0); PG8_MMA(1, 0, At, B0); PG8_BAR; PG8_SCHED;
            PG8_STAGE(PG8_SB(1, 1), b3 + hstep, voffB);
            PG8_WAIT_V(6); PG8_BAR; PG8_MMA(1, 1, At, B1); PG8_BAR;
        }
        PG8_STAMP();
        if constexpr (!Epi::AFTER_DRAIN) { if constexpr (Epi::PREF) E(acc, cur, wr, wc, fr, fq, lds, ui & 1); else E(acc, cur, wr, wc, fr, fq); S.done(cur); }
        PG8_STAMP();
        if (!has_next) break;
#pragma unroll
        for (int a = 0; a < 2; ++a)
#pragma unroll
            for (int b = 0; b < 2; ++b)
#pragma unroll
                for (int m = 0; m < 4; ++m)
#pragma unroll
                    for (int n = 0; n < 2; ++n) acc[a][b][m][n] = (AccT){0, 0, 0, 0};
        cur = nxt; cA = nA; cB = nB; ++ui;
    }
    PG8_WAIT_V(0);
    if (wr == 0) PG8_BAR;
    PG8_BAR;
    if constexpr (Epi::AFTER_DRAIN) { E.fused(acc, cur, wr, wc, fr, fq, lds, wid, lane); S.done(cur); }
    PG8_STAMP();
    if (STAMP && wid == 0) { stamps[lane] = lane < nts ? (((unsigned long long)(unsigned)ts_hi << 32) | (unsigned)ts_lo) : 0ull;
        if (lane == 62) stamps[62] = rt_entry; if (lane == 63) stamps[63] = (unsigned long long)wall_clock64(); }
#undef PG8_STAMP
#undef PG8_SA
#undef PG8_SB
#undef PG8_STAGE
#undef PG8_LDA
#undef PG8_LDB
#undef PG8_MMA
#undef PG8_WAIT_V
#undef PG8_WAIT_L
#undef PG8_BAR
#undef PG8_SCHED
}
}

#define GAS __attribute__((address_space(1)))
#define LAS __attribute__((address_space(3)))
typedef unsigned short bf16;
#define PIN(x) asm volatile("" : "+v"(x))
#define WS_OPAQUE(p_) ({ unsigned long long w_ = (unsigned long long)(p_); asm volatile("" : "+s"(w_)); (unsigned char*)(GAS unsigned char*)w_; })
typedef unsigned v4u __attribute__((ext_vector_type(4)));
typedef unsigned v2u __attribute__((ext_vector_type(2)));
typedef float f32x4 __attribute__((ext_vector_type(4)));
typedef float f32x16 __attribute__((ext_vector_type(16)));
typedef short bf16x8 __attribute__((ext_vector_type(8)));
typedef short bf16x4 __attribute__((ext_vector_type(4)));

constexpr int NB = 8, SEQ = 8192, T = NB * SEQ, D = 1024, MW = 512, NL = 2;
constexpr int HT = T / 2;
constexpr int N_RWKV = 1792, N_REST = 3584, N_GATE = 3072, N1 = N_RWKV + N_REST + N_GATE;
constexpr int NSLOT_MAX = 2 * T + 32 * 256;
constexpr int NWAVES = 8, NTHR = 512;

constexpr size_t MiB = (size_t)1 << 20;
constexpr size_t WS_CTL = 0, CTL_ZERO_BYTES = 2 * MiB;
constexpr size_t WS_MOD = 1 * MiB;
constexpr size_t WS_WT1 = 2 * MiB;
constexpr size_t WS_WBR = 35 * MiB;
constexpr size_t WS_WO = 41 * MiB;
constexpr size_t WS_LOT = 45 * MiB;
constexpr size_t WS_WR = 46 * MiB;
constexpr size_t WS_AMAX1 = 512 * 1024;
constexpr size_t WS_AMAXE = 640 * 1024;
constexpr size_t WS_W81 = 2 * MiB;
constexpr size_t WS_SW1 = 47 * MiB;
constexpr size_t WS_SWE = 47 * MiB + 128 * 1024;
constexpr size_t WS_H8M = 472 * MiB;
constexpr size_t TAB_SA = 5 * MiB, TAB_XS = 6 * MiB;
constexpr size_t WS_H = 48 * MiB;
constexpr size_t WS_YRWKV = 176 * MiB;
constexpr size_t WS_X2 = 112 * MiB;
constexpr size_t WS_H2 = 336 * MiB;
constexpr size_t WS_R = 240 * MiB;
constexpr size_t WS_PRW = WS_R;
constexpr size_t WS_SI = 464 * MiB;
constexpr size_t WS_E1 = 848 * MiB;
constexpr size_t WS_GT = 912 * MiB;
constexpr size_t WS_PREST = WS_R;
constexpr size_t WS_GATES = 464 * MiB;
constexpr size_t WS_YRET = 656 * MiB;
constexpr size_t WS_YCONV = 688 * MiB;
constexpr size_t WS_MERGED = 720 * MiB;
constexpr size_t WS_KV = 784 * MiB;
constexpr size_t WS_SST = 848 * MiB;
constexpr size_t OUT_WGU = 128 * MiB;
constexpr size_t OUT_WD = 160 * MiB;
constexpr size_t WS_XROWS = 336 * MiB;
constexpr size_t WS_GB = 608 * MiB;
constexpr size_t WS_YM = 744 * MiB;
constexpr size_t WS_TAB = 1016 * MiB;
constexpr size_t TAB_ROWTOK = 0, TAB_SLOTOF = 1 * MiB, TAB_RW = 2 * MiB, TAB_EID = 3 * MiB, TAB_CNT = 4 * MiB, TAB_TILEE = 4 * MiB + 512 * 1024, TAB_NT = TAB_TILEE + 4096;
constexpr size_t WS_END = 1024 * MiB;
constexpr int CW_BAR = 4096;

constexpr int LDS_BYTES = 163840;
constexpr int LDS_MISC = LDS_BYTES - 256;

#define LDS_WAIT() asm volatile("s_waitcnt lgkmcnt(0)" ::: "memory")
#define VM_WAIT() asm volatile("s_waitcnt vmcnt(0)" ::: "memory")

#define XB_TMO      128
#define XB_XCNT(j)  (256  + 64 * (j))
#define XB_XSUB(j)  (1280 + 64 * (j))
#define XB_XGEN(j)  (2304 + 64 * (j))
#define XB_TOP      3328
#define XB_TOPGEN   3392
#define XCD_BAR_WORDS 3456
#define XB_SPIN_CAP (1u << 20)

__device__ __forceinline__ unsigned xb_ld(unsigned* p)              { return __hip_atomic_load(p, __ATOMIC_RELAXED, __HIP_MEMORY_SCOPE_AGENT); }
__device__ __forceinline__ unsigned xb_add(unsigned* p, unsigned v) { return __hip_atomic_fetch_add(p, v, __ATOMIC_RELAXED, __HIP_MEMORY_SCOPE_AGENT); }
__device__ __forceinline__ unsigned xb_xcc_id() { return (unsigned)__builtin_amdgcn_s_getreg((3 << 11) | 20) & 0xFu; }
#define XB_SPIN(cond, bar) do { unsigned _sp = 0; while (cond) { __builtin_amdgcn_s_sleep(1); \
    if ((++_sp & 255u) == 0u) { if (xb_ld(&(bar)[XB_TMO])) break; if (_sp > XB_SPIN_CAP) { atomicAdd(&(bar)[XB_TMO], 1u); break; } } } } while (0)

struct XcdBarrier {
    unsigned* bar; unsigned x;
    volatile LAS unsigned* st;
};
__device__ __forceinline__ XcdBarrier xcd_barrier_post(unsigned* bar, volatile LAS unsigned* st, int tid) {
    XcdBarrier b; b.bar = bar; b.x = xb_xcc_id(); b.st = st;
    if (tid == 0) (void)xb_add(&bar[XB_XCNT(b.x)], 1u);
    return b;
}
__device__ __forceinline__ void xcd_barrier_complete(unsigned* bar, unsigned x, unsigned& nloc, unsigned& nx) {
    const unsigned G = gridDim.x * gridDim.y * gridDim.z;
    unsigned sum, cnt, mine, sp = 0u;
    for (;;) {
        sum = 0u; cnt = 0u; mine = 0u;
#pragma unroll
        for (unsigned j = 0; j < 16; ++j) { const unsigned c = xb_ld(&bar[XB_XCNT(j)]); sum += c; cnt += (c > 0u) ? 1u : 0u; mine = (j == x) ? c : mine; }
        if (sum == G) break;
        __builtin_amdgcn_s_sleep(1);
        if ((++sp & 255u) == 0u) { if (xb_ld(&bar[XB_TMO])) break; if (sp > XB_SPIN_CAP) { atomicAdd(&bar[XB_TMO], 1u); break; } }
    }
    nloc = mine > 0u ? mine : 1u; nx = cnt > 0u ? cnt : 1u;
}
__device__ __forceinline__ void xcd_barrier(const XcdBarrier& b, int tid) {
    asm volatile("s_waitcnt vmcnt(0)" ::: "memory");
    __syncthreads();
    if (tid == 0) {
        unsigned* bar = b.bar;
        __builtin_amdgcn_s_waitcnt(0);
        unsigned nloc = b.st[0], nx = b.st[1];
        if (nloc == 0u) { xcd_barrier_complete(bar, b.x, nloc, nx); b.st[0] = nloc; b.st[1] = nx; }
        const unsigned old = xb_add(&bar[XB_XSUB(b.x)], 1u);
        const unsigned gen = old / nloc;
        if (old + 1u == (gen + 1u) * nloc) {
            __builtin_amdgcn_fence(__ATOMIC_RELEASE, "agent");
            asm volatile("s_waitcnt vmcnt(0)" ::: "memory");
            const unsigned og = xb_add(&bar[XB_TOP], 1u);
            const unsigned tg = og / nx;
            if (og + 1u == (tg + 1u) * nx) xb_add(&bar[XB_TOPGEN], 1u);
            else XB_SPIN(xb_ld(&bar[XB_TOPGEN]) == tg, bar);
            __builtin_amdgcn_fence(__ATOMIC_ACQUIRE, "agent");
            xb_add(&bar[XB_XGEN(b.x)], 1u);
            asm volatile("s_waitcnt vmcnt(0)" ::: "memory");
        } else {
            XB_SPIN(xb_ld(&bar[XB_XGEN(b.x)]) == gen, bar);
            __builtin_amdgcn_fence(__ATOMIC_ACQUIRE, "agent");
            asm volatile("s_waitcnt vmcnt(0)" ::: "memory");
        }
    }
    __syncthreads();
}

__device__ __forceinline__ float bflo(unsigned u) { return __uint_as_float(u << 16); }
__device__ __forceinline__ float bfhi(unsigned u) { return __uint_as_float(u & 0xffff0000u); }
__device__ __forceinline__ unsigned pk2(float lo, float hi) { return pg8::cvt_pk_bf16(lo, hi); }
__device__ __forceinline__ void unpk8(const v4u a, float (&o)[8]) { o[0] = bflo(a.x); o[1] = bfhi(a.x); o[2] = bflo(a.y); o[3] = bfhi(a.y); o[4] = bflo(a.z); o[5] = bfhi(a.z); o[6] = bflo(a.w); o[7] = bfhi(a.w); }
__device__ __forceinline__ v4u pk8(const float (&x)[8]) { v4u o; o.x = pk2(x[0], x[1]); o.y = pk2(x[2], x[3]); o.z = pk2(x[4], x[5]); o.w = pk2(x[6], x[7]); return o; }
__device__ __forceinline__ float sigm(float x) { return __builtin_amdgcn_rcpf(1.0f + __expf(-x)); }
__device__ __forceinline__ float dppf(float x, const int ctrl) { return x; }
#define DPP_F(x, ctrl, rm, bm, bc) __builtin_bit_cast(float, __builtin_amdgcn_update_dpp(0, __builtin_bit_cast(int, (x)), (ctrl), (rm), (bm), (bc)))
__device__ __forceinline__ float sum16(float x) {
    x += DPP_F(x, 0xB1, 0xf, 0xf, false);
    x += DPP_F(x, 0x4E, 0xf, 0xf, false);
    x += DPP_F(x, 0x141, 0xf, 0xf, false);
    x += DPP_F(x, 0x140, 0xf, 0xf, false);
    return x;
}
__device__ __forceinline__ float wave_sum(float x) {
    x = sum16(x);
    x += DPP_F(x, 0x142, 0xa, 0xf, false);
    x += DPP_F(x, 0x143, 0xc, 0xf, false);
    return __builtin_bit_cast(float, __builtin_amdgcn_readlane(__builtin_bit_cast(int, x), 63));
}
__device__ __forceinline__ float xor_lane(float x, int lane, int m) { return __builtin_bit_cast(float, __builtin_amdgcn_ds_bpermute((lane ^ m) << 2, __builtin_bit_cast(int, x))); }
__device__ __forceinline__ float wave_max_pos(float x) {
    x = fmaxf(x, DPP_F(x, 0xB1, 0xf, 0xf, false)); x = fmaxf(x, DPP_F(x, 0x4E, 0xf, 0xf, false)); x = fmaxf(x, DPP_F(x, 0x141, 0xf, 0xf, false)); x = fmaxf(x, DPP_F(x, 0x140, 0xf, 0xf, false));
    x = fmaxf(x, DPP_F(x, 0x142, 0xa, 0xf, false)); x = fmaxf(x, DPP_F(x, 0x143, 0xc, 0xf, false));
    return __builtin_bit_cast(float, __builtin_amdgcn_readlane(__builtin_bit_cast(int, x), 63));
}
__device__ __forceinline__ unsigned q8x4(float a, float b, float c, float d) {
    const int ia = (int)__builtin_rintf(a), ib = (int)__builtin_rintf(b), ic = (int)__builtin_rintf(c), id = (int)__builtin_rintf(d);
    return (unsigned)(ia & 0xff) | ((unsigned)(ib & 0xff) << 8) | ((unsigned)(ic & 0xff) << 16) | ((unsigned)(id & 0xff) << 24);
}
__device__ __forceinline__ float sum8(float x) {
    x += DPP_F(x, 0xB1, 0xf, 0xf, false);
    x += DPP_F(x, 0x4E, 0xf, 0xf, false);
    x += DPP_F(x, 0x141, 0xf, 0xf, false);
    return x;
}

struct Params {
    const void* in[32];
    float* out;
    unsigned char* ws;
    int lo, hi;
};

__device__ __forceinline__ void tr_block(const float* W, int ldsrc, bf16* WT, int ldt, int k0, LAS float* scr, int lane) {
    {   float t[32];
#pragma unroll
        for (int i = 0; i < 32; ++i) { const int kk = 2 * i + (lane >> 5); t[i] = W[(size_t)(k0 + kk) * ldsrc + (lane & 31)]; }
        asm volatile("" ::: "memory");
#pragma unroll
        for (int i = 0; i < 32; ++i) { const int kk = 2 * i + (lane >> 5); scr[kk * 33 + (lane & 31)] = t[i]; } }
    LDS_WAIT(); asm volatile("" ::: "memory");
    const int c = lane & 7;
#pragma unroll
    for (int j = 0; j < 4; ++j) { const int n = (lane >> 3) + 8 * j; const LAS float* s = scr + (8 * c) * 33 + n;
        v4u o; o.x = pk2(s[0 * 33], s[1 * 33]); o.y = pk2(s[2 * 33], s[3 * 33]); o.z = pk2(s[4 * 33], s[5 * 33]); o.w = pk2(s[6 * 33], s[7 * 33]);
        *(v4u*)(WT + (size_t)n * ldt + k0 + 8 * c) = o; }
    LDS_WAIT(); asm volatile("" ::: "memory");
}
__device__ __forceinline__ void tr_block_i8(const float* W, int ldsrc, signed char* WT, int ldt, const unsigned* amax, int k0, LAS float* scr, int lane) {
#pragma unroll 8
    for (int i = 0; i < 32; ++i) { const int kk = 2 * i + (lane >> 5); scr[kk * 33 + (lane & 31)] = W[(size_t)(k0 + kk) * ldsrc + (lane & 31)]; }
    LDS_WAIT(); asm volatile("" ::: "memory");
    const int c = lane & 7;
#pragma unroll
    for (int j = 0; j < 4; ++j) { const int n = (lane >> 3) + 8 * j; const LAS float* s = scr + (8 * c) * 33 + n;
        const float inv = 127.0f / fmaxf(__uint_as_float(amax[n]), 1e-30f);
        v2u o; o.x = q8x4(s[0 * 33] * inv, s[1 * 33] * inv, s[2 * 33] * inv, s[3 * 33] * inv); o.y = q8x4(s[4 * 33] * inv, s[5 * 33] * inv, s[6 * 33] * inv, s[7 * 33] * inv);
        *(v2u*)(WT + (size_t)n * ldt + k0 + 8 * c) = o; }
    LDS_WAIT(); asm volatile("" ::: "memory");
}
__device__ __forceinline__ void amax_cols(const float* W, int ld, int K, int ncols, unsigned* amax  , int mode, int gt, int NT, int& base) {
    const int items = ncols * (K / 128);
    for (int it = (gt - (base % NT) + NT) % NT; it < items; it += NT) { const int col = it % ncols, kc = it / ncols;
        const float* p = W + (size_t)kc * 128 * ld + col; float m = 0.f;
#pragma unroll 16
        for (int k = 0; k < 128; ++k) m = fmaxf(m, fabsf(p[(size_t)k * ld]));
        int row;
        if (mode == 0) row = (col < 2048) ? 1792 + col : (col < 3840) ? col - 2048 : col;
        else if (mode == 1) row = col;
        else row = (col >> 7) * 256 + (col & 127) + (mode == 3 ? 128 : 0);
        atomicMax(amax + row, __float_as_uint(m)); }
    base += items;
}
__device__ __forceinline__ void tr_job(const float* W, int ldsrc, int K, int N, bf16* WT, int ldt, LAS float* scr, int lane, int gw, int NGW, int& base) {
    const int nblk = N / 32, items = (K / 64) * nblk;
    int start = (gw - (base % NGW) + NGW) % NGW;
    for (int it = start; it < items; it += NGW) { const int kb = it / nblk, nb = it % nblk;
        tr_block(W + nb * 32, ldsrc, WT + (size_t)nb * 32 * ldt, ldt, kb * 64, scr, lane); }
    base += items;
}
__device__ __forceinline__ void p0_mixer_weights(const Params& P, LAS float* scr, int lane, int gw, int NGW) {
    unsigned char* ws = WS_OPAQUE(P.ws); int base = 0;
#pragma unroll 1
    for (int l = 0; l < NL; ++l) {
        const float* w_in = (const float*)P.in[8] + (size_t)l * D * 5376;
        const float* w_gate = (const float*)P.in[9] + (size_t)l * D * N_GATE;
        for (int i = 0; i < 3; ++i)
            tr_job((const float*)P.in[23] + (size_t)(l * 3 + i) * MW * D, D, MW, D, (bf16*)(ws + WS_WBR) + (size_t)(l * 3 + i) * D * MW, MW, scr, lane, gw, NGW, base);
        tr_job((const float*)P.in[24] + (size_t)l * D * D, D, D, D, (bf16*)(ws + WS_WO) + (size_t)l * D * D, D, scr, lane, gw, NGW, base);
        bf16* lot = (bf16*)(ws + WS_LOT) + (size_t)l * 131072;
        tr_job((const float*)P.in[14] + (size_t)l * 64 * MW, MW, 64, MW, lot, 64, scr, lane, gw, NGW, base);
        tr_job((const float*)P.in[16] + (size_t)l * 64 * MW, MW, 64, MW, lot + 32768, 64, scr, lane, gw, NGW, base);
        tr_job((const float*)P.in[17] + (size_t)l * 128 * MW, MW, 128, MW, lot + 65536, 128, scr, lane, gw, NGW, base);
    }
}
__device__ __forceinline__ void p0_router_weights(const Params& P, int tid, int c, int G) {
    bf16* Wr = (bf16*)(P.ws + WS_WR);
    for (int i = c * NTHR + tid; i < NL * 256 * 1024; i += G * NTHR) {
        const int l = i >> 18, n = (i >> 10) & 255, k = i & 1023; const int nn = (n >= 64) ? n - 64 : n;
        float w = 0.f;
        if (nn < 4) w = ((const float*)P.in[25])[((size_t)l * D + k) * 4 + nn]; else if (nn < 36) w = ((const float*)P.in[27])[((size_t)l * D + k) * 32 + nn - 4];
        const unsigned hi = pk2(w, 0.f) & 0xffffu; const float lo = w - __uint_as_float(hi << 16);
        Wr[i] = (n < 36) ? (bf16)hi : (n >= 64 && n < 100) ? (bf16)(pk2(lo, 0.f) & 0xffffu) : (bf16)0;
    }
}
__device__ __forceinline__ void quant_strip(const float* src, int ld, signed char* dst, float* sw, LAS unsigned char* lds, int tid, int lane, int wave) {
    LAS float* strip = (LAS float*)lds;
    LAS float* red = strip + 1024 * 33;
    __syncthreads();
    {   float t[64];
#pragma unroll
        for (int i = 0; i < 64; ++i) { const int k = (wave * 64 + i) * 2 + (lane >> 5); t[i] = src[(size_t)k * ld + (lane & 31)]; }
        asm volatile("" ::: "memory");
#pragma unroll
        for (int i = 0; i < 64; ++i) { const int k = (wave * 64 + i) * 2 + (lane >> 5); strip[k * 33 + (lane & 31)] = t[i]; } }
    __syncthreads();
    { const int col = tid & 31, part = tid >> 5; float m = 0.f;
#pragma unroll 8
      for (int k = 0; k < 64; ++k) m = fmaxf(m, fabsf(strip[(part * 64 + k) * 33 + col]));
      red[part * 32 + col] = m; }
    __syncthreads();
    if (tid < 32) { float m = 0.f;
#pragma unroll
        for (int p = 0; p < 16; ++p) m = fmaxf(m, red[p * 32 + tid]);
        red[512 + tid] = fmaxf(m, 1e-30f); }
    __syncthreads();
    { const int n = tid & 31, kq = tid >> 5; const float am = red[512 + n], inv = 127.0f / am;
      signed char* d = dst + (size_t)n * 1024 + kq * 64;
#pragma unroll
      for (int q = 0; q < 4; ++q) { const LAS float* s = strip + (kq * 64 + q * 16) * 33 + n; v4u o;
          o.x = q8x4(s[0 * 33] * inv, s[1 * 33] * inv, s[2 * 33] * inv, s[3 * 33] * inv); o.y = q8x4(s[4 * 33] * inv, s[5 * 33] * inv, s[6 * 33] * inv, s[7 * 33] * inv);
          o.z = q8x4(s[8 * 33] * inv, s[9 * 33] * inv, s[10 * 33] * inv, s[11 * 33] * inv); o.w = q8x4(s[12 * 33] * inv, s[13 * 33] * inv, s[14 * 33] * inv, s[15 * 33] * inv);
          *(v4u*)(d + q * 16) = o; }
      if (kq == 0) sw[n] = am * (1.0f / 127.0f); }
}
__device__ __forceinline__ void p_quant_wt1(const Params& P, int l, LAS unsigned char* lds, int tid, int lane, int wave, int c, int G) {
    unsigned char* ws = WS_OPAQUE(P.ws);
    const float* w_in = (const float*)P.in[8] + (size_t)l * D * 5376; const float* w_gate = (const float*)P.in[9] + (size_t)l * D * N_GATE;
    signed char* w8 = (signed char*)(ws + WS_W81) + (size_t)l * N1 * D; float* sw = (float*)(ws + WS_SW1) + l * N1;
    for (int sidx = c; sidx < N1 / 32; sidx += G) { const int n0 = sidx * 32;
        const float* src; int ld;
        if (n0 < N_RWKV) { src = w_in + 2048 + n0; ld = 5376; } else if (n0 < N_RWKV + 2048) { src = w_in + (n0 - N_RWKV); ld = 5376; } else if (n0 < N_RWKV + N_REST) { src = w_in + n0; ld = 5376; } else { src = w_gate + (n0 - N_RWKV - N_REST); ld = N_GATE; }
        quant_strip(src, ld, w8 + (size_t)n0 * D, sw + n0, lds, tid, lane, wave); }
    __syncthreads();
}
__device__ __forceinline__ void p_expert_weights(const Params& P, int l, int part, LAS unsigned char* lds, int tid, int lane, int wave, int c, int G) {
    unsigned char* ws = WS_OPAQUE(P.ws);
    const float* wg = (const float*)P.in[29] + (size_t)l * 32 * D * MW;
    const float* wu = (const float*)P.in[30] + (size_t)l * 32 * D * MW;
    const float* wd = (const float*)P.in[31] + (size_t)l * 32 * MW * D;
    signed char* Wgu = (signed char*)P.out + OUT_WGU; bf16* Wd = (bf16*)((unsigned char*)P.out + OUT_WD); float* swe = (float*)(ws + WS_SWE);
    for (int sidx = part * 512 + c; sidx < part * 512 + 512; sidx += G) {
        const int e = sidx >> 5, which = (sidx >> 4) & 1, nb = sidx & 15, n0 = nb * 32;
        const int drow0 = (n0 / 128) * 256 + (n0 % 128) + (which ? 128 : 0);
        quant_strip((which ? wu : wg) + (size_t)e * D * MW + n0, MW, Wgu + (size_t)e * D * D + (size_t)drow0 * D, swe + e * 1024 + drow0, lds, tid, lane, wave);
    }
    __syncthreads();
    {   LAS float* scr = (LAS float*)(lds + wave * 8448); const int gw = c * NWAVES + wave, NGW = G * NWAVES;
        for (int it = part * 4096 + gw; it < part * 4096 + 4096; it += NGW) { const int e = it / 256, q = it % 256, kb = q / 32, nb = q % 32, n0 = nb * 32;
            tr_block(wd + (size_t)e * MW * D + n0, D, Wd + (size_t)e * D * MW + (size_t)n0 * MW, MW, kb * 64, scr, lane); } }
}
__device__ __forceinline__ void p0_mod(const Params& P, LAS unsigned char* lds, int tid, int c, int G) {
    LAS float* sc = (LAS float*)lds;
    LAS float* red = sc + 8192;
    const float* cin = (const float*)P.in[1]; const float* w_ada = (const float*)P.in[6]; const float* b_ada = (const float*)P.in[7];
    float* mod = (float*)(P.ws + WS_MOD);
    __syncthreads();
    for (int i = tid; i < 8192; i += NTHR) { const float cv = cin[i]; sc[i] = cv * sigm(cv); }
    __syncthreads();
    for (int it = c; it < 192; it += G) {
        const int l = it / 96, nb = it % 96;
        const int colL = tid & 63, ks = tid >> 6, col = nb * 64 + colL;
        const float* wp = w_ada + ((size_t)l * D + ks * 128) * 6144 + col;
        float a0 = 0.f, a1 = 0.f, a2 = 0.f, a3 = 0.f, a4 = 0.f, a5 = 0.f, a6 = 0.f, a7 = 0.f;
        for (int k0 = 0; k0 < 128; k0 += 32) {
            float wv[32];
#pragma unroll
            for (int k = 0; k < 32; ++k) wv[k] = wp[(size_t)(k0 + k) * 6144];
            asm volatile("" ::: "memory");
#pragma unroll
            for (int k = 0; k < 32; ++k) PIN(wv[k]);
#pragma unroll
            for (int k = 0; k < 32; ++k) { const LAS float* s = sc + ks * 128 + k0 + k; const float w_ = wv[k];
                a0 += s[0] * w_; a1 += s[1024] * w_; a2 += s[2048] * w_; a3 += s[3072] * w_; a4 += s[4096] * w_; a5 += s[5120] * w_; a6 += s[6144] * w_; a7 += s[7168] * w_; }
        }
        LAS float* rp = red + ks * 512 + colL;
        rp[0] = a0; rp[64] = a1; rp[128] = a2; rp[192] = a3; rp[256] = a4; rp[320] = a5; rp[384] = a6; rp[448] = a7;
        __syncthreads();
        { const int b = tid >> 6; float s = b_ada[l * 6144 + col];
#pragma unroll
          for (int q = 0; q < 8; ++q) s += red[q * 512 + b * 64 + colL];
          mod[((size_t)l * NB + b) * 6144 + col] = s; }
        __syncthreads();
    }
    __syncthreads();
}

template <int MODE>
__device__ __forceinline__ void row_phase(const Params& P, int l, LAS unsigned char* lds, int tid, int lane, int wave, int c, int G) {
    unsigned char* ws = WS_OPAQUE(P.ws);
    const float* mod = (const float*)(ws + WS_MOD);
    bf16* H = (bf16*)(ws + WS_H2);
    const bool combine = (MODE == 2) || (MODE == 0 && l > 0);
    const int lprev = (MODE == 2) ? NL - 1 : l - 1;
    const bool xf32 = (MODE == 0 && l == 0);
    const float* src = (const float*)P.in[0];
    const bf16* srcb = (MODE == 2 || (MODE == 1 && l == NL - 1)) ? (const bf16*)(ws + WS_X2) : (const bf16*)P.out;
    const int* slot_of = (const int*)(ws + WS_TAB + TAB_SLOTOF);
    const float* rwt = (const float*)(ws + WS_TAB + TAB_RW);
    const bf16* YM = (const bf16*)(ws + WS_YM);
    const float* gam = (MODE == 0) ? (const float*)P.in[3] + l * D : (MODE == 1) ? (const float*)P.in[4] + l * D : (const float*)P.in[5];
    for (int ck = c; ck < T / 256; ck += G) {
        const int b = (ck * 256) / SEQ;
        f32x4 gsc[4], shv[4], g2v[4];
        {   const float* mb = mod + ((size_t)l * NB + b) * 6144 + (MODE == 0 ? 0 : 3072);
            const float* g2 = mod + ((size_t)lprev * NB + b) * 6144 + 5120;
#pragma unroll
            for (int j = 0; j < 4; ++j) { const f32x4 g = *((const f32x4*)gam + lane + 64 * j);
                if (MODE == 2) { gsc[j] = g; shv[j] = g; } else { gsc[j] = g * (1.0f + *((const f32x4*)(mb + 1024) + lane + 64 * j)); shv[j] = *((const f32x4*)mb + lane + 64 * j); }
                g2v[j] = combine ? *((const f32x4*)g2 + lane + 64 * j) : g; } }
        const int row0 = ck * 256 + wave;
        f32x4 xn[4]; v2u xnb[4]; v2u y0n[4], y1n[4]; int s0n = 0, s1n = 0; float w0c = 0.f, w1c = 0.f, w0n = 0.f, w1n = 0.f;
        {   if (xf32) { const f32x4* xr = (const f32x4*)(src + (size_t)row0 * D) + lane;
#pragma unroll
                for (int j = 0; j < 4; ++j) xn[j] = xr[64 * j]; }
            else { const v2u* xr = (const v2u*)(srcb + (size_t)row0 * D) + lane;
#pragma unroll
                for (int j = 0; j < 4; ++j) xnb[j] = xr[64 * j]; }
            if (combine) { const int s0 = slot_of[row0 * 2], s1 = slot_of[row0 * 2 + 1]; w0c = rwt[row0 * 2]; w1c = rwt[row0 * 2 + 1];
                const v2u* y0 = (const v2u*)(YM + (size_t)s0 * D) + lane; const v2u* y1 = (const v2u*)(YM + (size_t)s1 * D) + lane;
#pragma unroll
                for (int j = 0; j < 4; ++j) { y0n[j] = y0[64 * j]; y1n[j] = y1[64 * j]; }
                s0n = slot_of[(row0 + 8) * 2]; s1n = slot_of[(row0 + 8) * 2 + 1]; w0n = rwt[(row0 + 8) * 2]; w1n = rwt[(row0 + 8) * 2 + 1]; } }
        for (int i = 0; i < 32; ++i) {
            const int row = row0 + 8 * i;
            f32x4 v[4]; v2u vb[4], ya[4], yb[4];
#pragma unroll
            for (int j = 0; j < 4; ++j) { if (xf32) v[j] = xn[j]; else vb[j] = xnb[j]; ya[j] = y0n[j]; yb[j] = y1n[j]; }
            const float w0 = w0c, w1 = w1c;
            if (i < 31) {
                if (xf32) { const f32x4* xr = (const f32x4*)(src + (size_t)(row + 8) * D) + lane;
#pragma unroll
                    for (int j = 0; j < 4; ++j) xn[j] = xr[64 * j]; }
                else { const v2u* xr = (const v2u*)(srcb + (size_t)(row + 8) * D) + lane;
#pragma unroll
                    for (int j = 0; j < 4; ++j) xnb[j] = xr[64 * j]; }
                if (combine) { const v2u* y0 = (const v2u*)(YM + (size_t)s0n * D) + lane; const v2u* y1 = (const v2u*)(YM + (size_t)s1n * D) + lane;
#pragma unroll
                    for (int j = 0; j < 4; ++j) { y0n[j] = y0[64 * j]; y1n[j] = y1[64 * j]; }
                    w0c = w0n; w1c = w1n;
                    if (i < 30) { s0n = slot_of[(row + 16) * 2]; s1n = slot_of[(row + 16) * 2 + 1]; w0n = rwt[(row + 16) * 2]; w1n = rwt[(row + 16) * 2 + 1]; } }
            }
            asm volatile("" ::: "memory");
            if (!xf32) {
#pragma unroll
                for (int j = 0; j < 4; ++j) { v[j][0] = bflo(vb[j].x); v[j][1] = bfhi(vb[j].x); v[j][2] = bflo(vb[j].y); v[j][3] = bfhi(vb[j].y); } }
            if (combine) {
#pragma unroll
                for (int j = 0; j < 4; ++j) { const v2u a = ya[j], bb = yb[j]; const f32x4 gg = g2v[j];
                    v[j][0] += gg[0] * (w0 * bflo(a.x) + w1 * bflo(bb.x)); v[j][1] += gg[1] * (w0 * bfhi(a.x) + w1 * bfhi(bb.x));
                    v[j][2] += gg[2] * (w0 * bflo(a.y) + w1 * bflo(bb.y)); v[j][3] += gg[3] * (w0 * bfhi(a.y) + w1 * bfhi(bb.y)); }
                if (MODE == 0) { v2u* xo = (v2u*)((bf16*)P.out + (size_t)row * D) + lane;
#pragma unroll
                    for (int j = 0; j < 4; ++j) { v2u o; o.x = pk2(v[j][0], v[j][1]); o.y = pk2(v[j][2], v[j][3]); xo[64 * j] = o; } }
            }
            float ss = 0.f;
#pragma unroll
            for (int j = 0; j < 4; ++j) ss += (v[j][0] * v[j][0] + v[j][1] * v[j][1]) + (v[j][2] * v[j][2] + v[j][3] * v[j][3]);
            ss = wave_sum(ss);
            const float rstd = rsqrtf(ss * (1.0f / D) + 1e-6f);
            if (MODE == 2) {
                f32x4* xo = (f32x4*)(P.out + (size_t)row * D) + lane;
#pragma unroll
                for (int j = 0; j < 4; ++j) xo[64 * j] = v[j] * rstd * gsc[j];
            } else {
                f32x4 h[4];
#pragma unroll
                for (int j = 0; j < 4; ++j) h[j] = v[j] * rstd * gsc[j] + shv[j];
                if (MODE == 1) { v2u* ho = (v2u*)(H + (size_t)row * D) + lane;
#pragma unroll
                    for (int j = 0; j < 4; ++j) { v2u o; o.x = pk2(h[j][0], h[j][1]); o.y = pk2(h[j][2], h[j][3]); ho[64 * j] = o; } }
                float am = 0.f;
#pragma unroll
                for (int j = 0; j < 4; ++j) am = fmaxf(fmaxf(am, fmaxf(fabsf(h[j][0]), fabsf(h[j][1]))), fmaxf(fabsf(h[j][2]), fabsf(h[j][3])));
                am = fmaxf(wave_max_pos(am), 1e-30f);
                const float inv = 127.0f / am;
                unsigned* h8 = (unsigned*)(ws + (MODE == 1 ? WS_H8M : WS_H) + (size_t)row * D) + lane;
#pragma unroll
                for (int j = 0; j < 4; ++j) h8[64 * j] = q8x4(h[j][0] * inv, h[j][1] * inv, h[j][2] * inv, h[j][3] * inv);
                if (lane == 0) ((float*)(ws + WS_TAB + TAB_SA))[row] = am * (1.0f / 127.0f);
            }
        }
    }
    __syncthreads();
}

__device__ __forceinline__ void router_phase(const Params& P, int l, LAS unsigned char* lds, int tid, int c, int G) {
    unsigned char* ws = WS_OPAQUE(P.ws);
    { int* row_tok = (int*)(ws + WS_TAB + TAB_ROWTOK); float* xs = (float*)(ws + WS_TAB + TAB_XS); for (int i = c * NTHR + tid; i < NSLOT_MAX; i += G * NTHR) { row_tok[i] = 0; xs[i] = 0.f; } }
    VM_WAIT(); __syncthreads();
    LAS int* hist = (LAS int*)(lds + 2 * 256 * 36 * 4);
    const float* bg = (const float*)P.in[26] + l * 4; const float* be = (const float*)P.in[28] + l * 32;
    for (int ck = c; ck < T / 256; ck += G) {
        pg8::Gemm g{(const bf16*)(ws + WS_H2), (const bf16*)(ws + WS_WR) + (size_t)l * 256 * D, T, 256, D};
        pg8::OneUnitOrder S{ck}; pg8::EpiRouter E{};
        pg8::gemm_phase<pg8::EpiRouter, pg8::OneUnitOrder>(lds, g, S, E, nullptr, tid);
        if (tid < 32) hist[tid] = 0;
        __syncthreads();
        if (tid < 256) {
            const LAS float* th = (const LAS float*)lds + tid * 36; const LAS float* tl = th + 256 * 36;
            float lg[36];
#pragma unroll
            for (int q = 0; q < 9; ++q) { const f32x4 a = *(const LAS f32x4*)(th + 4 * q), b = *(const LAS f32x4*)(tl + 4 * q); lg[4 * q] = a[0] + b[0]; lg[4 * q + 1] = a[1] + b[1]; lg[4 * q + 2] = a[2] + b[2]; lg[4 * q + 3] = a[3] + b[3]; }
            const float g0 = lg[0] + bg[0], g1 = lg[1] + bg[1], g2 = lg[2] + bg[2], g3 = lg[3] + bg[3];
            int gsel = 0; float gm = g0;
            if (g1 > gm) { gm = g1; gsel = 1; } if (g2 > gm) { gm = g2; gsel = 2; } if (g3 > gm) { gm = g3; gsel = 3; }
            const float den = __expf(g0 - gm) + __expf(g1 - gm) + __expf(g2 - gm) + __expf(g3 - gm);
            const float pgrp = 1.0f / den;
            float el[8];
#pragma unroll
            for (int j = 0; j < 8; ++j) { const float a = gsel == 0 ? lg[4 + j] : gsel == 1 ? lg[12 + j] : gsel == 2 ? lg[20 + j] : lg[28 + j]; el[j] = a + be[gsel * 8 + j]; }
            int i1 = 0; float v1 = el[0];
#pragma unroll
            for (int j = 1; j < 8; ++j) if (el[j] > v1) { v1 = el[j]; i1 = j; }
            int i2 = -1; float v2 = -3.0e38f;
#pragma unroll
            for (int j = 0; j < 8; ++j) if (j != i1 && el[j] > v2) { v2 = el[j]; i2 = j; }
            const float e2 = __expf(v2 - v1), p1 = 1.0f / (1.0f + e2), p2 = e2 * p1;
            const int row = ck * 256 + tid;
            int* eid = (int*)(ws + WS_TAB + TAB_EID); float* rwo = (float*)(ws + WS_TAB + TAB_RW);
            const int e0 = gsel * 8 + i1, e1 = gsel * 8 + i2;
            eid[row * 2] = e0; eid[row * 2 + 1] = e1; rwo[row * 2] = p1 * pgrp; rwo[row * 2 + 1] = p2 * pgrp;
            __hip_atomic_fetch_add(&hist[e0], 1, __ATOMIC_RELAXED, __HIP_MEMORY_SCOPE_WORKGROUP); __hip_atomic_fetch_add(&hist[e1], 1, __ATOMIC_RELAXED, __HIP_MEMORY_SCOPE_WORKGROUP);
        }
        __syncthreads();
        if (tid < 32) ((int*)(ws + WS_TAB + TAB_CNT))[ck * 32 + tid] = hist[tid];
        __syncthreads();
    }
}

__device__ __forceinline__ void moe_slots(const Params& P, LAS unsigned char* lds, int tid, int c, int G) {
    unsigned char* ws = WS_OPAQUE(P.ws);
    const int* cnt = (const int*)(ws + WS_TAB + TAB_CNT); const int* eid = (const int*)(ws + WS_TAB + TAB_EID);
    int* row_tok = (int*)(ws + WS_TAB + TAB_ROWTOK); int* slot_of = (int*)(ws + WS_TAB + TAB_SLOTOF);
    LAS int* tot = (LAS int*)lds; LAS int* bef = tot + 32; LAS int* ps = bef + 32; LAS int* eb = ps + 64;
    for (int ck = c; ck < T / 256; ck += G) {
        __syncthreads();
        { const int e_ = tid & 31, part = tid >> 5; int t = 0, b = 0; int cv[16];
#pragma unroll
          for (int k2 = 0; k2 < 16; ++k2) cv[k2] = cnt[(part * 16 + k2) * 32 + e_];
          asm volatile("" ::: "memory");
#pragma unroll
          for (int k2 = 0; k2 < 16; ++k2) PIN(cv[k2]);
#pragma unroll
          for (int k2 = 0; k2 < 16; ++k2) { const int k = part * 16 + k2; const int v = cv[k2]; t += v; b += (k < ck) ? v : 0; }
          LAS int* pt = eb + 512; pt[tid] = t; pt[512 + tid] = b; }
        eb[tid] = eid[ck * 512 + tid];
        __syncthreads();
        if (tid < 32) { const LAS int* pt = eb + 512; int t = 0, b = 0;
#pragma unroll
          for (int p = 0; p < 16; ++p) { t += pt[p * 32 + tid]; b += pt[512 + p * 32 + tid]; }
          tot[tid] = t; bef[tid] = b; }
        __syncthreads();
        if (tid == 0) { int s = 0; for (int e = 0; e < 32; ++e) { ps[e] = s; s += (tot[e] + 255) & ~255; } ps[32] = s; }
        __syncthreads();
        const int e = eb[tid]; int rank = 0;
        {   LAS int* wcnt = eb + 1536;
            const int wv_ = tid >> 6;
#pragma unroll 4
            for (int ev = 0; ev < 32; ++ev) { const unsigned long long m = __builtin_amdgcn_ballot_w64(e == ev);
                const int below = (int)__builtin_amdgcn_mbcnt_hi((unsigned)(m >> 32), __builtin_amdgcn_mbcnt_lo((unsigned)m, 0u));
                if (e == ev) rank = below;
                if ((tid & 63) == 0) wcnt[wv_ * 32 + ev] = __popcll(m); }
            __syncthreads();
            for (int w2 = 0; w2 < wv_; ++w2) rank += wcnt[w2 * 32 + e];
        }
        const int slot = ps[e] + bef[e] + rank;
        row_tok[slot] = (ck * 512 + tid) >> 1; slot_of[ck * 512 + tid] = slot;
        __syncthreads();
        eb[tid] = slot;
        __syncthreads();
        { const unsigned char* Hh = ws + WS_H8M; unsigned char* X = ws + WS_XROWS; const int lane = tid & 63, wv = tid >> 6;
          const float* sa = (const float*)(ws + WS_TAB + TAB_SA); float* xs = (float*)(ws + WS_TAB + TAB_XS);
          for (int i0 = 0; i0 < 32; i0 += 8) {
              v4u a[8]; float sc[8];
#pragma unroll
              for (int k = 0; k < 8; ++k) { const int tl = wv + 8 * (i0 + k); a[k] = *((const v4u*)(Hh + (size_t)(ck * 256 + tl) * D) + lane); sc[k] = sa[ck * 256 + tl]; }
              asm volatile("" ::: "memory");
#pragma unroll
              for (int k = 0; k < 8; ++k) { const int tl = wv + 8 * (i0 + k); const int s0 = eb[2 * tl], s1 = eb[2 * tl + 1];
                  *((v4u*)(X + (size_t)s0 * D) + lane) = a[k]; *((v4u*)(X + (size_t)s1 * D) + lane) = a[k];
                  if (lane == 0) { xs[s0] = sc[k]; xs[s1] = sc[k]; } } } }
        if (ck == 0) {
            int* tile_e = (int*)(ws + WS_TAB + TAB_TILEE);
            if (tid <= 32) tile_e[tid] = ps[tid] >> 8;
            if (tid == 0) *(int*)(ws + WS_TAB + TAB_NT) = ps[32] >> 8;
        }
    }
    __syncthreads();
}
__device__ __forceinline__ void moe_gather(const Params& P, int lane, int gw, int NGW) {
    unsigned char* ws = WS_OPAQUE(P.ws);
    const int nslots = *(const int*)(ws + WS_TAB + TAB_NT) * 256; const int* row_tok = (const int*)(ws + WS_TAB + TAB_ROWTOK);
    const bf16* H = (const bf16*)(ws + WS_H); bf16* X = (bf16*)(ws + WS_XROWS);
    for (int s = gw; s < nslots; s += NGW) { const int t = row_tok[s];
        const v4u* sp = (const v4u*)(H + (size_t)t * D) + lane; v4u* dp = (v4u*)(X + (size_t)s * D) + lane;
        const v4u a = sp[0], b = sp[64]; dp[0] = a; dp[64] = b; }
}

constexpr int R1_AW = 0, R1_AA = 4608, R1_AG = 9216, R1_LW = 17920, R1_LSTR = 1040, R1_LA = R1_LW + 32 * R1_LSTR, R1_LG = R1_LA + 32 * R1_LSTR;
#define R1_SYNC() do { asm volatile("s_waitcnt lgkmcnt(0)" ::: "memory"); __builtin_amdgcn_s_barrier(); asm volatile("" ::: "memory"); } while (0)
__device__ __forceinline__ void rwkv_prep(const Params& P, int l, LAS unsigned char* lds, int tid, int lane, int wave, int c, int G) {
    unsigned char* ws = WS_OPAQUE(P.ws);
    const bf16* PR = (const bf16*)(ws + WS_PRW);
    bf16* SI = (bf16*)(ws + WS_SI); bf16* E1 = (bf16*)(ws + WS_E1); bf16* GT = (bf16*)(ws + WS_GT);
    const bf16* lot = (const bf16*)(ws + WS_LOT) + (size_t)l * 131072;
    const float* mu = (const float*)P.in[12] + l * N_RWKV;
    const float* w0 = (const float*)P.in[13] + l * MW; const float* a0 = (const float*)P.in[15] + l * MW;
    const float* k_k = (const float*)P.in[18] + l * MW; const float* k_a = (const float*)P.in[19] + l * MW; const float* r_k = (const float*)P.in[20] + l * MW;
    float p_mr[8], p_mk[8], p_mv[8], p_w0[8], p_a0[8], p_kk[8], p_ka[8], p_rk[8];
#pragma unroll
    for (int j = 0; j < 8; ++j) { const int ch = lane * 8 + j; p_mr[j] = mu[ch]; p_mk[j] = mu[512 + ch]; p_mv[j] = mu[1024 + ch]; p_w0[j] = w0[ch]; p_a0[j] = a0[ch]; p_kk[j] = k_k[ch]; p_ka[j] = k_a[ch]; p_rk[j] = r_k[ch]; }
    for (int it = c; it < NB * (SEQ / 32); it += G) {
        const int b = it / (SEQ / 32), t0 = (it % (SEQ / 32)) * 32;
        R1_SYNC();
        {
            const int tok = tid >> 4, cg = tid & 15, t = t0 + tok;
            const bf16* cur = PR + ((size_t)(b * SEQ + t)) * N_RWKV + 1536 + cg * 16;
            const v4u c0 = *(const v4u*)cur, c1 = *(const v4u*)(cur + 8);
            v4u p0 = (v4u){0u, 0u, 0u, 0u}, p1 = p0;
            if (t > 0) { p0 = *(const v4u*)(cur - N_RWKV); p1 = *(const v4u*)(cur - N_RWKV + 8); }
            const float* mp = mu + 1536 + cg * 16;
            float x[16];
            const unsigned cw[8] = {c0.x, c0.y, c0.z, c0.w, c1.x, c1.y, c1.z, c1.w}, pw[8] = {p0.x, p0.y, p0.z, p0.w, p1.x, p1.y, p1.z, p1.w};
#pragma unroll
            for (int j = 0; j < 8; ++j) { const float a = bflo(cw[j]), bq = bfhi(cw[j]), pa = bflo(pw[j]), pb = bfhi(pw[j]);
                x[2 * j] = a + mp[2 * j] * (pa - a); x[2 * j + 1] = bq + mp[2 * j + 1] * (pb - bq); }
            LAS unsigned char* dst;
            if (cg < 4) {
#pragma unroll
                for (int j = 0; j < 16; ++j) { const float e = __expf(2.0f * x[j]); x[j] = 1.0f - 2.0f * __builtin_amdgcn_rcpf(e + 1.0f); }
                dst = lds + R1_AW + tok * 144 + cg * 32;
            } else if (cg < 8) { dst = lds + R1_AA + tok * 144 + (cg - 4) * 32;
            } else {
#pragma unroll
                for (int j = 0; j < 16; ++j) x[j] = sigm(x[j]);
                dst = lds + R1_AG + tok * 272 + (cg - 8) * 32;
            }
            v4u o0, o1; o0.x = pk2(x[0], x[1]); o0.y = pk2(x[2], x[3]); o0.z = pk2(x[4], x[5]); o0.w = pk2(x[6], x[7]);
            o1.x = pk2(x[8], x[9]); o1.y = pk2(x[10], x[11]); o1.z = pk2(x[12], x[13]); o1.w = pk2(x[14], x[15]);
            *(LAS v4u*)dst = o0; *(LAS v4u*)(dst + 16) = o1;
        }
        R1_SYNC();
        {
            const int r = lane & 31, hh = lane >> 5;
#pragma unroll
            for (int which = 0; which < 3; ++which) {
                const int KL = (which == 2) ? 128 : 64;
                const bf16* lo = lot + (which == 0 ? 0 : which == 1 ? 32768 : 65536);
                const LAS unsigned char* at = lds + (which == 0 ? R1_AW : which == 1 ? R1_AA : R1_AG) + r * (which == 2 ? 272 : 144) + hh * 16;
                LAS unsigned char* outp = lds + (which == 0 ? R1_LW : which == 1 ? R1_LA : R1_LG);
#pragma unroll
                for (int blk = 0; blk < 2; ++blk) {
                    f32x16 acc;
#pragma unroll
                    for (int q = 0; q < 16; ++q) acc[q] = 0.f;
                    const bf16* arow = lo + (size_t)(wave * 64 + blk * 32 + r) * KL + hh * 8;
#pragma unroll
                    for (int s = 0; s < KL / 16; ++s) {
                        const bf16x8 af = *(const bf16x8*)(arow + s * 16);
                        const bf16x8 bfr = *(const LAS bf16x8*)(at + s * 32);
                        acc = __builtin_amdgcn_mfma_f32_32x32x16_bf16(af, bfr, acc, 0, 0, 0);
                    }
#pragma unroll
                    for (int q4 = 0; q4 < 4; ++q4) { v2u o; o.x = pk2(acc[4 * q4], acc[4 * q4 + 1]); o.y = pk2(acc[4 * q4 + 2], acc[4 * q4 + 3]);
                        *(LAS v2u*)(outp + r * R1_LSTR + (wave * 64 + blk * 32 + 8 * q4 + 4 * hh) * 2) = o; }
                }
            }
        }
        R1_SYNC();
        v4u nx[6];
        { const int t = t0 + wave; const bf16* cur = PR + ((size_t)(b * SEQ + t)) * N_RWKV + lane * 8;
          nx[0] = *(const v4u*)cur; nx[1] = *(const v4u*)(cur + 512); nx[2] = *(const v4u*)(cur + 1024);
          if (t > 0) { nx[3] = *(const v4u*)(cur - N_RWKV); nx[4] = *(const v4u*)(cur - N_RWKV + 512); nx[5] = *(const v4u*)(cur - N_RWKV + 1024); } else { nx[3] = (v4u){0u, 0u, 0u, 0u}; nx[4] = nx[3]; nx[5] = nx[3]; } }
#pragma unroll 1
        for (int q = 0; q < 4; ++q) {
            const int tok = wave + 8 * q, t = t0 + tok, c0 = lane * 8, head = lane >> 3;
            const v4u cr = nx[0], ck = nx[1], cv = nx[2], pr = nx[3], pk = nx[4], pv = nx[5];
            if (q < 3) { const bf16* cur = PR + ((size_t)(b * SEQ + t + 8)) * N_RWKV + c0;
                nx[0] = *(const v4u*)cur; nx[1] = *(const v4u*)(cur + 512); nx[2] = *(const v4u*)(cur + 1024);
                nx[3] = *(const v4u*)(cur - N_RWKV); nx[4] = *(const v4u*)(cur - N_RWKV + 512); nx[5] = *(const v4u*)(cur - N_RWKV + 1024); }
            const v4u lw = *(const LAS v4u*)(lds + R1_LW + tok * R1_LSTR + c0 * 2), la = *(const LAS v4u*)(lds + R1_LA + tok * R1_LSTR + c0 * 2), lg = *(const LAS v4u*)(lds + R1_LG + tok * R1_LSTR + c0 * 2);
            const unsigned crw[4] = {cr.x, cr.y, cr.z, cr.w}, ckw[4] = {ck.x, ck.y, ck.z, ck.w}, cvw[4] = {cv.x, cv.y, cv.z, cv.w};
            const unsigned prw[4] = {pr.x, pr.y, pr.z, pr.w}, pkw[4] = {pk.x, pk.y, pk.z, pk.w}, pvw[4] = {pv.x, pv.y, pv.z, pv.w};
            const unsigned lww[4] = {lw.x, lw.y, lw.z, lw.w}, law[4] = {la.x, la.y, la.z, la.w}, lgw[4] = {lg.x, lg.y, lg.z, lg.w};
            float rr[8], ww[8], kt[8], vv[8], kk[8], aa[8], gg[8];
            float skk = 0.f, bon = 0.f;
#pragma unroll
            for (int j = 0; j < 8; ++j) {
                const int wi = j >> 1; const bool hi = j & 1;
                const float r_c = hi ? bfhi(crw[wi]) : bflo(crw[wi]), r_p = hi ? bfhi(prw[wi]) : bflo(prw[wi]);
                const float k_c = hi ? bfhi(ckw[wi]) : bflo(ckw[wi]), k_p = hi ? bfhi(pkw[wi]) : bflo(pkw[wi]);
                const float v_c = hi ? bfhi(cvw[wi]) : bflo(cvw[wi]), v_p = hi ? bfhi(pvw[wi]) : bflo(pvw[wi]);
                const float r = r_c + p_mr[j] * (r_p - r_c), k = k_c + p_mk[j] * (k_p - k_c), v = v_c + p_mv[j] * (v_p - v_c);
                const float lwv = hi ? bfhi(lww[wi]) : bflo(lww[wi]), lav = hi ? bfhi(law[wi]) : bflo(law[wi]), lgv = hi ? bfhi(lgw[wi]) : bflo(lgw[wi]);
                const float w = __expf(-0.6065306597126334f * sigm(p_w0[j] + lwv));
                const float a = sigm(p_a0[j] + lav);
                const float kkv = k * p_kk[j];
                const float ktv = k * (1.0f + (a - 1.0f) * p_ka[j]);
                skk += kkv * kkv; bon += r * ktv * p_rk[j];
                rr[j] = r; ww[j] = w; kt[j] = ktv; vv[j] = v; kk[j] = kkv; aa[j] = a; gg[j] = lgv;
            }
            skk = sum8(skk); bon = sum8(bon);
            const float inv = rsqrtf(fmaxf(skk, 1e-12f));
            bf16* so = SI + (((size_t)(b * 8 + head)) * SEQ + t) * 384 + (lane & 7) * 8;
            v4u o;
            o.x = pk2(rr[0], rr[1]); o.y = pk2(rr[2], rr[3]); o.z = pk2(rr[4], rr[5]); o.w = pk2(rr[6], rr[7]); *(v4u*)(so) = o;
            o.x = pk2(ww[0], ww[1]); o.y = pk2(ww[2], ww[3]); o.z = pk2(ww[4], ww[5]); o.w = pk2(ww[6], ww[7]); *(v4u*)(so + 64) = o;
            o.x = pk2(kt[0], kt[1]); o.y = pk2(kt[2], kt[3]); o.z = pk2(kt[4], kt[5]); o.w = pk2(kt[6], kt[7]); *(v4u*)(so + 128) = o;
            o.x = pk2(vv[0], vv[1]); o.y = pk2(vv[2], vv[3]); o.z = pk2(vv[4], vv[5]); o.w = pk2(vv[6], vv[7]); *(v4u*)(so + 192) = o;
#pragma unroll
            for (int j = 0; j < 8; ++j) { kk[j] *= inv; aa[j] *= kk[j]; }
            o.x = pk2(kk[0], kk[1]); o.y = pk2(kk[2], kk[3]); o.z = pk2(kk[4], kk[5]); o.w = pk2(kk[6], kk[7]); *(v4u*)(so + 256) = o;
            o.x = pk2(aa[0], aa[1]); o.y = pk2(aa[2], aa[3]); o.z = pk2(aa[4], aa[5]); o.w = pk2(aa[6], aa[7]); *(v4u*)(so + 320) = o;
            const size_t eo = ((size_t)(b * SEQ + t)) * MW + c0;
            o.x = pk2(bon * vv[0], bon * vv[1]); o.y = pk2(bon * vv[2], bon * vv[3]); o.z = pk2(bon * vv[4], bon * vv[5]); o.w = pk2(bon * vv[6], bon * vv[7]); *(v4u*)(E1 + eo) = o;
            o.x = pk2(gg[0], gg[1]); o.y = pk2(gg[2], gg[3]); o.z = pk2(gg[4], gg[5]); o.w = pk2(gg[6], gg[7]); *(v4u*)(GT + eo) = o;
        }
    }
    R1_SYNC();
}

constexpr int SC_TB = 32, SC_STEP = 336  , SC_BUF = SC_TB * SC_STEP * 4  , SC_NBUF = 3;
__device__ __forceinline__ void sc_load(const bf16* blk, int tl, v4u (&rg)[6]) {
#pragma unroll
    for (int p = 0; p < 6; ++p) rg[p] = *(const v4u*)(blk + (size_t)(tl + 256 * p) * 8);
}
__device__ __forceinline__ void sc_store(LAS float* buf, int tl, int quarter, const v4u (&rg)[6]) {
#pragma unroll
    for (int p = 0; p < 6; ++p) {
        const int ck = tl + 256 * p, step = ck / 48, cw = ck % 48, q = cw >> 3, j0 = (cw & 7) * 8;
        int off;
        if (q == 3) { const int jj = j0 - 16 * quarter; if (jj < 0 || jj >= 16) continue; off = 320 + jj; }
        else { const int slot = (q == 0) ? 4 : (q == 1) ? 1 : (q == 2) ? 3 : (q == 4) ? 0 : 2; off = slot * 64 + j0; }
        LAS float* d = buf + step * SC_STEP + off;
        const v4u w = rg[p];
        *(LAS f32x4*)d = (f32x4){bflo(w.x), bfhi(w.x), bflo(w.y), bfhi(w.y)};
        *(LAS f32x4*)(d + 4) = (f32x4){bflo(w.z), bfhi(w.z), bflo(w.w), bfhi(w.w)};
    }
}
__device__ __forceinline__ void rwkv_scan(const Params& P, LAS unsigned char* lds, int tid, int lane, int wave, int c, int G) {
    unsigned char* ws = WS_OPAQUE(P.ws);
    const bf16* SI = (const bf16*)(ws + WS_SI); bf16* O = (bf16*)(ws + WS_YRWKV);
    constexpr int NBLK = SEQ / SC_TB;
    for (int it = c; it < 256; it += G) {
        const int x = it & 7, y = it >> 3, bh = x * 8 + (y >> 2), quarter = y & 3;
        const bf16* sib = SI + (size_t)bh * SEQ * 384;
        const int b = bh >> 3, h = bh & 7;
        __syncthreads();
        if (wave >= 4) {
            const int tl = tid - 256; v4u rg[6];
            sc_load(sib, tl, rg); sc_store((LAS float*)(lds), tl, quarter, rg);
            sc_load(sib + (size_t)SC_TB * 384, tl, rg); sc_store((LAS float*)(lds + SC_BUF), tl, quarter, rg);
            sc_load(sib + (size_t)2 * SC_TB * 384, tl, rg);
            __syncthreads();
            for (int n = 0; n < NBLK; ++n) {
                if (n + 2 < NBLK) { sc_store((LAS float*)(lds + ((n + 2) % SC_NBUF) * SC_BUF), tl, quarter, rg);
                    if (n + 3 < NBLK) sc_load(sib + (size_t)(n + 3) * SC_TB * 384, tl, rg); }
                __syncthreads();
            }
        } else {
            typedef float f2 __attribute__((ext_vector_type(2)));
            const int kq = lane & 15, rg_ = lane >> 4, row = quarter * 16 + wave * 4 + rg_;
            f2 sA = {0.f, 0.f}, sB = {0.f, 0.f}; float yk = 0.f;
            __syncthreads();
            const LAS float* sp0 = (const LAS float*)lds;
            f32x4 kh = *(const LAS f32x4*)(sp0 + 4 * kq), w = *(const LAS f32x4*)(sp0 + 64 + 4 * kq), bb = *(const LAS f32x4*)(sp0 + 128 + 4 * kq);
            f32x4 kt = *(const LAS f32x4*)(sp0 + 192 + 4 * kq), r = *(const LAS f32x4*)(sp0 + 256 + 4 * kq); float v = sp0[320 + wave * 4 + rg_];
            const LAS float* sp1 = sp0 + SC_STEP;
            f32x4 kh_1 = *(const LAS f32x4*)(sp1 + 4 * kq), w_1 = *(const LAS f32x4*)(sp1 + 64 + 4 * kq), bb_1 = *(const LAS f32x4*)(sp1 + 128 + 4 * kq);
            f32x4 kt_1 = *(const LAS f32x4*)(sp1 + 192 + 4 * kq), r_1 = *(const LAS f32x4*)(sp1 + 256 + 4 * kq); float v_1 = sp1[320 + wave * 4 + rg_];
            for (int n = 0; n < NBLK; ++n) {
                const LAS float* buf = (const LAS float*)(lds + (n % SC_NBUF) * SC_BUF);
                const LAS float* nbuf = (const LAS float*)(lds + ((n + 1) % SC_NBUF) * SC_BUF);
#pragma unroll 4
                for (int st = 0; st < SC_TB; ++st) {
                    const LAS float* sp = (st >= SC_TB - 2) ? nbuf + (st - (SC_TB - 2)) * SC_STEP : buf + (st + 2) * SC_STEP;
                    const f32x4 kh_n = *(const LAS f32x4*)(sp + 4 * kq), w_n = *(const LAS f32x4*)(sp + 64 + 4 * kq), bb_n = *(const LAS f32x4*)(sp + 128 + 4 * kq);
                    const f32x4 kt_n = *(const LAS f32x4*)(sp + 192 + 4 * kq), r_n = *(const LAS f32x4*)(sp + 256 + 4 * kq); const float v_n = sp[320 + wave * 4 + rg_];
                    asm volatile("" ::: "memory");
                    f2 t = sA * (f2){kh[0], kh[1]}; t = sB * (f2){kh[2], kh[3]} + t;
                    float sk = sum16(t[0] + t[1]);
                    const f2 nsk = {-sk, -sk}, vv = {v, v};
                    f2 uA = vv * (f2){kt[0], kt[1]}, uB = vv * (f2){kt[2], kt[3]};
                    uA = nsk * (f2){bb[0], bb[1]} + uA; uB = nsk * (f2){bb[2], bb[3]} + uB;
                    sA = sA * (f2){w[0], w[1]} + uA; sB = sB * (f2){w[2], w[3]} + uB;
                    f2 ty = sA * (f2){r[0], r[1]}; ty = sB * (f2){r[2], r[3]} + ty;
                    const float y = sum16(ty[0] + ty[1]);
                    yk = ((st & 15) == kq) ? y : yk;
                    if ((st & 15) == 15) {
                        const int t_ = n * SC_TB + (st & 16) + kq;
                        O[((size_t)(b * SEQ + t_)) * MW + h * 64 + row] = (bf16)(pk2(yk, 0.f) & 0xffffu);
                    }
                    kh = kh_1; w = w_1; bb = bb_1; kt = kt_1; r = r_1; v = v_1;
                    kh_1 = kh_n; w_1 = w_n; bb_1 = bb_n; kt_1 = kt_n; r_1 = r_n; v_1 = v_n;
                }
                __syncthreads();
            }
        }
    }
    __syncthreads();
}

__device__ __forceinline__ void rwkv_post(const Params& P, int l, int tid, int c, int G) {
    unsigned char* ws = WS_OPAQUE(P.ws);
    bf16* O = (bf16*)(ws + WS_YRWKV); const bf16* E1 = (const bf16*)(ws + WS_E1); const bf16* GT = (const bf16*)(ws + WS_GT);
    const float* gn = (const float*)P.in[21] + l * MW;
    for (size_t i = (size_t)c * NTHR + tid; i < (size_t)T * 64; i += (size_t)G * NTHR) {
        const int c0 = (int)(i & 63) * 8; const size_t off = (i >> 6) * MW + c0;
        const v4u ov = *(const v4u*)(O + off), ev = *(const v4u*)(E1 + off), gv = *(const v4u*)(GT + off);
        float o[8] = {bflo(ov.x), bfhi(ov.x), bflo(ov.y), bfhi(ov.y), bflo(ov.z), bfhi(ov.z), bflo(ov.w), bfhi(ov.w)};
        const float e[8] = {bflo(ev.x), bfhi(ev.x), bflo(ev.y), bfhi(ev.y), bflo(ev.z), bfhi(ev.z), bflo(ev.w), bfhi(ev.w)};
        const float g[8] = {bflo(gv.x), bfhi(gv.x), bflo(gv.y), bfhi(gv.y), bflo(gv.z), bfhi(gv.z), bflo(gv.w), bfhi(gv.w)};
        float s = 0.f;
#pragma unroll
        for (int j = 0; j < 8; ++j) s += o[j];
        const float mean = sum8(s) * (1.0f / 64.0f);
        float q = 0.f;
#pragma unroll
        for (int j = 0; j < 8; ++j) { o[j] -= mean; q += o[j] * o[j]; }
        const float rstd = rsqrtf(sum8(q) * (1.0f / 64.0f) + 64e-5f);
#pragma unroll
        for (int j = 0; j < 8; ++j) o[j] = (o[j] * rstd * gn[c0 + j] + e[j]) * g[j];
        v4u w; w.x = pk2(o[0], o[1]); w.y = pk2(o[2], o[3]); w.z = pk2(o[4], o[5]); w.w = pk2(o[6], o[7]);
        *(v4u*)(O + off) = w;
    }
}

constexpr int RT_STR = 272;
constexpr int RT_TILE = 128 * RT_STR;
__device__ __forceinline__ float ret_log2gamma(int h) { return __log2f(1.0f - exp2f(-5.0f - (float)h)); }
__device__ __forceinline__ void rot8(const v4u a, const v4u b, float pos, int d0, float scale, float (&o1)[8], float (&o2)[8]) {
    const unsigned aw[4] = {a.x, a.y, a.z, a.w}, bw[4] = {b.x, b.y, b.z, b.w};
#pragma unroll
    for (int j = 0; j < 8; ++j) {
        const float f = exp2f(-(float)(d0 + j) * (13.287712379549449f / 64.0f)) * 0.15915494309189535f;
        float rev = pos * f; rev = rev - floorf(rev);
        const float sn = __builtin_amdgcn_sinf(rev), cs = __builtin_amdgcn_cosf(rev);
        const float x1 = (j & 1) ? bfhi(aw[j >> 1]) : bflo(aw[j >> 1]), x2 = (j & 1) ? bfhi(bw[j >> 1]) : bflo(bw[j >> 1]);
        o1[j] = (x1 * cs - x2 * sn) * scale; o2[j] = (x1 * sn + x2 * cs) * scale;
    }
}
#define RT_SYNC() do { asm volatile("s_waitcnt lgkmcnt(0)" ::: "memory"); __builtin_amdgcn_s_barrier(); asm volatile("" ::: "memory"); } while (0)
struct RotLd { v4u a[2], b[2]; int pos[2]; };
__device__ __forceinline__ void rot_load(RotLd& r, const bf16* src, const int* pos, int tid, bool rowmajor) {
#pragma unroll
    for (int i = 0; i < 2; ++i) { const int p = tid + NTHR * i; const int j = rowmajor ? (p >> 3) : (p & 127), d0 = (rowmajor ? (p & 7) : (p >> 7)) * 8;
        const bf16* rp = src + (size_t)j * N_REST + d0; r.a[i] = *(const v4u*)rp; r.b[i] = *(const v4u*)(rp + 64); r.pos[i] = pos[j]; }
}
__device__ __forceinline__ void rot_store_rows(const RotLd& r, float scale, LAS unsigned char* dst, int tid) {
#pragma unroll
    for (int i = 0; i < 2; ++i) { const int p = tid + NTHR * i, j = p >> 3, d0 = (p & 7) * 8;
        float o1[8], o2[8]; rot8(r.a[i], r.b[i], (float)r.pos[i], d0, scale, o1, o2);
        v4u w1, w2; w1.x = pk2(o1[0], o1[1]); w1.y = pk2(o1[2], o1[3]); w1.z = pk2(o1[4], o1[5]); w1.w = pk2(o1[6], o1[7]);
        w2.x = pk2(o2[0], o2[1]); w2.y = pk2(o2[2], o2[3]); w2.z = pk2(o2[4], o2[5]); w2.w = pk2(o2[6], o2[7]);
        *(LAS v4u*)(dst + j * RT_STR + d0 * 2) = w1; *(LAS v4u*)(dst + j * RT_STR + (64 + d0) * 2) = w2; }
}
__device__ __forceinline__ void rot_store_cols(const RotLd& r, float l2g, LAS unsigned char* dst, int tid) {
#pragma unroll
    for (int i = 0; i < 2; ++i) { const int p = tid + NTHR * i, j = p & 127, d0 = (p >> 7) * 8;
        float o1[8], o2[8]; rot8(r.a[i], r.b[i], (float)r.pos[i], d0, 0.08838834764831845f * __builtin_amdgcn_exp2f(l2g * (float)(127 - j)), o1, o2);
#pragma unroll
        for (int q = 0; q < 8; ++q) { *(LAS bf16*)(dst + (d0 + q) * RT_STR + j * 2) = (bf16)(pk2(o1[q], 0.f) & 0xffffu); *(LAS bf16*)(dst + (64 + d0 + q) * RT_STR + j * 2) = (bf16)(pk2(o2[q], 0.f) & 0xffffu); } }
}
__device__ __forceinline__ void vt_load(v4u (&r)[4], const bf16* src, int tid) {
#pragma unroll
    for (int i = 0; i < 4; ++i) { const int p = tid + NTHR * i, j = p & 127, v0 = (p >> 7) * 8; r[i] = *(const v4u*)(src + (size_t)j * N_REST + v0); }
}
__device__ __forceinline__ void vt_store(const v4u (&r)[4], LAS unsigned char* dst, int tid) {
#pragma unroll
    for (int i = 0; i < 4; ++i) { const int p = tid + NTHR * i, j = p & 127, v0 = (p >> 7) * 8; const unsigned aw[4] = {r[i].x, r[i].y, r[i].z, r[i].w};
#pragma unroll
        for (int q = 0; q < 8; ++q) *(LAS bf16*)(dst + (v0 + q) * RT_STR + j * 2) = (bf16)((q & 1) ? (aw[q >> 1] >> 16) : (aw[q >> 1] & 0xffffu)); }
}
__device__ __forceinline__ void ret_kv(const Params& P, int half, LAS unsigned char* lds, int tid, int lane, int wave, int c, int G) {
    unsigned char* ws = WS_OPAQUE(P.ws);
    const bf16* PR = (const bf16*)(ws + WS_PREST); bf16* KV = (bf16*)(ws + WS_KV);
    const int* positions = (const int*)P.in[2];
    LAS unsigned char* KT = lds; LAS unsigned char* VT = lds + RT_TILE;
    RotLd kld; v4u vld[4];
    if (c < 1024) { const int bl = c >> 8, h = (c >> 6) & 3, ch = c & 63; const size_t row0 = (size_t)bl * SEQ + ch * 128;
        rot_load(kld, PR + row0 * N_REST + 512 + h * 128, positions + (size_t)(half * 4 + bl) * SEQ + ch * 128, tid, false); vt_load(vld, PR + row0 * N_REST + 1024 + h * 128, tid); }
    for (int it = c; it < 1024; it += G) {
        const int h = (it >> 6) & 3;
        const float l2g = ret_log2gamma(h);
        RT_SYNC();
        rot_store_cols(kld, l2g, KT, tid); vt_store(vld, VT, tid);
        if (it + G < 1024) { const int in_ = it + G, bl = in_ >> 8, hn = (in_ >> 6) & 3, ch = in_ & 63; const size_t row0 = (size_t)bl * SEQ + ch * 128;
            rot_load(kld, PR + row0 * N_REST + 512 + hn * 128, positions + (size_t)(half * 4 + bl) * SEQ + ch * 128, tid, false); vt_load(vld, PR + row0 * N_REST + 1024 + hn * 128, tid); }
        RT_SYNC();
        const int fr = lane & 15, g = lane >> 4;
        bf16x8 af[4];
#pragma unroll
        for (int s = 0; s < 4; ++s) af[s] = *(const LAS bf16x8*)(VT + (wave * 16 + fr) * RT_STR + (32 * s + 8 * g) * 2);
        bf16* kvo = KV + (size_t)it * 16384 + (size_t)(wave * 16 + fr) * 128 + 4 * g;
#pragma unroll
        for (int db = 0; db < 8; ++db) {
            f32x4 acc = (f32x4){0.f, 0.f, 0.f, 0.f};
#pragma unroll
            for (int s = 0; s < 4; ++s) { const bf16x8 bfr = *(const LAS bf16x8*)(KT + (db * 16 + fr) * RT_STR + (32 * s + 8 * g) * 2);
                acc = __builtin_amdgcn_mfma_f32_16x16x32_bf16(bfr, af[s], acc, 0, 0, 0); }
            { v2u o; o.x = pk2(acc[0], acc[1]); o.y = pk2(acc[2], acc[3]); *(v2u*)(kvo + db * 16) = o; }
        }
    }
    __syncthreads();
}
__device__ __forceinline__ void ret_state(const Params& P, int tid, int c, int G) {
    unsigned char* ws = WS_OPAQUE(P.ws);
    const bf16* KV = (const bf16*)(ws + WS_KV); bf16* SST = (bf16*)(ws + WS_SST);
    for (int gid = c * NTHR + tid; gid < 16 * 8192; gid += G * NTHR) {
        const int chain = gid >> 13, e = (gid & 8191) * 2, h = chain & 3;
        const float dc = exp2f(128.0f * ret_log2gamma(h));
        float s0 = 0.f, s1 = 0.f;
        const size_t off0 = (size_t)chain * 64 * 16384 + e;
        unsigned cur[16], nxt[16];
#pragma unroll
        for (int k = 0; k < 16; ++k) cur[k] = *(const unsigned*)(KV + off0 + (size_t)k * 16384);
#pragma unroll
        for (int b = 0; b < 4; ++b) {
            if (b < 3) {
#pragma unroll
                for (int k = 0; k < 16; ++k) nxt[k] = *(const unsigned*)(KV + off0 + (size_t)((b + 1) * 16 + k) * 16384); }
            asm volatile("" : "+v"(s0), "+v"(s1) :: "memory");
#pragma unroll
            for (int k = 0; k < 16; ++k) { *(unsigned*)(SST + off0 + (size_t)(b * 16 + k) * 16384) = pk2(s0, s1); s0 = s0 * dc + bflo(cur[k]); s1 = s1 * dc + bfhi(cur[k]); }
#pragma unroll
            for (int k = 0; k < 16; ++k) cur[k] = nxt[k];
        }
    }
}
__device__ __forceinline__ void ret_out(const Params& P, int l, int half, LAS unsigned char* lds, int tid, int lane, int wave, int c, int G) {
    unsigned char* ws = WS_OPAQUE(P.ws);
    const bf16* PR = (const bf16*)(ws + WS_PREST); const bf16* SST = (const bf16*)(ws + WS_SST); bf16* YR = (bf16*)(ws + WS_YRET);
    const int* positions = (const int*)P.in[2];
    const float* gn = (const float*)P.in[11] + l * MW;
    LAS unsigned char* QL = lds; LAS unsigned char* KL = lds + RT_TILE; LAS unsigned char* VT = lds + 2 * RT_TILE; LAS unsigned char* ST = lds + 3 * RT_TILE;
    RotLd qld, kld; v4u vld[4], sld[4];
    if (c < 1024) { const int bl = c >> 8, h = (c >> 6) & 3, ch = c & 63; const size_t row0 = (size_t)bl * SEQ + ch * 128; const int* pos = positions + (size_t)(half * 4 + bl) * SEQ + ch * 128;
        rot_load(qld, PR + row0 * N_REST + h * 128, pos, tid, true); rot_load(kld, PR + row0 * N_REST + 512 + h * 128, pos, tid, true); vt_load(vld, PR + row0 * N_REST + 1024 + h * 128, tid);
#pragma unroll
        for (int i = 0; i < 4; ++i) sld[i] = *(const v4u*)(SST + (size_t)c * 16384 + (size_t)(tid + NTHR * i) * 8); }
    for (int it = c; it < 1024; it += G) {
        const int bl = it >> 8, h = (it >> 6) & 3, ch = it & 63;
        const size_t row0 = (size_t)bl * SEQ + ch * 128;
        const float l2g = ret_log2gamma(h);
        RT_SYNC();
        rot_store_rows(qld, 1.0f, QL, tid); rot_store_rows(kld, 0.08838834764831845f, KL, tid); vt_store(vld, VT, tid);
#pragma unroll
        for (int i = 0; i < 4; ++i) { const int p = tid + NTHR * i; *(LAS v4u*)(ST + (p >> 4) * RT_STR + (p & 15) * 16) = sld[i]; }
        if (it + G < 1024) { const int in_ = it + G, bn = in_ >> 8, hn = (in_ >> 6) & 3, cn = in_ & 63; const size_t rn = (size_t)bn * SEQ + cn * 128; const int* pos = positions + (size_t)(half * 4 + bn) * SEQ + cn * 128;
            rot_load(qld, PR + rn * N_REST + hn * 128, pos, tid, true); rot_load(kld, PR + rn * N_REST + 512 + hn * 128, pos, tid, true); vt_load(vld, PR + rn * N_REST + 1024 + hn * 128, tid);
#pragma unroll
            for (int i = 0; i < 4; ++i) sld[i] = *(const v4u*)(SST + (size_t)in_ * 16384 + (size_t)(tid + NTHR * i) * 8); }
        RT_SYNC();
        const int fr = lane & 15, g = lane >> 4;
        bf16x8 qf[4];
#pragma unroll
        for (int s = 0; s < 4; ++s) qf[s] = *(const LAS bf16x8*)(QL + (wave * 16 + fr) * RT_STR + (32 * s + 8 * g) * 2);
        f32x4 acc[8];
#pragma unroll
        for (int vb = 0; vb < 8; ++vb) { acc[vb] = (f32x4){0.f, 0.f, 0.f, 0.f};
#pragma unroll
            for (int s = 0; s < 4; ++s) { const bf16x8 a = *(const LAS bf16x8*)(ST + (vb * 16 + fr) * RT_STR + (32 * s + 8 * g) * 2);
                acc[vb] = __builtin_amdgcn_mfma_f32_16x16x32_bf16(a, qf[s], acc[vb], 0, 0, 0); } }
        const int il = wave * 16 + fr;
        const float xi = exp2f(l2g * (float)(il + 1));
#pragma unroll
        for (int vb = 0; vb < 8; ++vb) acc[vb] *= xi;
        const bf16* gp = PR + (row0 + il) * N_REST + 1536 + h * 128 + 4 * g;
        const float* gnp = gn + h * 128 + 4 * g;
        v2u gvl[8]; f32x4 gml[8];
#pragma unroll
        for (int vb = 0; vb < 8; ++vb) { gvl[vb] = *(const v2u*)(gp + vb * 16); gml[vb] = *(const f32x4*)(gnp + vb * 16); }
        asm volatile("" ::: "memory");
        for (int s2 = 0; s2 <= (wave >> 1); ++s2) {
            f32x4 p0 = (f32x4){0.f, 0.f, 0.f, 0.f}, p1 = p0;
            const int jb0 = 2 * s2, jb1 = 2 * s2 + 1;
#pragma unroll
            for (int s = 0; s < 4; ++s) { const bf16x8 a = *(const LAS bf16x8*)(KL + (jb0 * 16 + fr) * RT_STR + (32 * s + 8 * g) * 2);
                p0 = __builtin_amdgcn_mfma_f32_16x16x32_bf16(a, qf[s], p0, 0, 0, 0); }
            if (jb1 <= wave) {
#pragma unroll
                for (int s = 0; s < 4; ++s) { const bf16x8 a = *(const LAS bf16x8*)(KL + (jb1 * 16 + fr) * RT_STR + (32 * s + 8 * g) * 2);
                    p1 = __builtin_amdgcn_mfma_f32_16x16x32_bf16(a, qf[s], p1, 0, 0, 0); }
            }
#pragma unroll
            for (int r = 0; r < 4; ++r) { const int d0 = il - (jb0 * 16 + 4 * g + r), d1 = il - (jb1 * 16 + 4 * g + r);
                p0[r] = d0 >= 0 ? p0[r] * exp2f(l2g * (float)d0) : 0.f; p1[r] = d1 >= 0 ? p1[r] * exp2f(l2g * (float)d1) : 0.f; }
            v4u pw; pw.x = pk2(p0[0], p0[1]); pw.y = pk2(p0[2], p0[3]); pw.z = pk2(p1[0], p1[1]); pw.w = pk2(p1[2], p1[3]);
            const bf16x8 pf = __builtin_bit_cast(bf16x8, pw);
#pragma unroll
            for (int vb = 0; vb < 8; ++vb) {
                const LAS unsigned char* vp = VT + (vb * 16 + fr) * RT_STR + (32 * s2 + 4 * g) * 2;
                const v2u lo = *(const LAS v2u*)vp, hi = *(const LAS v2u*)(vp + 32);
                const v4u aw = (v4u){lo.x, lo.y, hi.x, hi.y};
                acc[vb] = __builtin_amdgcn_mfma_f32_16x16x32_bf16(__builtin_bit_cast(bf16x8, aw), pf, acc[vb], 0, 0, 0);
            }
        }
        float s = 0.f;
#pragma unroll
        for (int vb = 0; vb < 8; ++vb) s += (acc[vb][0] + acc[vb][1]) + (acc[vb][2] + acc[vb][3]);
        s += xor_lane(s, lane, 16); s += xor_lane(s, lane, 32);
        const float mean = s * (1.0f / 128.0f);
        float q = 0.f;
#pragma unroll
        for (int vb = 0; vb < 8; ++vb) { acc[vb] -= mean; q += (acc[vb][0] * acc[vb][0] + acc[vb][1] * acc[vb][1]) + (acc[vb][2] * acc[vb][2] + acc[vb][3] * acc[vb][3]); }
        q += xor_lane(q, lane, 16); q += xor_lane(q, lane, 32);
        const float rstd = rsqrtf(q * (1.0f / 128.0f) + 1e-5f);
        bf16* yp = YR + (row0 + il) * MW + h * 128 + 4 * g;
#pragma unroll
        for (int vb = 0; vb < 8; ++vb) { PIN(gvl[vb]); PIN(gml[vb]); }
#pragma unroll
        for (int vb = 0; vb < 8; ++vb) { const v2u gv = gvl[vb]; const f32x4 gm = gml[vb];
            const float g0 = bflo(gv.x), g1 = bfhi(gv.x), g2 = bflo(gv.y), g3 = bfhi(gv.y);
            const float y0 = acc[vb][0] * rstd * gm[0] * (g0 * sigm(g0)), y1 = acc[vb][1] * rstd * gm[1] * (g1 * sigm(g1));
            const float y2 = acc[vb][2] * rstd * gm[2] * (g2 * sigm(g2)), y3 = acc[vb][3] * rstd * gm[3] * (g3 * sigm(g3));
            v2u o; o.x = pk2(y0, y1); o.y = pk2(y2, y3); *(v2u*)(yp + vb * 16) = o; }
    }
    __syncthreads();
}
__device__ __forceinline__ void conv_phase(const Params& P, int l, int tid, int c, int G) {
    unsigned char* ws = WS_OPAQUE(P.ws);
    const bf16* PR = (const bf16*)(ws + WS_PREST); bf16* YC = (bf16*)(ws + WS_YCONV);
    const float* cw = (const float*)P.in[22] + l * 3 * MW;
    for (int i = c * NTHR + tid; i < HT * 4; i += G * NTHR) {
        const int c0 = (i & 63) * 8; const size_t row0 = (size_t)(i >> 6) * 16; const int t0 = (int)(row0 & (SEQ - 1));
        const bf16* rp = PR + row0 * N_REST + 2048 + c0;
        float w0[8], w1[8], w2[8];
#pragma unroll
        for (int j = 0; j < 8; ++j) { w0[j] = cw[c0 + j]; w1[j] = cw[MW + c0 + j]; w2[j] = cw[2 * MW + c0 + j]; }
        v4u hb[4], cb[4], gb[4], hn[4], cn[4], gn[4]; v4u ph0 = {0u, 0u, 0u, 0u}, pc0 = ph0, ph1 = ph0, pc1 = ph0;
        if (t0 > 0) { ph0 = *(const v4u*)(rp - 2 * (size_t)N_REST); pc0 = *(const v4u*)(rp - 2 * (size_t)N_REST + 1024); ph1 = *(const v4u*)(rp - (size_t)N_REST); pc1 = *(const v4u*)(rp - (size_t)N_REST + 1024); }
#pragma unroll
        for (int k = 0; k < 4; ++k) { const bf16* q = rp + (size_t)k * N_REST; hb[k] = *(const v4u*)q; cb[k] = *(const v4u*)(q + 1024); gb[k] = *(const v4u*)(q + 512); }
        float um2[8], um1[8];
        { float a[8], b2[8]; unpk8(ph0, a); unpk8(pc0, b2);
#pragma unroll
          for (int j = 0; j < 8; ++j) um2[j] = a[j] * b2[j];
          unpk8(ph1, a); unpk8(pc1, b2);
#pragma unroll
          for (int j = 0; j < 8; ++j) um1[j] = a[j] * b2[j]; }
#pragma unroll
        for (int b = 0; b < 4; ++b) {
            if (b < 3) {
#pragma unroll
                for (int k = 0; k < 4; ++k) { const bf16* q = rp + (size_t)((b + 1) * 4 + k) * N_REST; hn[k] = *(const v4u*)q; cn[k] = *(const v4u*)(q + 1024); gn[k] = *(const v4u*)(q + 512); } }
            asm volatile("" ::: "memory");
#pragma unroll
            for (int k = 0; k < 4; ++k) { PIN(hb[k]); PIN(cb[k]); PIN(gb[k]); }
#pragma unroll
            for (int k = 0; k < 4; ++k) { float hv[8], cv[8], bg[8], u[8], y[8]; unpk8(hb[k], hv); unpk8(cb[k], cv); unpk8(gb[k], bg);
#pragma unroll
                for (int j = 0; j < 8; ++j) { u[j] = hv[j] * cv[j]; y[j] = bg[j] * (w0[j] * um2[j] + w1[j] * um1[j] + w2[j] * u[j]); um2[j] = um1[j]; um1[j] = u[j]; }
                *(v4u*)(YC + (row0 + b * 4 + k) * MW + c0) = pk8(y); }
#pragma unroll
            for (int k = 0; k < 4; ++k) { hb[k] = hn[k]; cb[k] = cn[k]; gb[k] = gn[k]; }
        }
    }
}

constexpr int CK = 32, CK_NCH = SEQ / CK;
#ifndef CKREP
#define CKREP 0
#endif
constexpr size_t WS_CM = 464 * MiB, WS_CN = 528 * MiB, WS_CS = 592 * MiB;
constexpr size_t WS_CWX = 112 * MiB, WS_CUX = 144 * MiB, WS_CAX = 656 * MiB, WS_CRX = 976 * MiB;
constexpr int CK_ITEM = 67072;
constexpr int CK_RAW = 0, CK_LC = 24576, CK_AT = 33024, CK_BT = 37632, CK_KT = 42240, CK_RT = 46848, CK_BHT = 51456, CK_KHT = 56576, CK_VT = 61696, CK_GC = 66816;
constexpr int CK_AAB = 0, CK_AAK = 4096, CK_ARB = 6656, CK_ARK = 9216, CK_GT = 11776, CK_UTT = 11776, CK_WT = 20224, CK_WTT = 24832, CK_EX = 29952;
constexpr size_t WS_A8 = 688 * MiB;
constexpr int CK_FA = 33024, CK_FL = 51456;
constexpr int CK_RS = 144, CK_TS = 80, CK_GS = 132;

__device__ __forceinline__ bf16x8 ld_frag(const LAS unsigned char* p) { return *(const LAS bf16x8*)p; }
__device__ __forceinline__ bf16x8 ld_frag2(const LAS unsigned char* p0, const LAS unsigned char* p1) { const v2u a = *(const LAS v2u*)p0, b = *(const LAS v2u*)p1; const v4u w = (v4u){a.x, a.y, b.x, b.y}; return __builtin_bit_cast(bf16x8, w); }
__device__ __forceinline__ unsigned short bf1(float x) { return (unsigned short)(pk2(x, 0.f) & 0xffffu); }

__device__ __forceinline__ void rwkv_lora_in(const Params& P, int l, int tid, int c, int G) {
    unsigned char* ws = WS_OPAQUE(P.ws);
    const bf16* PR = (const bf16*)(ws + WS_PRW); bf16* A8 = (bf16*)(ws + WS_A8); const float* mu = (const float*)P.in[12] + l * N_RWKV + 1536;
    const int cg = tid & 15;
    const f32x4 mq[4] = {*(const f32x4*)(mu + cg * 16), *(const f32x4*)(mu + cg * 16 + 4), *(const f32x4*)(mu + cg * 16 + 8), *(const f32x4*)(mu + cg * 16 + 12)};
    for (int i0 = c * NTHR + tid; i0 < T * 16; i0 += 4 * G * NTHR) {
        v4u ca[4][2], pa[4][2];
#pragma unroll
        for (int k = 0; k < 4; ++k) { const int i = i0 + k * G * NTHR; const int row = i >> 4, t = row & (SEQ - 1);
            if (i < T * 16) { const bf16* cur = PR + (size_t)row * N_RWKV + 1536 + cg * 16;
#pragma unroll
                for (int q = 0; q < 2; ++q) { ca[k][q] = *(const v4u*)(cur + 8 * q); pa[k][q] = (t > 0) ? *(const v4u*)(cur - N_RWKV + 8 * q) : (v4u){0u, 0u, 0u, 0u}; } }
            else { ca[k][0] = ca[k][1] = pa[k][0] = pa[k][1] = (v4u){0u, 0u, 0u, 0u}; } }
        asm volatile("" ::: "memory");
#pragma unroll
        for (int k = 0; k < 4; ++k) { PIN(ca[k][0]); PIN(ca[k][1]); PIN(pa[k][0]); PIN(pa[k][1]); }
#pragma unroll
        for (int k = 0; k < 4; ++k) { const int i = i0 + k * G * NTHR; const int row = i >> 4;
            float x[16];
#pragma unroll
            for (int q = 0; q < 2; ++q) { float a[8], p[8]; unpk8(ca[k][q], a); unpk8(pa[k][q], p);
                const f32x4 m0 = mq[2 * q], m1 = mq[2 * q + 1];
#pragma unroll
                for (int j = 0; j < 8; ++j) { float v = a[j] + (j < 4 ? m0[j] : m1[j - 4]) * (p[j] - a[j]);
                    if (cg < 4) { const float e = __expf(2.0f * v); v = 1.0f - 2.0f * __builtin_amdgcn_rcpf(e + 1.0f); } else if (cg >= 8) v = sigm(v);
                    x[8 * q + j] = v; } }
            float lo8[8], hi8[8];
#pragma unroll
            for (int j = 0; j < 8; ++j) { lo8[j] = x[j]; hi8[j] = x[8 + j]; }
            if (i < T * 16) { *(v4u*)(A8 + (size_t)row * 256 + cg * 16) = pk8(lo8); *(v4u*)(A8 + (size_t)row * 256 + cg * 16 + 8) = pk8(hi8); } }
    }
}
struct FeLd { v4u lc[4], lp[4], rc[3], rp[3]; };
__device__ __forceinline__ void fe_load(FeLd& f, const bf16* PR, int b, int h, int t0, int tq) {
    const int tok = tq >> 3, g8 = tq & 7, t = t0 + tok;
    const bf16* row = PR + ((size_t)b * SEQ + t) * N_RWKV;
#pragma unroll
    for (int i = 0; i < 4; ++i) f.lc[i] = *(const v4u*)(row + 1536 + g8 * 32 + i * 8);
#pragma unroll
    for (int i = 0; i < 3; ++i) f.rc[i] = *(const v4u*)(row + i * 512 + 64 * h + g8 * 8);
    if (t > 0) {
#pragma unroll
        for (int i = 0; i < 4; ++i) f.lp[i] = *(const v4u*)(row - N_RWKV + 1536 + g8 * 32 + i * 8);
#pragma unroll
        for (int i = 0; i < 3; ++i) f.rp[i] = *(const v4u*)(row - N_RWKV + i * 512 + 64 * h + g8 * 8);
    } else {
#pragma unroll
        for (int i = 0; i < 4; ++i) f.lp[i] = (v4u){0u, 0u, 0u, 0u};
#pragma unroll
        for (int i = 0; i < 3; ++i) f.rp[i] = (v4u){0u, 0u, 0u, 0u};
    }
}
__device__ __forceinline__ void fe_load_rows(FeLd& f, const bf16* PR, int b, int h, int t0, int tq) {
    const int tok = tq >> 3, g8 = tq & 7, t = t0 + tok; const bf16* row = PR + ((size_t)b * SEQ + t) * N_RWKV;
#pragma unroll
    for (int i = 0; i < 3; ++i) f.rc[i] = *(const v4u*)(row + i * 512 + 64 * h + g8 * 8);
}
__device__ __forceinline__ void fe_load_prev(FeLd& f, const bf16* PR, int b, int h, int t0, int tq) {
    const int tok = tq >> 3, g8 = tq & 7, t = t0 + tok; const bf16* row = PR + ((size_t)b * SEQ + t) * N_RWKV;
#pragma unroll
    for (int i = 0; i < 3; ++i) f.rp[i] = (t > 0) ? *(const v4u*)(row - N_RWKV + i * 512 + 64 * h + g8 * 8) : (v4u){0u, 0u, 0u, 0u};
}
__device__ __forceinline__ void fe_load_lora(FeLd& f, const bf16* A8, int b, int t0, int tq) {
#pragma unroll
    for (int i = 0; i < 4; ++i) { const int p = tq + 256 * i; f.lc[i] = *(const v4u*)(A8 + ((size_t)b * SEQ + t0 + (p >> 5)) * 256 + (p & 31) * 8); }
}
#define CK_SYNC() do { asm volatile("s_waitcnt lgkmcnt(0)" ::: "memory"); __builtin_amdgcn_s_barrier(); asm volatile("" ::: "memory"); } while (0)
__device__ __forceinline__ void rwkv_chunk(const Params& P, int l, int hb, const bool ZMODE, LAS unsigned char* lds, int tid, int lane, int wave, int c, int G) {
    unsigned char* ws = WS_OPAQUE(P.ws);
    const bf16* PR = (const bf16*)(ws + WS_PRW); const bf16* lot = (const bf16*)(ws + WS_LOT) + (size_t)l * 131072;
    const float* mu = (const float*)P.in[12] + l * N_RWKV;
    const float* pw0 = (const float*)P.in[13] + l * MW; const float* pa0 = (const float*)P.in[15] + l * MW; const float* pkk = (const float*)P.in[18] + l * MW; const float* pka = (const float*)P.in[19] + l * MW; const float* prk = (const float*)P.in[20] + l * MW;
    bf16* Mo = (bf16*)(ws + WS_CM); bf16* No = (bf16*)(ws + WS_CN); const bf16* SS = (const bf16*)(ws + WS_CS);
    bf16* E1 = (bf16*)(ws + WS_E1); bf16* GTg = (bf16*)(ws + WS_GT); bf16* YO = (bf16*)(ws + WS_YRWKV);
    const float* gn = (const float*)P.in[21] + l * MW;
    const int ib = wave >> 2, W4RAW = wave & 3, w4 = (W4RAW + 2 * ib) & 3;
    LAS unsigned char* L = lds + ib * CK_ITEM;
    LAS float* PT = (LAS float*)(lds + 2 * CK_ITEM);
    if (!ZMODE) { const int a = tid >> 6, i8 = (tid & 63) * 8;
        const float* srcp = (a == 0) ? mu : (a == 1) ? mu + 512 : (a == 2) ? mu + 1024 : (a == 3) ? pw0 : (a == 4) ? pa0 : (a == 5) ? pkk : (a == 6) ? pka : prk;
        const f32x4 p0 = *(const f32x4*)(srcp + i8), p1 = *(const f32x4*)(srcp + i8 + 4);
        *(LAS f32x4*)(PT + a * 512 + i8) = p0; *(LAS f32x4*)(PT + a * 512 + i8 + 4) = p1; }
    else if (tid < 128) { const int a = tid >> 6, i8 = (tid & 63) * 8; const float* srcp = a ? gn : mu + 1024;
        const f32x4 p0 = *(const f32x4*)(srcp + i8), p1 = *(const f32x4*)(srcp + i8 + 4); *(LAS f32x4*)(PT + 1024 + a * 512 + i8) = p0; *(LAS f32x4*)(PT + 1024 + a * 512 + i8 + 4) = p1; }
    FeLd fe;
    if (c < 4096) { const int item0 = c * 2 + ib, tq = (W4RAW << 6) | lane, b0 = hb * 4 + (item0 >> 11), h0 = (item0 >> 8) & 7, t00 = (item0 & 255) * CK;
        if (!ZMODE) { fe_load_rows(fe, PR, b0, h0, t00, tq); fe_load_lora(fe, (const bf16*)(ws + WS_A8), b0, t00, tq); }
        else { const int t = t00 + (tq >> 3); const bf16* row = PR + ((size_t)b0 * SEQ + t) * N_RWKV + 1024 + 64 * h0 + (tq & 7) * 8; fe.lp[0] = *(const v4u*)row; fe.lp[1] = (t > 0) ? *(const v4u*)(row - N_RWKV) : (v4u){0u, 0u, 0u, 0u}; } }
    if (ZMODE && c < 4096) { const int item0 = c * 2 + ib, tq = (W4RAW << 6) | lane; const unsigned char* zb = ws + (size_t)item0 * 4096 + (size_t)tq * 16;
        fe.lc[0] = *(const v4u*)(zb + WS_CWX); fe.lc[1] = *(const v4u*)(zb + WS_CUX); fe.lc[2] = *(const v4u*)(zb + WS_CAX); fe.lc[3] = *(const v4u*)(zb + WS_CRX); }
    for (int pr = c; pr < 4096; pr += G) {
        int lane_ = lane; asm volatile("" : "+v"(lane_));
        const int r32 = lane_ & 31, hh = lane_ >> 5, t256 = (W4RAW << 6) | lane_;
        const int item = pr * 2 + ib, bhl = item >> 8, ch = item & 255, b = hb * 4 + (bhl >> 3), h = bhl & 7;
        CK_SYNC();
        const int itn = (pr + G) * 2 + ib, bn = hb * 4 + (itn >> 11), hn = (itn >> 8) & 7, tn0 = (itn & 255) * CK;
        if (!ZMODE) {
            const int tok = t256 >> 3, g8 = t256 & 7;
            fe_load_prev(fe, PR, b, h, ch * CK, t256);
            bf16x8 lf[8];
            { const int which = (w4 < 2) ? w4 : 2, KL = (w4 < 2) ? 64 : 128; const bf16* lo = lot + (which == 0 ? 0 : which == 1 ? 32768 : 65536);
#pragma unroll
              for (int i = 0; i < 8; ++i) { const int blk = (w4 < 2) ? (i >> 2) : (w4 - 2), s_ = (w4 < 2) ? (i & 3) : i; lf[i] = *(const bf16x8*)(lo + (size_t)(h * 64 + blk * 32 + r32) * KL + hh * 8 + s_ * 16); } }
            const v4u q_rc = fe.rc[0], q_rp = fe.rp[0], q_kc = fe.rc[1], q_kp = fe.rp[1], q_vc = fe.rc[2], q_vp = fe.rp[2];
            for (int rpf_ = 0; rpf_ < 1 + ((CKREP >> 3) & 1); ++rpf_) {
#pragma unroll
            for (int i = 0; i < 4; ++i) { const int p = t256 + 256 * i, row = p >> 5, col = (p & 31) * 8;
                *(LAS v4u*)(L + CK_FA + ((col < 64) ? row * 144 + col * 2 : (col < 128) ? 4608 + row * 144 + (col - 64) * 2 : 9216 + row * 272 + (col - 128) * 2)) = fe.lc[i]; }
            CK_SYNC();
            {
                const int which = (w4 < 2) ? w4 : 2, KL = (w4 < 2) ? 64 : 128;
                const bf16* lo = lot + (which == 0 ? 0 : which == 1 ? 32768 : 65536);
                const LAS unsigned char* at = L + CK_FA + (which == 0 ? 0 : which == 1 ? 4608 : 9216) + r32 * (which == 2 ? 272 : 144) + hh * 16;
                LAS unsigned char* outp = L + CK_FL + which * 4608;
                if (w4 < 2) {
#pragma unroll
                    for (int blk = 0; blk < 2; ++blk) {
                        f32x16 acc;
#pragma unroll
                        for (int q = 0; q < 16; ++q) acc[q] = 0.f;
#pragma unroll
                        for (int s_ = 0; s_ < 4; ++s_) acc = __builtin_amdgcn_mfma_f32_32x32x16_bf16(lf[blk * 4 + s_], ld_frag(at + s_ * 32), acc, 0, 0, 0);
#pragma unroll
                        for (int q4 = 0; q4 < 4; ++q4) { v2u o; o.x = pk2(acc[4 * q4], acc[4 * q4 + 1]); o.y = pk2(acc[4 * q4 + 2], acc[4 * q4 + 3]);
                            *(LAS v2u*)(outp + r32 * 144 + (blk * 32 + 8 * q4 + 4 * hh) * 2) = o; }
                    }
                } else {
                    const int blk = w4 - 2;
                    f32x16 acc;
#pragma unroll
                    for (int q = 0; q < 16; ++q) acc[q] = 0.f;
#pragma unroll
                    for (int s_ = 0; s_ < 8; ++s_) acc = __builtin_amdgcn_mfma_f32_32x32x16_bf16(lf[s_], ld_frag(at + s_ * 32), acc, 0, 0, 0);
#pragma unroll
                    for (int q4 = 0; q4 < 4; ++q4) { v2u o; o.x = pk2(acc[4 * q4], acc[4 * q4 + 1]); o.y = pk2(acc[4 * q4 + 2], acc[4 * q4 + 3]);
                        *(LAS v2u*)(outp + r32 * 144 + (blk * 32 + 8 * q4 + 4 * hh) * 2) = o; }
                }
            }
            CK_SYNC();
            {
                const int ch0 = h * 64 + g8 * 8, t = ch * CK + tok;
                float lwv[8], lav[8], lgv[8];
                unpk8(*(const LAS v4u*)(L + CK_FL + tok * 144 + g8 * 16), lwv); unpk8(*(const LAS v4u*)(L + CK_FL + 4608 + tok * 144 + g8 * 16), lav); unpk8(*(const LAS v4u*)(L + CK_FL + 9216 + tok * 144 + g8 * 16), lgv);
                float rr_[8], rp_[8], kc_[8], kp_[8], vc_[8], vp_[8];
                unpk8(q_rc, rr_); unpk8(q_rp, rp_); unpk8(q_kc, kc_); unpk8(q_kp, kp_); unpk8(q_vc, vc_); unpk8(q_vp, vp_);
                float rr[8], ww[8], kt[8], vv[8], kk[8], aa[8];
                float skk = 0.f, bon = 0.f;
#pragma unroll
                for (int q = 0; q < 2; ++q) {
                    const LAS float* pt = PT + ch0 + 4 * q;
                    const f32x4 mr = *(const LAS f32x4*)pt, mk = *(const LAS f32x4*)(pt + 512), mv = *(const LAS f32x4*)(pt + 1024), w0v = *(const LAS f32x4*)(pt + 1536),
                        a0v = *(const LAS f32x4*)(pt + 2048), kkp = *(const LAS f32x4*)(pt + 2560), kap = *(const LAS f32x4*)(pt + 3072), rkp = *(const LAS f32x4*)(pt + 3584);
#pragma unroll
                    for (int jj = 0; jj < 4; ++jj) { const int j = 4 * q + jj;
                        const float r = rr_[j] + mr[jj] * (rp_[j] - rr_[j]), k = kc_[j] + mk[jj] * (kp_[j] - kc_[j]), v = vc_[j] + mv[jj] * (vp_[j] - vc_[j]);
                        const float w = __expf(-0.6065306597126334f * sigm(w0v[jj] + lwv[j]));
                        const float a = sigm(a0v[jj] + lav[j]);
                        const float kkv = k * kkp[jj], ktv = k * (1.0f + (a - 1.0f) * kap[jj]);
                        skk += kkv * kkv; bon += r * ktv * rkp[jj];
                        rr[j] = r; ww[j] = w; kt[j] = ktv; vv[j] = v; kk[j] = kkv; aa[j] = a; }
                }
                skk = sum8(skk); bon = sum8(bon);
                const float inv = rsqrtf(fmaxf(skk, 1e-12f));
                LAS unsigned char* ro = L + CK_RAW + tok * 768 + g8 * 16;
                *(LAS v4u*)(ro) = pk8(rr); *(LAS v4u*)(ro + 128) = pk8(ww); *(LAS v4u*)(ro + 256) = pk8(kt); *(LAS v4u*)(ro + 384) = pk8(vv);
#pragma unroll
                for (int j = 0; j < 8; ++j) { kk[j] *= inv; aa[j] *= kk[j]; vv[j] *= bon; }
                *(LAS v4u*)(ro + 512) = pk8(kk); *(LAS v4u*)(ro + 640) = pk8(aa);
                const size_t eo = ((size_t)b * SEQ + t) * MW + ch0;
                *(v4u*)(E1 + eo) = pk8(vv); *(v4u*)(GTg + eo) = pk8(lgv);
            }
            }
        } else {
            *(LAS v4u*)(L + CK_WT + (t256 >> 3) * CK_RS + (t256 & 7) * 16) = fe.lc[0];
            *(LAS v4u*)(L + CK_UTT + (t256 >> 2) * CK_TS + (t256 & 3) * 16) = fe.lc[1];
            *(LAS v4u*)(L + ((t256 >> 7) ? CK_ARK : CK_ARB) + ((t256 >> 2) & 31) * CK_TS + (t256 & 3) * 16) = fe.lc[2];
            *(LAS v4u*)(L + CK_RT + (t256 >> 3) * CK_RS + (t256 & 7) * 16) = fe.lc[3];
            { const int t = t256 >> 3, k0 = (t256 & 7) * 8; float vc[8], vp[8]; unpk8(fe.lp[0], vc); unpk8(fe.lp[1], vp);
              const f32x4 m0 = *(const LAS f32x4*)(PT + 1024 + h * 64 + k0), m1 = *(const LAS f32x4*)(PT + 1024 + h * 64 + k0 + 4);
#pragma unroll
              for (int j = 0; j < 8; ++j) *(LAS unsigned short*)(L + CK_VT + (k0 + j) * CK_TS + t * 2) = bf1(vc[j] + (j < 4 ? m0[j] : m1[j - 4]) * (vp[j] - vc[j])); }
            if (pr + G < 4096) { const unsigned char* zb = ws + (size_t)itn * 4096 + (size_t)t256 * 16;
                fe.lc[0] = *(const v4u*)(zb + WS_CWX); fe.lc[1] = *(const v4u*)(zb + WS_CUX); fe.lc[2] = *(const v4u*)(zb + WS_CAX); fe.lc[3] = *(const v4u*)(zb + WS_CRX);
                const int t = tn0 + (t256 >> 3); const bf16* row = PR + ((size_t)bn * SEQ + t) * N_RWKV + 1024 + 64 * hn + (t256 & 7) * 8; fe.lp[0] = *(const v4u*)row; fe.lp[1] = (t > 0) ? *(const v4u*)(row - N_RWKV) : (v4u){0u, 0u, 0u, 0u}; }
        }
        CK_SYNC();
        bf16x8 s0f[4]; v2u e1v[4], gtv[4];
        if (ZMODE && w4 < 2) {
            const bf16* sp = SS + (size_t)item * 4096 + (32 * w4 + r32) * 64 + hh * 8;
#pragma unroll
            for (int s_ = 0; s_ < 4; ++s_) s0f[s_] = *(const bf16x8*)(sp + s_ * 16);
            const size_t tg_ = (size_t)b * SEQ + (size_t)ch * CK + r32;
#pragma unroll
            for (int q4 = 0; q4 < 4; ++q4) { const int vch = h * 64 + 32 * w4 + 8 * q4 + 4 * hh; e1v[q4] = *(const v2u*)(E1 + tg_ * MW + vch); gtv[q4] = *(const v2u*)(GTg + tg_ * MW + vch); }
        }
        if (!ZMODE) {
        for (int rp_ = 0; rp_ < 1 + (CKREP & 1); ++rp_) {
        if (w4 == 0) {
            LAS float* lc = (LAS float*)(L + CK_LC); float a = 0.f; lc[lane_] = 0.f;
#pragma unroll 8
            for (int t = 0; t < CK; ++t) { const unsigned short wv = *(const LAS unsigned short*)(L + CK_RAW + t * 768 + 128 + lane_ * 2); a += __log2f(__uint_as_float(((unsigned)wv) << 16)); lc[(t + 1) * 64 + lane_] = a; }
            *(LAS float*)(L + CK_GC + lane_ * 4) = exp2f(a);
        }
        CK_SYNC();
        {
            const int t = t256 >> 3, k0 = (t256 & 7) * 8;
            const LAS unsigned char* rp = L + CK_RAW + t * 768 + k0 * 2;
            const v4u rv = *(const LAS v4u*)rp, ktv = *(const LAS v4u*)(rp + 256), vv = *(const LAS v4u*)(rp + 384), khv = *(const LAS v4u*)(rp + 512), bv = *(const LAS v4u*)(rp + 640);
            const LAS float* lc = (const LAS float*)(L + CK_LC);
            const unsigned rw[4] = {rv.x, rv.y, rv.z, rv.w}, kw[4] = {ktv.x, ktv.y, ktv.z, ktv.w}, vw[4] = {vv.x, vv.y, vv.z, vv.w}, hw[4] = {khv.x, khv.y, khv.z, khv.w}, bw[4] = {bv.x, bv.y, bv.z, bv.w};
            float at[8], bt[8], kt[8], rt[8], bh[8], kh[8];
#pragma unroll
            for (int j = 0; j < 8; ++j) {
                const float lp = lc[t * 64 + k0 + j], lt = lc[(t + 1) * 64 + k0 + j], lC = lc[CK * 64 + k0 + j];
                const float ep = __builtin_amdgcn_exp2f(lp), en = __builtin_amdgcn_exp2f(-lt), et = __builtin_amdgcn_exp2f(lt), ec = __builtin_amdgcn_exp2f(lC - lt);
                const bool hi = j & 1; const int wi = j >> 1;
                const float r_ = hi ? bfhi(rw[wi]) : bflo(rw[wi]), k_ = hi ? bfhi(kw[wi]) : bflo(kw[wi]), h_ = hi ? bfhi(hw[wi]) : bflo(hw[wi]), b_ = hi ? bfhi(bw[wi]) : bflo(bw[wi]);
                at[j] = -h_ * ep; bt[j] = b_ * en; kt[j] = k_ * en; rt[j] = r_ * et; bh[j] = b_ * ec; kh[j] = k_ * ec;
            }
            v4u o;
            o.x = pk2(rt[0], rt[1]); o.y = pk2(rt[2], rt[3]); o.z = pk2(rt[4], rt[5]); o.w = pk2(rt[6], rt[7]); *(LAS v4u*)(L + CK_RT + t * CK_RS + k0 * 2) = o;
#pragma unroll
            for (int j = 0; j < 8; ++j) *(LAS unsigned short*)(L + CK_VT + (k0 + j) * CK_TS + t * 2) = (unsigned short)((j & 1) ? (vw[j >> 1] >> 16) : (vw[j >> 1] & 0xffffu));
            if (!ZMODE) {
                o.x = pk2(at[0], at[1]); o.y = pk2(at[2], at[3]); o.z = pk2(at[4], at[5]); o.w = pk2(at[6], at[7]); *(LAS v4u*)(L + CK_AT + t * CK_RS + k0 * 2) = o;
                o.x = pk2(bt[0], bt[1]); o.y = pk2(bt[2], bt[3]); o.z = pk2(bt[4], bt[5]); o.w = pk2(bt[6], bt[7]); *(LAS v4u*)(L + CK_BT + t * CK_RS + k0 * 2) = o;
                o.x = pk2(kt[0], kt[1]); o.y = pk2(kt[2], kt[3]); o.z = pk2(kt[4], kt[5]); o.w = pk2(kt[6], kt[7]); *(LAS v4u*)(L + CK_KT + t * CK_RS + k0 * 2) = o;
#pragma unroll
                for (int j = 0; j < 8; ++j) { *(LAS unsigned short*)(L + CK_BHT + (k0 + j) * CK_TS + t * 2) = bf1(bh[j]); *(LAS unsigned short*)(L + CK_KHT + (k0 + j) * CK_TS + t * 2) = bf1(kh[j]); }
            }
        }
        CK_SYNC();
        }
        for (int rp_ = 0; rp_ < 1 + ((CKREP >> 1) & 1); ++rp_) {
        {
            const LAS unsigned char* xa = L + ((w4 < 2) ? CK_AT : CK_RT) + r32 * CK_RS + hh * 16;
            const LAS unsigned char* yb = L + ((w4 & 1) ? CK_KT : CK_BT) + r32 * CK_RS + hh * 16;
            f32x16 acc;
#pragma unroll
            for (int q = 0; q < 16; ++q) acc[q] = 0.f;
#pragma unroll
            for (int s = 0; s < 4; ++s) acc = __builtin_amdgcn_mfma_f32_32x32x16_bf16(ld_frag(xa + s * 32), ld_frag(yb + s * 32), acc, 0, 0, 0);
            const int i = r32;
#pragma unroll
            for (int q = 0; q < 16; ++q) { const int t = (q & 3) + 8 * (q >> 2) + 4 * hh;
                const float v = ((w4 < 2) ? (i < t) : (i <= t)) ? acc[q] : 0.f;
                if (w4 == 0) *(LAS float*)(L + CK_AAB + t * 128 + i * 4) = v;
                else *(LAS unsigned short*)(L + (w4 == 1 ? CK_AAK : w4 == 2 ? CK_ARB : CK_ARK) + t * CK_TS + i * 2) = bf1(v); }
        }
        CK_SYNC();
        if (w4 < 2) {
            f32x16 acc;
#pragma unroll
            for (int q = 0; q < 16; ++q) acc[q] = 0.f;
#pragma unroll
            for (int s = 0; s < 2; ++s) acc = __builtin_amdgcn_mfma_f32_32x32x16_bf16(ld_frag(L + CK_AAK + r32 * CK_TS + s * 32 + hh * 16), ld_frag(L + CK_VT + (32 * w4 + r32) * CK_TS + s * 32 + hh * 16), acc, 0, 0, 0);
#pragma unroll
            for (int q = 0; q < 16; ++q) { const int t = (q & 3) + 8 * (q >> 2) + 4 * hh; *(LAS float*)(L + CK_GT + (32 * w4 + r32) * CK_GS + t * 4) = acc[q]; }
        }
        CK_SYNC();
        }
        for (int rp_ = 0; rp_ < 1 + ((CKREP >> 2) & 1); ++rp_)
        if (w4 < 2 && (rp_ == 0 || w4 == 0)) {
            float x[CK];
            if (w4 == 0) {
#pragma unroll
                for (int t = 0; t < CK; ++t) x[t] = __uint_as_float(((unsigned)*(const LAS unsigned short*)(L + CK_AT + t * CK_RS + lane_ * 2)) << 16);
            } else {
#pragma unroll
                for (int t = 0; t < CK; ++t) x[t] = *(const LAS float*)(L + CK_GT + lane_ * CK_GS + t * 4);
            }
#pragma unroll
            for (int t = 0; t < CK; t += 4) {
                asm volatile("" ::: "memory");
                float a0 = x[t], a1 = x[t + 1], a2 = x[t + 2], a3 = x[t + 3];
#pragma unroll
                for (int i4 = 0; i4 < t / 4; ++i4) {
                    const f32x4 r0 = *(const LAS f32x4*)(L + CK_AAB + t * 128 + i4 * 16), r1 = *(const LAS f32x4*)(L + CK_AAB + (t + 1) * 128 + i4 * 16);
                    const f32x4 r2 = *(const LAS f32x4*)(L + CK_AAB + (t + 2) * 128 + i4 * 16), r3 = *(const LAS f32x4*)(L + CK_AAB + (t + 3) * 128 + i4 * 16);
#pragma unroll
                    for (int j = 0; j < 4; ++j) { const float xv = x[i4 * 4 + j]; a0 += r0[j] * xv; a1 += r1[j] * xv; a2 += r2[j] * xv; a3 += r3[j] * xv; } }
                const f32x4 d1 = *(const LAS f32x4*)(L + CK_AAB + (t + 1) * 128 + t * 4), d2 = *(const LAS f32x4*)(L + CK_AAB + (t + 2) * 128 + t * 4), d3 = *(const LAS f32x4*)(L + CK_AAB + (t + 3) * 128 + t * 4);
                x[t] = a0;
                a1 += d1[0] * a0; x[t + 1] = a1;
                a2 += d2[0] * a0; a2 += d2[1] * a1; x[t + 2] = a2;
                a3 += d3[0] * a0; a3 += d3[1] * a1; a3 += d3[2] * a2; x[t + 3] = a3;
            }
            if (w4 == 0) {
#pragma unroll
                for (int t = 0; t < CK; ++t) *(LAS unsigned short*)(L + CK_WT + t * CK_RS + lane_ * 2) = bf1(x[t]);
            }
            LAS unsigned char* tp = L + (w4 == 0 ? CK_WTT : CK_UTT) + lane_ * CK_TS;
#pragma unroll
            for (int q = 0; q < 4; ++q) { v4u o; o.x = pk2(x[8 * q], x[8 * q + 1]); o.y = pk2(x[8 * q + 2], x[8 * q + 3]); o.z = pk2(x[8 * q + 4], x[8 * q + 5]); o.w = pk2(x[8 * q + 6], x[8 * q + 7]); *(LAS v4u*)(tp + q * 16) = o; }
        }
        CK_SYNC();
        }
        if (!ZMODE) {
            if (pr + G < 4096) { fe_load_rows(fe, PR, bn, hn, tn0, t256); fe_load_lora(fe, (const bf16*)(ws + WS_A8), bn, tn0, t256); }
            { unsigned char* zb = ws + (size_t)item * 4096 + (size_t)t256 * 16;
              *(v4u*)(zb + WS_CWX) = *(const LAS v4u*)(L + CK_WT + (t256 >> 3) * CK_RS + (t256 & 7) * 16);
              *(v4u*)(zb + WS_CUX) = *(const LAS v4u*)(L + CK_UTT + (t256 >> 2) * CK_TS + (t256 & 3) * 16);
              *(v4u*)(zb + WS_CAX) = *(const LAS v4u*)(L + ((t256 >> 7) ? CK_ARK : CK_ARB) + ((t256 >> 2) & 31) * CK_TS + (t256 & 3) * 16);
              *(v4u*)(zb + WS_CRX) = *(const LAS v4u*)(L + CK_RT + (t256 >> 3) * CK_RS + (t256 & 7) * 16); }
            for (int rp7_ = 0; rp7_ < 1 + ((CKREP >> 4) & 1); ++rp7_) {
            const int kb1 = w4 >> 1, kb2 = w4 & 1;
            const LAS unsigned char* bha = L + CK_BHT + (32 * kb1 + r32) * CK_TS + hh * 16;
            const LAS unsigned char* kha = L + CK_KHT + (32 * kb1 + r32) * CK_TS + hh * 16;
            f32x16 am, an;
#pragma unroll
            for (int q = 0; q < 16; ++q) { am[q] = 0.f; an[q] = 0.f; }
#pragma unroll
            for (int s = 0; s < 2; ++s) {
                const bf16x8 fb = ld_frag(bha + s * 32);
                am = __builtin_amdgcn_mfma_f32_32x32x16_bf16(ld_frag(L + CK_WTT + (32 * kb2 + r32) * CK_TS + s * 32 + hh * 16), fb, am, 0, 0, 0);
                an = __builtin_amdgcn_mfma_f32_32x32x16_bf16(fb, ld_frag(L + CK_UTT + (32 * kb2 + r32) * CK_TS + s * 32 + hh * 16), an, 0, 0, 0);
                an = __builtin_amdgcn_mfma_f32_32x32x16_bf16(ld_frag(kha + s * 32), ld_frag(L + CK_VT + (32 * kb2 + r32) * CK_TS + s * 32 + hh * 16), an, 0, 0, 0);
            }
            const float gc = *(const LAS float*)(L + CK_GC + (32 * kb2 + r32) * 4);
            bf16* mo = Mo + (size_t)item * 4096; bf16* no = No + (size_t)item * 4096;
#pragma unroll
            for (int q4 = 0; q4 < 4; ++q4) { float mv[4];
#pragma unroll
                for (int e = 0; e < 4; ++e) { const int kr = 8 * q4 + 4 * hh + e;
                    mv[e] = am[4 * q4 + e] + ((kb1 == kb2 && kr == r32) ? gc : 0.f); }
                v2u o; o.x = pk2(mv[0], mv[1]); o.y = pk2(mv[2], mv[3]);
                *(v2u*)(mo + (32 * kb1 + r32) * 64 + 32 * kb2 + 8 * q4 + 4 * hh) = o; }
#pragma unroll
            for (int q4 = 0; q4 < 4; ++q4) { v2u o; o.x = pk2(an[4 * q4], an[4 * q4 + 1]); o.y = pk2(an[4 * q4 + 2], an[4 * q4 + 3]);
                *(v2u*)(no + (32 * kb2 + r32) * 64 + 32 * kb1 + 8 * q4 + 4 * hh) = o; }
            }
        } else {
            float s1 = 0.f, s2 = 0.f; f32x16 yt;
            const int vt = w4;
            if (w4 < 2) {
                f32x16 u;
#pragma unroll
                for (int q4 = 0; q4 < 4; ++q4) { const v2u uv = *(const LAS v2u*)(L + CK_UTT + (32 * vt + r32) * CK_TS + (8 * q4 + 4 * hh) * 2);
                    u[4 * q4] = bflo(uv.x); u[4 * q4 + 1] = bfhi(uv.x); u[4 * q4 + 2] = bflo(uv.y); u[4 * q4 + 3] = bfhi(uv.y); }
#pragma unroll
                for (int s = 0; s < 4; ++s) u = __builtin_amdgcn_mfma_f32_32x32x16_bf16(ld_frag(L + CK_WT + r32 * CK_RS + s * 32 + hh * 16), s0f[s], u, 0, 0, 0);
#pragma unroll
                for (int q = 0; q < 16; ++q) yt[q] = 0.f;
#pragma unroll
                for (int s = 0; s < 4; ++s) yt = __builtin_amdgcn_mfma_f32_32x32x16_bf16(s0f[s], ld_frag(L + CK_RT + r32 * CK_RS + s * 32 + hh * 16), yt, 0, 0, 0);
#pragma unroll
                for (int s = 0; s < 2; ++s) {
                    v4u uw; uw.x = pk2(u[8 * s], u[8 * s + 1]); uw.y = pk2(u[8 * s + 2], u[8 * s + 3]); uw.z = pk2(u[8 * s + 4], u[8 * s + 5]); uw.w = pk2(u[8 * s + 6], u[8 * s + 7]);
                    const LAS unsigned char* ab = L + CK_ARB + r32 * CK_TS + (16 * s + 4 * hh) * 2;
                    yt = __builtin_amdgcn_mfma_f32_32x32x16_bf16(__builtin_bit_cast(bf16x8, uw), ld_frag2(ab, ab + 16), yt, 0, 0, 0);
                    yt = __builtin_amdgcn_mfma_f32_32x32x16_bf16(ld_frag(L + CK_VT + (32 * vt + r32) * CK_TS + s * 32 + hh * 16), ld_frag(L + CK_ARK + r32 * CK_TS + s * 32 + hh * 16), yt, 0, 0, 0);
                }
#pragma unroll
                for (int q = 0; q < 16; ++q) { s1 += yt[q]; s2 += yt[q] * yt[q]; }
                s1 += xor_lane(s1, lane_, 32); s2 += xor_lane(s2, lane_, 32);
                if (hh == 0) { *(LAS float*)(L + CK_EX + (vt * 32 + r32) * 8) = s1; *(LAS float*)(L + CK_EX + (vt * 32 + r32) * 8 + 4) = s2; }
            }
            CK_SYNC();
            if (w4 < 2) {
                const float o1 = *(const LAS float*)(L + CK_EX + ((vt ^ 1) * 32 + r32) * 8), o2 = *(const LAS float*)(L + CK_EX + ((vt ^ 1) * 32 + r32) * 8 + 4);
                const float mean = (s1 + o1) * (1.0f / 64.0f), var = (s2 + o2) * (1.0f / 64.0f) - mean * mean, rstd = rsqrtf(fmaxf(var, 0.f) + 64e-5f);
                const size_t tg = (size_t)b * SEQ + (size_t)ch * CK + r32;
#pragma unroll
                for (int q4 = 0; q4 < 4; ++q4) { const int vch = h * 64 + 32 * vt + 8 * q4 + 4 * hh;
                    const v2u ev = e1v[q4], gv = gtv[q4]; const f32x4 gm = *(const LAS f32x4*)(PT + 1536 + vch);
                    const float y0 = ((yt[4 * q4] - mean) * rstd * gm[0] + bflo(ev.x)) * bflo(gv.x), y1 = ((yt[4 * q4 + 1] - mean) * rstd * gm[1] + bfhi(ev.x)) * bfhi(gv.x);
                    const float y2 = ((yt[4 * q4 + 2] - mean) * rstd * gm[2] + bflo(ev.y)) * bflo(gv.y), y3 = ((yt[4 * q4 + 3] - mean) * rstd * gm[3] + bfhi(ev.y)) * bfhi(gv.y);
                    v2u o; o.x = pk2(y0, y1); o.y = pk2(y2, y3); *(v2u*)(YO + tg * MW + vch) = o; }
            }
        }
    }
    CK_SYNC();
}

constexpr int YS_MROW = 136, YS_CHUNK = 64 * YS_MROW + 16 * YS_MROW  , YS_ROUND = 4 * YS_CHUNK  ;
__device__ __forceinline__ void ys_issue(const unsigned char* rbase, const unsigned (&goff)[6], int ll, v4u (&rg)[6]) {
#pragma unroll
    for (int j = 0; j < 6; ++j) if (j < 5 || ll + 448 * 5 < 2560) rg[j] = *(const v4u*)(rbase + goff[j]);
}
__device__ __forceinline__ void ys_write(LAS unsigned char* buf, const unsigned (&loff)[6], int ll, const v4u (&rg)[6]) {
#pragma unroll
    for (int j = 0; j < 6; ++j) if (j < 5 || ll + 448 * 5 < 2560) *(LAS v4u*)(buf + loff[j]) = rg[j];
}
__device__ __forceinline__ void rwkv_state(const Params& P, LAS unsigned char* lds, int tid, int lane, int wave, int c, int G) {
    unsigned char* ws = WS_OPAQUE(P.ws);
    const bf16* Mo = (const bf16*)(ws + WS_CM); const bf16* No = (const bf16*)(ws + WS_CN); bf16* SS = (bf16*)(ws + WS_CS);
    constexpr int NR = CK_NCH / 4;
    for (int wi = c; wi < 128; wi += G) {
        const int vs = (wi >> 3) & 3, bhl = (wi & 7) + 8 * (wi >> 5);
        const size_t ibase = (size_t)bhl * 256 * 4096;
        __syncthreads();
        if (wave != 0) {
            const int ll = tid - 64;
            unsigned goff[6], loff[6];
#pragma unroll
            for (int j = 0; j < 6; ++j) { const int Pp = ll + 448 * j, cr = Pp / 640, p = Pp - cr * 640, q = p - 512;
                goff[j] = (unsigned)(cr * 8192) + ((p < 512) ? (unsigned)(p * 16) : (unsigned)(WS_CN - WS_CM) + (unsigned)(((16 * vs + (q >> 3)) * 64 + (q & 7) * 8) * 2));
                loff[j] = (unsigned)(cr * YS_CHUNK) + ((p < 512) ? (unsigned)((p >> 3) * YS_MROW + (p & 7) * 16) : (unsigned)(64 * YS_MROW + (q >> 3) * YS_MROW + (q & 7) * 16)); }
            const unsigned char* mb = (const unsigned char*)(Mo + ibase);
            v4u r0[6], r1[6], r2[6], r3[6];
            ys_issue(mb, goff, ll, r0); ys_issue(mb + 32768, goff, ll, r1); ys_issue(mb + 2 * 32768, goff, ll, r2); ys_issue(mb + 3 * 32768, goff, ll, r3);
            ys_write(lds, loff, ll, r0); ys_issue(mb + 4 * 32768, goff, ll, r0);
            asm volatile("s_waitcnt lgkmcnt(0)" ::: "memory"); __builtin_amdgcn_s_barrier(); asm volatile("" ::: "memory");
            for (int r = 0; r < NR; r += 4) {
#define YS_STEP(RR, REG) do { const int rr_ = r + (RR); if (rr_ + 1 < NR) { ys_write(lds + ((rr_ + 1) % 3) * YS_ROUND, loff, ll, REG); if (rr_ + 5 < NR) ys_issue(mb + (size_t)(rr_ + 5) * 32768, goff, ll, REG); } \
                    asm volatile("s_waitcnt lgkmcnt(0)" ::: "memory"); __builtin_amdgcn_s_barrier(); asm volatile("" ::: "memory"); } while (0)
                YS_STEP(0, r1); YS_STEP(1, r2); YS_STEP(2, r3); YS_STEP(3, r0);
#undef YS_STEP
            }
        } else {
            const int fr = lane & 15, g = lane >> 4;
            f32x4 st[4];
#pragma unroll
            for (int kt = 0; kt < 4; ++kt) st[kt] = (f32x4){0.f, 0.f, 0.f, 0.f};
            asm volatile("" ::: "memory"); __builtin_amdgcn_s_barrier(); asm volatile("" ::: "memory");
            for (int r = 0; r < NR; ++r) {
                const LAS unsigned char* rb = lds + (r % 3) * YS_ROUND;
                bf16x8 mf[4][4][2]; v2u nf[4][4];
#pragma unroll
                for (int cr = 0; cr < 4; ++cr) { const LAS unsigned char* cb = rb + cr * YS_CHUNK;
#pragma unroll
                    for (int kt = 0; kt < 4; ++kt) { nf[cr][kt] = *(const LAS v2u*)(cb + 64 * YS_MROW + fr * YS_MROW + (16 * kt + 4 * g) * 2);
#pragma unroll
                        for (int s = 0; s < 2; ++s) { const LAS unsigned char* mp = cb + (16 * kt + fr) * YS_MROW + (32 * s + 4 * g) * 2; mf[cr][kt][s] = ld_frag2(mp, mp + 32); } } }
                asm volatile("" ::: "memory");
#pragma unroll
                for (int cr = 0; cr < 4; ++cr) {
                    const int ch = r * 4 + cr;
                    bf16* so = SS + ibase + (size_t)ch * 4096 + (16 * vs + fr) * 64 + 4 * g;
                    bf16x8 bfr[2];
#pragma unroll
                    for (int s = 0; s < 2; ++s) { v4u w; w.x = pk2(st[2 * s][0], st[2 * s][1]); w.y = pk2(st[2 * s][2], st[2 * s][3]); w.z = pk2(st[2 * s + 1][0], st[2 * s + 1][1]); w.w = pk2(st[2 * s + 1][2], st[2 * s + 1][3]); bfr[s] = __builtin_bit_cast(bf16x8, w); }
                    { const v4u w0 = __builtin_bit_cast(v4u, bfr[0]), w1 = __builtin_bit_cast(v4u, bfr[1]);
                      *(v2u*)(so) = (v2u){w0.x, w0.y}; *(v2u*)(so + 16) = (v2u){w0.z, w0.w}; *(v2u*)(so + 32) = (v2u){w1.x, w1.y}; *(v2u*)(so + 48) = (v2u){w1.z, w1.w}; }
#pragma unroll
                    for (int kt = 0; kt < 4; ++kt) {
                        const v2u nv = nf[cr][kt];
                        f32x4 a = (f32x4){bflo(nv.x), bfhi(nv.x), bflo(nv.y), bfhi(nv.y)};
#pragma unroll
                        for (int s = 0; s < 2; ++s) a = __builtin_amdgcn_mfma_f32_16x16x32_bf16(mf[cr][kt][s], bfr[s], a, 0, 0, 0);
                        st[kt] = a;
                    }
                }
                asm volatile("s_waitcnt lgkmcnt(0)" ::: "memory"); __builtin_amdgcn_s_barrier(); asm volatile("" ::: "memory");
            }
        }
    }
    __syncthreads();
}

#ifndef MK_MULTI
#define MK_MULTI 0
#endif
#ifndef ONLYMASK
#define ONLYMASK 0x7ffff
#endif
#define EN(k) (((ONLYMASK) >> (k)) & 1)
#ifndef BARREP
#define BARREP 0
#endif
#ifndef REPMASK
#define REPMASK 0
#endif
#ifndef REPSUB
#define REPSUB 1
#endif
#define NREP(k) (1 + (((REPMASK) >> (k)) & 1))
#ifndef DUPSUB
#define DUPSUB -1
#endif
constexpr int NSUB = (DUPSUB >= 0) ? 4 : 3;
constexpr int N_PHASES = 1 + NL * (3 + 2 * NSUB + 2 * 6 + 4) + 1;

__global__ void __launch_bounds__(NTHR, 2) __attribute__((amdgpu_waves_per_eu(2, 2))) fwd_kernel(Params P) {
    extern __shared__ __attribute__((aligned(16))) unsigned char lds_raw[];
    LAS unsigned char* lds = (LAS unsigned char*)lds_raw;
    const int G0 = gridDim.x, c0 = blockIdx.x;
    unsigned char* ws0 = P.ws;
    const int wave0 = __builtin_amdgcn_readfirstlane(threadIdx.x >> 6);
    if (threadIdx.x < 64) ((LAS unsigned*)(lds + LDS_MISC))[threadIdx.x] = 0u;
    __syncthreads();
    XcdBarrier bar = xcd_barrier_post((unsigned*)(ws0 + WS_CTL) + CW_BAR, (volatile LAS unsigned*)(lds + LDS_MISC), (int)threadIdx.x);
    int ph = 0; const int lo = P.lo, hi = P.hi; bool run;
#define PH_BEGIN (run = (ph >= lo && ph < hi), ++ph, run)
#define PH_LOCALS int lane; asm volatile("v_mbcnt_lo_u32_b32 %0, -1, 0\n\tv_mbcnt_hi_u32_b32 %0, -1, %0" : "=v"(lane));     int wave = wave0; asm volatile("" : "+s"(wave)); const int tid = wave * 64 + lane; \
    int G = G0, c = c0; asm volatile("" : "+s"(G), "+s"(c)); const int gw = c * NWAVES + wave, NGW = G * NWAVES; unsigned char* ws = WS_OPAQUE(ws0); (void)lane; (void)gw; (void)NGW; (void)ws;
#define PH_END do { if (run && ph < hi) { int bl_; asm volatile("v_mbcnt_lo_u32_b32 %0, -1, 0\n\tv_mbcnt_hi_u32_b32 %0, -1, %0" : "=v"(bl_)); xcd_barrier(bar, wave0 * 64 + bl_); if (BARREP) xcd_barrier(bar, wave0 * 64 + bl_); } } while (0)

    if (PH_BEGIN) if constexpr (EN(0)) { PH_LOCALS for (int rep_ = 0; rep_ < ((true) ? NREP(0) : 1); ++rep_) { p0_mixer_weights(P, (LAS float*)(lds + wave * 8448), lane, gw, NGW); p0_router_weights(P, tid, c, G); p0_mod(P, lds, tid, c, G); } } PH_END;

    for (int l = 0; l < NL; ++l) {
        if (PH_BEGIN) if constexpr (EN(1)) { PH_LOCALS for (int rep_ = 0; rep_ < ((l == 0) ? NREP(1) : 1); ++rep_) { row_phase<0>(P, l, lds, tid, lane, wave, c, G); p_quant_wt1(P, l, lds, tid, lane, wave, c, G); } } PH_END;
        if (PH_BEGIN) if constexpr (EN(2)) { PH_LOCALS for (int rep_ = 0; rep_ < ((true) ? NREP(2) : 1); ++rep_) {
            pg8::Gemm g{(const bf16*)(ws + WS_H), (const bf16*)(ws + WS_W81 + (size_t)l * N1 * D), T, N_RWKV, D / 2}; pg8::StaticOrder S; S.init(T, N_RWKV, G, c);
            pg8::EpiPlainI8 E{(bf16*)(ws + WS_PRW), N_RWKV, (const float*)(ws + WS_TAB + TAB_SA), (const float*)(ws + WS_SW1) + l * N1};
            pg8::gemm_phase<pg8::EpiPlainI8, pg8::StaticOrder, false, true>(lds, g, S, E, nullptr, tid);
        } } PH_END;
        if (PH_BEGIN) if constexpr (EN(3)) { PH_LOCALS rwkv_lora_in(P, l, tid, c, G); } PH_END;
        for (int hb = 0; hb < 2; ++hb)
            for (int s2 = 0; s2 < NSUB; ++s2) { const int sub = (DUPSUB >= 0 && s2 > DUPSUB) ? s2 - 1 : s2;
                if (PH_BEGIN) if constexpr (EN(4)) { PH_LOCALS for (int rep_ = 0; rep_ < ((sub == REPSUB) ? NREP(4) : 1); ++rep_) {
                    if (sub == 1) {
                        const bool helper = (G > 128 && c >= 128);
                        if (!helper) rwkv_state(P, lds, tid, lane, wave, c, G);
                        if ((helper || G <= 128) && !(DUPSUB >= 0 && s2 == DUPSUB + 1)) p_expert_weights(P, l, hb, lds, tid, lane, wave, helper ? c - 128 : c, helper ? G - 128 : G); }
                    else rwkv_chunk(P, l, hb, sub == 2, lds, tid, lane, wave, c, G); } } PH_END;
            }

        for (int half = 0; half < 2; ++half) {
            if (PH_BEGIN) if constexpr (EN(5)) { PH_LOCALS
                pg8::Gemm g{(const bf16*)(ws + WS_H + (size_t)half * HT * D), (const bf16*)(ws + WS_W81 + ((size_t)l * N1 + N_RWKV) * D), HT, N_REST + N_GATE, D / 2};
                pg8::StaticOrder S; S.init(HT, N_REST + N_GATE, G, c);
                pg8::EpiB2I8 E{(bf16*)(ws + WS_PREST), N_REST, N_REST / 256, (bf16*)(ws + WS_GATES), N_GATE, (const float*)P.in[10] + (size_t)l * N_GATE,
                               (const float*)(ws + WS_TAB + TAB_SA) + (size_t)half * HT, (const float*)(ws + WS_SW1) + l * N1 + N_RWKV};
#ifdef STAG
                if ((STAGSEL) & 1) { for (int i_ = 0; i_ < STAG; ++i_) __builtin_amdgcn_s_sleep(127); }
#endif
                for (int rep_ = 0; rep_ < NREP(5); ++rep_) pg8::gemm_phase<pg8::EpiB2I8, pg8::StaticOrder, false, true>(lds, g, S, E, nullptr, tid);
            } PH_END;
            if (PH_BEGIN) if constexpr (EN(6)) { PH_LOCALS for (int rep_ = 0; rep_ < ((true) ? NREP(6) : 1); ++rep_) { ret_kv(P, half, lds, tid, lane, wave, c, G); conv_phase(P, l, tid, c, G); } } PH_END;
            if (PH_BEGIN) if constexpr (EN(7)) { PH_LOCALS for (int rep_ = 0; rep_ < ((true) ? NREP(7) : 1); ++rep_) { ret_state(P, tid, c, G); } } PH_END;
            if (PH_BEGIN) if constexpr (EN(8)) { PH_LOCALS for (int rep_ = 0; rep_ < ((true) ? NREP(8) : 1); ++rep_) { ret_out(P, l, half, lds, tid, lane, wave, c, G); } } PH_END;
            if (PH_BEGIN) if constexpr (EN(9)) { PH_LOCALS for (int rep_ = 0; rep_ < ((true) ? NREP(9) : 1); ++rep_) {
                pg8::Gemm g{(const bf16*)(ws + WS_YRET), (const bf16*)(ws + WS_WBR) + (size_t)(l * 3) * D * MW, HT, D, MW};
                pg8::MergeOrder S; S.T.init(HT, D, G, c); S.Y0 = (const bf16*)(ws + WS_YRET); S.Y1 = (const bf16*)(ws + WS_YRWKV) + (size_t)half * HT * MW; S.Y2 = (const bf16*)(ws + WS_YCONV);
                S.W = (const bf16*)(ws + WS_WBR) + (size_t)(l * 3) * D * MW;
                pg8::EpiMerge E{(bf16*)(ws + WS_MERGED), (const bf16*)(ws + WS_GATES), N_GATE, (unsigned)((size_t)HT * D * 2)};
                pg8::gemm_phase<pg8::EpiMerge, pg8::MergeOrder>(lds, g, S, E, nullptr, tid);
            } } PH_END;
            if (PH_BEGIN) if constexpr (EN(10)) { PH_LOCALS for (int rep_ = 0; rep_ < ((l == 0) ? NREP(10) : 1); ++rep_) {
                pg8::Gemm g{(const bf16*)(ws + WS_MERGED), (const bf16*)(ws + WS_WO) + (size_t)l * D * D, HT, D, D}; pg8::StaticOrder S; S.init(HT, D, G, c);
                const void* xin = (l == 0) ? (const void*)((const float*)P.in[0] + (size_t)half * HT * D) : (const void*)((const bf16*)P.out + (size_t)half * HT * D);
                bf16* xout = ((l == NL - 1) ? (bf16*)(ws + WS_X2) : (bf16*)P.out) + (size_t)half * HT * D;
                pg8::EpiWo E{xin, xout, (const float*)(ws + WS_MOD) + (size_t)l * NB * 6144 + 2048, 6144, half * HT, SEQ, l == 0};
                pg8::gemm_phase<pg8::EpiWo, pg8::StaticOrder>(lds, g, S, E, nullptr, tid);
            } } PH_END;
        }
        if (PH_BEGIN) if constexpr (EN(11)) { PH_LOCALS for (int rep_ = 0; rep_ < ((true) ? NREP(11) : 1); ++rep_) { row_phase<1>(P, l, lds, tid, lane, wave, c, G); router_phase(P, l, lds, tid, c, G); } } PH_END;
        if (PH_BEGIN) if constexpr (EN(12)) { PH_LOCALS for (int rep_ = 0; rep_ < ((true) ? NREP(12) : 1); ++rep_) { moe_slots(P, lds, tid, c, G); } } PH_END;
        if (PH_BEGIN) if constexpr (EN(14)) { PH_LOCALS for (int rep_ = 0; rep_ < ((true) ? NREP(14) : 1); ++rep_) {
            pg8::Gemm g{(const bf16*)(ws + WS_XROWS), (const bf16*)((const unsigned char*)P.out + OUT_WGU), 0, 0, D / 2};
            pg8::moe_build_units((LAS int*)(lds + 131072 + 8192), (const int*)(ws + WS_TAB + TAB_TILEE), G, c, tid); __syncthreads();
            pg8::MoeOrder S{(const LAS int*)(lds + 131072 + 8192)};
            pg8::EpiGLUI8 E{(bf16*)(ws + WS_GB), (const float*)(ws + WS_TAB + TAB_XS), (const float*)(ws + WS_SWE)};
#ifdef STAGM
            if ((STAGSELM) & 1) { for (int i_ = 0; i_ < STAGM; ++i_) __builtin_amdgcn_s_sleep(127); }
#endif
            pg8::gemm_phase<pg8::EpiGLUI8, pg8::MoeOrder, false, true>(lds, g, S, E, nullptr, tid);
        } } PH_END;
        if (PH_BEGIN) if constexpr (EN(15)) { PH_LOCALS for (int rep_ = 0; rep_ < ((true) ? NREP(15) : 1); ++rep_) {
            pg8::Gemm g{(const bf16*)(ws + WS_GB), (const bf16*)((const unsigned char*)P.out + OUT_WD), 0, 0, MW};
            pg8::moe_build_units((LAS int*)(lds + 131072 + 8192), (const int*)(ws + WS_TAB + TAB_TILEE), G, c, tid); __syncthreads();
            pg8::MoeOrder S{(const LAS int*)(lds + 131072 + 8192)};
            pg8::EpiPlain E{(bf16*)(ws + WS_YM), D, 4};
#ifdef STAGM
            if ((STAGSELM) & 1) { for (int i_ = 0; i_ < STAGM; ++i_) __builtin_amdgcn_s_sleep(127); }
#endif
            pg8::gemm_phase<pg8::EpiPlain, pg8::MoeOrder>(lds, g, S, E, nullptr, tid);
        } } PH_END;
    }
    if (PH_BEGIN) if constexpr (EN(16)) { PH_LOCALS row_phase<2>(P, 0, lds, tid, lane, wave, c, G); }
}

#ifdef DBG_SRC
#ifndef DBG_N
#define DBG_N (T * D)
#endif
__global__ void dbg_dump(const unsigned short* src, float* out) {
    for (size_t i = (size_t)blockIdx.x * blockDim.x + threadIdx.x; i < (size_t)T * D; i += (size_t)gridDim.x * blockDim.x) { float v = 0.f; if (i < (size_t)(DBG_N)) { v = __uint_as_float(((unsigned)src[i]) << 16); v = (v - v == 0.f) ? v : 10000.0f; } out[i] = v; }
}
#endif
extern "C" void kernel_launch(void* const* d_in, const int* in_sizes, int n_in, void* d_out, int out_size, void* d_ws, size_t ws_size, hipStream_t stream) {
    static int grid = 0;
    if (grid == 0) {
        if (n_in != 32 || out_size != T * D || ws_size < WS_END) { fprintf(stderr, "kernel_launch: unexpected problem (n_in %d out %d ws %zu)\n", n_in, out_size, ws_size); grid = -1; return; }
        int dev = 0, cus = 0, per_cu = 0;
        if (hipGetDevice(&dev) != hipSuccess || hipDeviceGetAttribute(&cus, hipDeviceAttributeMultiprocessorCount, dev) != hipSuccess) { grid = -1; return; }
        if (hipFuncSetAttribute((const void*)fwd_kernel, hipFuncAttributeMaxDynamicSharedMemorySize, LDS_BYTES) != hipSuccess) { fprintf(stderr, "kernel_launch: hipFuncSetAttribute failed\n"); grid = -1; return; }
        if (hipOccupancyMaxActiveBlocksPerMultiprocessor(&per_cu, (const void*)fwd_kernel, NTHR, LDS_BYTES) != hipSuccess || per_cu < 1) { fprintf(stderr, "kernel_launch: occupancy query says %d\n", per_cu); }
        grid = cus > 0 ? cus : 256;
    }
    if (grid < 0) return;
    if (hipMemsetAsync((char*)d_ws + WS_CTL, 0, CTL_ZERO_BYTES, stream) != hipSuccess) return;
    Params p{};
    for (int i = 0; i < 32; ++i) p.in[i] = d_in[i];
    p.out = (float*)d_out; p.ws = (unsigned char*)d_ws;
#if MK_MULTI
    for (int ph = 0; ph < N_PHASES; ++ph) { p.lo = ph; p.hi = ph + 1; hipLaunchKernelGGL(fwd_kernel, dim3(grid), dim3(NTHR), LDS_BYTES, stream, p); }
#else
    p.lo = 0; p.hi = N_PHASES;
#ifdef DBG_STOP
    p.hi = DBG_STOP;
#endif
#ifdef DBG_SPLIT
    p.hi = DBG_SPLIT;
    hipLaunchKernelGGL(fwd_kernel, dim3(grid), dim3(NTHR), LDS_BYTES, stream, p);
    hipMemsetAsync((char*)d_ws + WS_CTL, 0, 65536, stream);
    p.lo = DBG_SPLIT; p.hi = DBG_STOP;
#endif
    hipLaunchKernelGGL(fwd_kernel, dim3(grid), dim3(NTHR), LDS_BYTES, stream, p);
#ifdef DBG_SRC
    hipLaunchKernelGGL(dbg_dump, dim3(2048), dim3(256), 0, stream, (const unsigned short*)((const char*)d_ws + (size_t)(DBG_SRC) * MiB), (float*)d_out);
#endif
#endif
}
```

```cpp
#include <hip/hip_runtime.h>
#include <cstdio>
#include <cstdint>
#include <type_traits>
namespace pg8 {
#define PG8_LAS __attribute__((address_space(3)))
typedef unsigned short bf16_t;
typedef short bf16x8 __attribute__((ext_vector_type(8)));
typedef float f32x4 __attribute__((ext_vector_type(4)));
typedef unsigned u32x4 __attribute__((ext_vector_type(4)));
constexpr int BM = 256, BK = 64, HALF = 128, HTB = HALF * BK * 2  , STAGE_BYTES = 8 * HTB, NXCD = 8, WGM = 8;

__host__ __device__ __forceinline__ int lds_byte(int r, int c) { const int st = (r >> 4) * 2 + (c >> 5), rr = r & 15, cc = c & 31, ob = rr * 64 + cc * 2; return st * 1024 + (ob ^ (((ob >> 9) & 1) << 5)); }
__host__ __device__ __forceinline__ void stage_rc(int b, int& R, int& C) { const int st = b / 1024, sb = b % 1024, swz = sb ^ (((sb >> 9) & 1) << 5); R = (st >> 1) * 16 + swz / 64; C = (st & 1) * 32 + (swz % 64) / 2; }
__host__ __device__ __forceinline__ int perm32(int rho) { const int n = rho >> 4, i = rho & 15; return 8 * (i >> 2) + 4 * n + (i & 3); }

struct Unit { int pm, pn; };
struct Gemm { const bf16_t* A; const bf16_t* Bt; int M, N, K; };

struct StaticOrder {
    static constexpr bool GATHER = false;
    int nM, nN, nwg, G, c;
    __host__ __device__ void init(int M, int N, int G_, int c_) { nM = M / BM; nN = N / BM; nwg = nM * nN; G = G_; c = c_; }
    __host__ __device__ bool next(int i, Unit& u) const {
        const long L = (long)i * G + c; if (L >= nwg) return false;
        int wgid = (int)L; { const int q = nwg / NXCD, r = nwg % NXCD, xcd = wgid % NXCD, off = wgid / NXCD; wgid = (xcd < r ? xcd * (q + 1) : r * (q + 1) + (xcd - r) * q) + off; }
        const int nig = WGM * nN, gid = wgid / nig, fm = gid * WGM, gsz = (nM - fm) < WGM ? (nM - fm) : WGM;
        u.pm = fm + ((wgid % nig) % gsz); u.pn = (wgid % nig) / gsz; return true;
    }
    __device__ __forceinline__ void a_ready(const Unit&) const {}
    __device__ __forceinline__ void done(const Unit&) const {}
    __device__ __forceinline__ const char* baseA(const Gemm& g, const Unit& u, size_t tstep) const { return (const char*)g.A + (size_t)u.pm * tstep; }
    __device__ __forceinline__ const char* baseB(const Gemm& g, const Unit& u, size_t tstep) const { return (const char*)g.Bt + (size_t)u.pn * tstep; }
};
typedef __bf16 bf16v2_t __attribute__((ext_vector_type(2)));
typedef float f32v2_t __attribute__((ext_vector_type(2)));
__device__ __forceinline__ unsigned cvt_pk_bf16(float lo, float hi) { const f32v2_t v = {lo, hi}; return __builtin_bit_cast(unsigned, __builtin_convertvector(v, bf16v2_t)); }
__device__ __forceinline__ float bflo(unsigned u) { return __uint_as_float(u << 16); }
__device__ __forceinline__ float bfhi(unsigned u) { return __uint_as_float(u & 0xffff0000u); }
__device__ __forceinline__ float sigmoidf_(float x) { return __builtin_amdgcn_rcpf(1.0f + __expf(-x)); }

struct EpiPlain {
    static constexpr bool PERM = true, AFTER_DRAIN = false, PREF = false;
    bf16_t* O; int ldc; int ntn;
    __device__ __forceinline__ void operator()(const f32x4 (&acc)[2][2][4][2], const Unit& u, int wr, int wc, int fr, int fq) const {
        const int row0 = u.pm * BM + wr * 64 + fr; const int col0 = (u.pn % ntn) * BM + wc * 32 + 8 * fq;
#pragma unroll
        for (int ai = 0; ai < 2; ++ai)
#pragma unroll
            for (int m = 0; m < 4; ++m) { bf16_t* rowp = O + (size_t)(row0 + ai * HALF + m * 16) * ldc + col0;
#pragma unroll
                for (int bj = 0; bj < 2; ++bj) { const f32x4 v0 = acc[ai][bj][m][0], v1 = acc[ai][bj][m][1];
                    u32x4 w; w.x = cvt_pk_bf16(v0[0], v0[1]); w.y = cvt_pk_bf16(v0[2], v0[3]); w.z = cvt_pk_bf16(v1[0], v1[1]); w.w = cvt_pk_bf16(v1[2], v1[3]);
                    __builtin_nontemporal_store(w, (u32x4*)(rowp + bj * HALF)); } }
    }
};
struct EpiB2 {
    static constexpr bool PERM = true, AFTER_DRAIN = false, PREF = false;
    bf16_t* P; int ldp; int npl; bf16_t* Gt; int ldg; const float* bias;
    __device__ __forceinline__ void operator()(const f32x4 (&acc)[2][2][4][2], const Unit& u, int wr, int wc, int fr, int fq) const {
        const int row0 = u.pm * BM + wr * 64 + fr;
        if (u.pn < npl) {
            const int col0 = u.pn * BM + wc * 32 + 8 * fq;
#pragma unroll
            for (int ai = 0; ai < 2; ++ai)
#pragma unroll
                for (int m = 0; m < 4; ++m) { bf16_t* rowp = P + (size_t)(row0 + ai * HALF + m * 16) * ldp + col0;
#pragma unroll
                    for (int bj = 0; bj < 2; ++bj) { const f32x4 v0 = acc[ai][bj][m][0], v1 = acc[ai][bj][m][1];
                        u32x4 w; w.x = cvt_pk_bf16(v0[0], v0[1]); w.y = cvt_pk_bf16(v0[2], v0[3]); w.z = cvt_pk_bf16(v1[0], v1[1]); w.w = cvt_pk_bf16(v1[2], v1[3]);
                        *(u32x4*)(rowp + bj * HALF) = w; } }
        } else {
            const int col0 = (u.pn - npl) * BM + wc * 32 + 8 * fq;
#pragma unroll
            for (int ai = 0; ai < 2; ++ai)
#pragma unroll
                for (int m = 0; m < 4; ++m) { bf16_t* rowp = Gt + (size_t)(row0 + ai * HALF + m * 16) * ldg + col0;
#pragma unroll
                    for (int bj = 0; bj < 2; ++bj) { f32x4 v0 = acc[ai][bj][m][0] + *(const f32x4*)(bias + col0 + bj * HALF), v1 = acc[ai][bj][m][1] + *(const f32x4*)(bias + col0 + bj * HALF + 4);
#pragma unroll
                        for (int j = 0; j < 4; ++j) { v0[j] = sigmoidf_(v0[j]); v1[j] = sigmoidf_(v1[j]); }
                        u32x4 w; w.x = cvt_pk_bf16(v0[0], v0[1]); w.y = cvt_pk_bf16(v0[2], v0[3]); w.z = cvt_pk_bf16(v1[0], v1[1]); w.w = cvt_pk_bf16(v1[2], v1[3]);
                        *(u32x4*)(rowp + bj * HALF) = w; } }
        }
    }
};
__device__ __forceinline__ float ubf0(unsigned x) { return (float)(x & 0xffu); }
__device__ __forceinline__ float ubf1(unsigned x) { return (float)((x >> 8) & 0xffu); }
__device__ __forceinline__ float ubf2(unsigned x) { return (float)((x >> 16) & 0xffu); }
__device__ __forceinline__ float ubf3(unsigned x) { return (float)(x >> 24); }
struct EpiMerge {
    static constexpr bool PERM = true, AFTER_DRAIN = false, PREF = false;
    bf16_t* Mg; const bf16_t* gate; int ldg; unsigned mg_bytes;
    __device__ __forceinline__ void operator()(const f32x4 (&acc)[2][2][4][2], const Unit& u, int wr, int wc, int fr, int fq) const {
        const int br = u.pn >> 2, pn = u.pn & 3;
        const int row0 = u.pm * BM + wr * 64 + fr; const int col0 = pn * BM + wc * 32 + 8 * fq;
        const unsigned char* gp = (const unsigned char*)gate + br * 1024;
        const __amdgpu_buffer_rsrc_t rs = __builtin_amdgcn_make_buffer_rsrc((void*)Mg, 0, mg_bytes, 0x00020000);
        typedef unsigned u32x2 __attribute__((ext_vector_type(2))); u32x2 g[2][4][2];
#pragma unroll
        for (int ai = 0; ai < 2; ++ai)
#pragma unroll
            for (int m = 0; m < 4; ++m)
#pragma unroll
                for (int bj = 0; bj < 2; ++bj) { const size_t r = (size_t)(row0 + ai * HALF + m * 16); g[ai][m][bj] = *(const u32x2*)(gp + r * ldg + col0 + bj * HALF); }
        asm volatile("" ::: "memory");
#pragma unroll
        for (int ai = 0; ai < 2; ++ai) {
            u32x4 o[4][2];
#pragma unroll
            for (int m = 0; m < 4; ++m)
#pragma unroll
                for (int bj = 0; bj < 2; ++bj) { const size_t r = (size_t)(row0 + ai * HALF + m * 16);
                    o[m][bj] = (br == 0) ? (u32x4){0u, 0u, 0u, 0u} : __builtin_amdgcn_raw_buffer_load_b128(rs, (unsigned)((r * 1024 + col0 + bj * HALF) * 2), 0, 16); }
            asm volatile("" ::: "memory");
#pragma unroll
            for (int m = 0; m < 4; ++m)
#pragma unroll
                for (int bj = 0; bj < 2; ++bj) { asm volatile("" : "+v"(g[ai][m][bj])); asm volatile("" : "+v"(o[m][bj])); }
#pragma unroll
            for (int m = 0; m < 4; ++m)
#pragma unroll
                for (int bj = 0; bj < 2; ++bj) { const size_t r = (size_t)(row0 + ai * HALF + m * 16);
                    f32x4 v0 = acc[ai][bj][m][0] * (1.0f / 255.0f), v1 = acc[ai][bj][m][1] * (1.0f / 255.0f); const u32x2 gg = g[ai][m][bj]; const u32x4 oo = o[m][bj];
                    v0[0] = v0[0] * ubf0(gg.x) + bflo(oo.x); v0[1] = v0[1] * ubf1(gg.x) + bfhi(oo.x); v0[2] = v0[2] * ubf2(gg.x) + bflo(oo.y); v0[3] = v0[3] * ubf3(gg.x) + bfhi(oo.y);
                    v1[0] = v1[0] * ubf0(gg.y) + bflo(oo.z); v1[1] = v1[1] * ubf1(gg.y) + bfhi(oo.z); v1[2] = v1[2] * ubf2(gg.y) + bflo(oo.w); v1[3] = v1[3] * ubf3(gg.y) + bfhi(oo.w);
                    u32x4 w; w.x = cvt_pk_bf16(v0[0], v0[1]); w.y = cvt_pk_bf16(v0[2], v0[3]); w.z = cvt_pk_bf16(v1[0], v1[1]); w.w = cvt_pk_bf16(v1[2], v1[3]);
                    *(u32x4*)(Mg + r * 1024 + col0 + bj * HALF) = w; }
        }
    }
};
struct MergeOrder {
    static constexpr bool GATHER = false;
    StaticOrder T; const bf16_t* Y0; const bf16_t* Y1; const bf16_t* Y2; const bf16_t* W;
    __device__ __forceinline__ bool next(int i, Unit& u) const { const int ti = i / 3, br = i - 3 * ti; Unit t; if (!T.next(ti, t)) return false; u.pm = t.pm; u.pn = t.pn + 4 * br; return true; }
    __device__ __forceinline__ void a_ready(const Unit&) const {}
    __device__ __forceinline__ void done(const Unit&) const {}
    __device__ __forceinline__ const char* baseA(const Gemm&, const Unit& u, size_t tstep) const { const int br = u.pn >> 2;
        unsigned long long a0 = (unsigned long long)Y0, a1 = (unsigned long long)Y1, a2 = (unsigned long long)Y2; asm volatile("" : "+s"(a0), "+s"(a1), "+s"(a2));
        const unsigned long long a = br == 0 ? a0 : br == 1 ? a1 : a2; return (const char*)a + (size_t)u.pm * tstep; }
    __device__ __forceinline__ const char* baseB(const Gemm&, const Unit& u, size_t tstep) const { return (const char*)W + (size_t)(u.pn >> 2) * (1024 * 512 * 2) + (size_t)(u.pn & 3) * tstep; }
};
struct EpiWo {
    static constexpr bool PERM = true, AFTER_DRAIN = false, PREF = false;
    const void* xin; bf16_t* xout; const float* gate1; int gstride; int row_g0; int seq; bool xf32;
    __device__ __forceinline__ void operator()(const f32x4 (&acc)[2][2][4][2], const Unit& u, int wr, int wc, int fr, int fq) const {
        const int row0 = u.pm * BM + wr * 64 + fr, col0 = u.pn * BM + wc * 32 + 8 * fq;
        const int b = (row_g0 + u.pm * BM) / seq;
        const float* g1 = gate1 + (size_t)b * gstride + col0;
        f32x4 gv[2][2];
#pragma unroll
        for (int bj = 0; bj < 2; ++bj)
#pragma unroll
            for (int n = 0; n < 2; ++n) gv[bj][n] = *(const f32x4*)(g1 + bj * HALF + n * 4);
        if (xf32) {
            const float* xf = (const float*)xin;
#pragma unroll
            for (int ai = 0; ai < 2; ++ai) {
                f32x4 xv[4][2][2];
#pragma unroll
                for (int m = 0; m < 4; ++m)
#pragma unroll
                    for (int bj = 0; bj < 2; ++bj)
#pragma unroll
                        for (int n = 0; n < 2; ++n) xv[m][bj][n] = *(const f32x4*)(xf + (size_t)(row0 + ai * HALF + m * 16) * 1024 + col0 + bj * HALF + n * 4);
                asm volatile("" ::: "memory");
#pragma unroll
                for (int m = 0; m < 4; ++m)
#pragma unroll
                    for (int bj = 0; bj < 2; ++bj) { asm volatile("" : "+v"(xv[m][bj][0])); asm volatile("" : "+v"(xv[m][bj][1])); }
#pragma unroll
                for (int m = 0; m < 4; ++m)
#pragma unroll
                    for (int bj = 0; bj < 2; ++bj) { const f32x4 v0 = xv[m][bj][0] + gv[bj][0] * acc[ai][bj][m][0], v1 = xv[m][bj][1] + gv[bj][1] * acc[ai][bj][m][1];
                        u32x4 w; w.x = cvt_pk_bf16(v0[0], v0[1]); w.y = cvt_pk_bf16(v0[2], v0[3]); w.z = cvt_pk_bf16(v1[0], v1[1]); w.w = cvt_pk_bf16(v1[2], v1[3]);
                        *(u32x4*)(xout + (size_t)(row0 + ai * HALF + m * 16) * 1024 + col0 + bj * HALF) = w; }
            }
        } else {
            const bf16_t* xb = (const bf16_t*)xin;
            u32x4 xv[2][4][2];
#pragma unroll
            for (int ai = 0; ai < 2; ++ai)
#pragma unroll
                for (int m = 0; m < 4; ++m)
#pragma unroll
                    for (int bj = 0; bj < 2; ++bj) xv[ai][m][bj] = *(const u32x4*)(xb + (size_t)(row0 + ai * HALF + m * 16) * 1024 + col0 + bj * HALF);
            asm volatile("" ::: "memory");
#pragma unroll
            for (int ai = 0; ai < 2; ++ai)
#pragma unroll
                for (int m = 0; m < 4; ++m)
#pragma unroll
                    for (int bj = 0; bj < 2; ++bj) asm volatile("" : "+v"(xv[ai][m][bj]));
#pragma unroll
            for (int ai = 0; ai < 2; ++ai)
#pragma unroll
                for (int m = 0; m < 4; ++m)
#pragma unroll
                    for (int bj = 0; bj < 2; ++bj) { const u32x4 o = xv[ai][m][bj]; f32x4 v0 = gv[bj][0] * acc[ai][bj][m][0], v1 = gv[bj][1] * acc[ai][bj][m][1];
                        v0[0] += bflo(o.x); v0[1] += bfhi(o.x); v0[2] += bflo(o.y); v0[3] += bfhi(o.y); v1[0] += bflo(o.z); v1[1] += bfhi(o.z); v1[2] += bflo(o.w); v1[3] += bfhi(o.w);
                        u32x4 w; w.x = cvt_pk_bf16(v0[0], v0[1]); w.y = cvt_pk_bf16(v0[2], v0[3]); w.z = cvt_pk_bf16(v1[0], v1[1]); w.w = cvt_pk_bf16(v1[2], v1[3]);
                        *(u32x4*)(xout + (size_t)(row0 + ai * HALF + m * 16) * 1024 + col0 + bj * HALF) = w; }
        }
    }
};
struct EpiGLU {
    static constexpr bool PERM = true, AFTER_DRAIN = false, PREF = false;
    bf16_t* Gb;
    __device__ __forceinline__ void operator()(const f32x4 (&acc)[2][2][4][2], const Unit& u, int wr, int wc, int fr, int fq) const {
        const int row0 = u.pm * BM + wr * 64 + fr; const int col0 = (u.pn & 3) * HALF + wc * 32 + 8 * fq;
#pragma unroll
        for (int ai = 0; ai < 2; ++ai)
#pragma unroll
            for (int m = 0; m < 4; ++m) { bf16_t* rowp = Gb + (size_t)(row0 + ai * HALF + m * 16) * 512 + col0;
                f32x4 v0, v1;
#pragma unroll
                for (int j = 0; j < 4; ++j) { const float g0 = acc[ai][0][m][0][j], g1 = acc[ai][0][m][1][j];
                    v0[j] = g0 * sigmoidf_(g0) * acc[ai][1][m][0][j]; v1[j] = g1 * sigmoidf_(g1) * acc[ai][1][m][1][j]; }
                u32x4 w; w.x = cvt_pk_bf16(v0[0], v0[1]); w.y = cvt_pk_bf16(v0[2], v0[3]); w.z = cvt_pk_bf16(v1[0], v1[1]); w.w = cvt_pk_bf16(v1[2], v1[3]);
                *(u32x4*)rowp = w; }
    }
};
constexpr int MOE_MAXU = 72;
struct MoeOrder {
    static constexpr bool GATHER = false;
    const PG8_LAS int* tab;
    __device__ __forceinline__ bool next(int i, Unit& u) const {
        if (i >= MOE_MAXU) return false;
        const int v = __builtin_amdgcn_readfirstlane(tab[i]); if (v < 0) return false;
        u.pm = v & 0xffff; u.pn = v >> 16; return true;
    }
    __device__ __forceinline__ void a_ready(const Unit&) const {}
    __device__ __forceinline__ void done(const Unit&) const {}
    __device__ __forceinline__ const char* baseA(const Gemm& g, const Unit& u, size_t tstep) const { return (const char*)g.A + (size_t)u.pm * tstep; }
    __device__ __forceinline__ const char* baseB(const Gemm& g, const Unit& u, size_t tstep) const { return (const char*)g.Bt + (size_t)u.pn * tstep; }
};
__device__ __forceinline__ void moe_build_units(PG8_LAS int* tab, const int* tile_start_g, int G, int c, int tid) {
    PG8_LAS int* tile_start = tab + MOE_MAXU;
    if (tid < 33) tile_start[tid] = tile_start_g[tid];
    __syncthreads();
    if (tid < MOE_MAXU) {
        const int i = tid; int v = -1;
        if ((G & 7) == 0) {
            const int xcd = c & 7, W = G >> 3, U = 4 * tile_start[32];
            const int lo = ((U * xcd) >> 3) & ~3, hi = (xcd == 7) ? U : (((U * (xcd + 1)) >> 3) & ~3);
            const int u = lo + i * W + (c >> 3);
            if (u < hi) { const int r = u >> 2; int e = 0;
#pragma unroll 1
                for (int k = 1; k < 32; ++k) e = (r >= tile_start[k]) ? k : e;
                v = r | ((e * 4 + (u & 3)) << 16); }
        } else {
            const int L = i * G + c, r = L >> 2;
            if (r < tile_start[32]) { int e = 0;
#pragma unroll 1
                for (int k = 1; k < 32; ++k) e = (r >= tile_start[k]) ? k : e;
                v = r | ((e * 4 + (L & 3)) << 16); }
        }
        tab[i] = v;
    }
}

struct EpiRouter {
    static constexpr bool PERM = false, AFTER_DRAIN = true, PREF = false;
    __device__ __forceinline__ void operator()(const f32x4 (&)[2][2][4][2], const Unit&, int, int, int, int) const {}
    __device__ __forceinline__ void fused(const f32x4 (&acc)[2][2][4][2], const Unit&, int wr, int wc, int fr, int fq, PG8_LAS unsigned char* lds, int, int) const {
        PG8_LAS float* tab = (PG8_LAS float*)lds + ((wc >= 2) ? 256 * 36 : 0);
        const int cb = 32 * (wc & 1) + 4 * fq;
#pragma unroll
        for (int ai = 0; ai < 2; ++ai)
#pragma unroll
            for (int m = 0; m < 4; ++m) { const int row = 128 * ai + 64 * wr + 16 * m + fr;
#pragma unroll
                for (int n = 0; n < 2; ++n) { const int col = cb + 16 * n;
                    if (col < 36) *(PG8_LAS f32x4*)(tab + row * 36 + col) = acc[ai][0][m][n]; } }
    }
};
struct OneUnitOrder {
    static constexpr bool GATHER = false;
    int pm;
    __device__ __forceinline__ bool next(int i, Unit& u) const { if (i != 0) return false; u.pm = pm; u.pn = 0; return true; }
    __device__ __forceinline__ void a_ready(const Unit&) const {}
    __device__ __forceinline__ void done(const Unit&) const {}
    __device__ __forceinline__ const char* baseA(const Gemm& g, const Unit& u, size_t tstep) const { return (const char*)g.A + (size_t)u.pm * tstep; }
    __device__ __forceinline__ const char* baseB(const Gemm& g, const Unit& u, size_t tstep) const { return (const char*)g.Bt + (size_t)u.pn * tstep; }
};


typedef int i32x4 __attribute__((ext_vector_type(4)));
__device__ __forceinline__ f32x4 i2f(const i32x4 v) { return __builtin_convertvector(v, f32x4); }
struct EpiPlainI8 {
    static constexpr bool PERM = true, AFTER_DRAIN = false, PREF = true;
    bf16_t* O; int ldc; const float* sa; const float* sw;
    __device__ __forceinline__ void prefetch(const Unit& u, int par, PG8_LAS unsigned char* lds, int wid, int lane) const {
        const float* src = (wid < 4) ? sa + u.pm * BM + wid * 64 + lane : sw + u.pn * BM + (wid - 4) * 64 + lane;
        __builtin_amdgcn_global_load_lds((const unsigned*)src, (PG8_LAS unsigned*)(lds + STAGE_BYTES + par * 3072 + wid * 256), 4, 0, 0);
    }
    __device__ __forceinline__ void operator()(const i32x4 (&acc)[2][2][4][2], const Unit& u, int wr, int wc, int fr, int fq, PG8_LAS unsigned char* lds, int par) const {
        const int row0 = u.pm * BM + wr * 64 + fr; const int col0 = u.pn * BM + wc * 32 + 8 * fq;
        const PG8_LAS float* sal = (const PG8_LAS float*)(lds + STAGE_BYTES + par * 3072); const PG8_LAS float* swl = sal + 256 + wc * 32 + 8 * fq;
        f32x4 s0[2], s1[2];
#pragma unroll
        for (int bj = 0; bj < 2; ++bj) { s0[bj] = *(const PG8_LAS f32x4*)(swl + bj * HALF); s1[bj] = *(const PG8_LAS f32x4*)(swl + bj * HALF + 4); }
#pragma unroll
        for (int ai = 0; ai < 2; ++ai)
#pragma unroll
            for (int m = 0; m < 4; ++m) { const int r = row0 + ai * HALF + m * 16; const float a = sal[wr * 64 + fr + ai * HALF + m * 16]; bf16_t* rowp = O + (size_t)r * ldc + col0;
#pragma unroll
                for (int bj = 0; bj < 2; ++bj) { const f32x4 v0 = i2f(acc[ai][bj][m][0]) * (s0[bj] * a), v1 = i2f(acc[ai][bj][m][1]) * (s1[bj] * a);
                    u32x4 w; w.x = cvt_pk_bf16(v0[0], v0[1]); w.y = cvt_pk_bf16(v0[2], v0[3]); w.z = cvt_pk_bf16(v1[0], v1[1]); w.w = cvt_pk_bf16(v1[2], v1[3]);
                    *(u32x4*)(rowp + bj * HALF) = w; } }
    }
};
#ifndef EPIREP
#define EPIREP 0
#endif
struct EpiB2I8 {
    static constexpr bool PERM = true, AFTER_DRAIN = false, PREF = true;
    bf16_t* P; int ldp; int npl; bf16_t* Gt; int ldg; const float* bias; const float* sa; const float* sw;
    __device__ __forceinline__ void prefetch(const Unit& u, int par, PG8_LAS unsigned char* lds, int wid, int lane) const {
        const float* src = (wid < 4) ? sa + u.pm * BM + wid * 64 + lane : sw + u.pn * BM + (wid - 4) * 64 + lane;
        __builtin_amdgcn_global_load_lds((const unsigned*)src, (PG8_LAS unsigned*)(lds + STAGE_BYTES + par * 3072 + wid * 256), 4, 0, 0);
        if (wid >= 4 && u.pn >= npl) __builtin_amdgcn_global_load_lds((const unsigned*)(bias + (u.pn - npl) * BM + (wid - 4) * 64 + lane), (PG8_LAS unsigned*)(lds + STAGE_BYTES + par * 3072 + 1024 + wid * 256), 4, 0, 0);
    }
    __device__ __forceinline__ void operator()(const i32x4 (&acc)[2][2][4][2], const Unit& u, int wr, int wc, int fr, int fq, PG8_LAS unsigned char* lds, int par) const {
      for (int rep_ = 0; rep_ < 1 + EPIREP; ++rep_) {
        asm volatile("" ::: "memory");
        const int row0 = u.pm * BM + wr * 64 + fr; const int colw = u.pn * BM + wc * 32 + 8 * fq;
        const PG8_LAS float* sal = (const PG8_LAS float*)(lds + STAGE_BYTES + par * 3072); const PG8_LAS float* swl = sal + 256 + wc * 32 + 8 * fq;
        f32x4 s0[2], s1[2];
#pragma unroll
        for (int bj = 0; bj < 2; ++bj) { s0[bj] = *(const PG8_LAS f32x4*)(swl + bj * HALF); s1[bj] = *(const PG8_LAS f32x4*)(swl + bj * HALF + 4); }
        if (u.pn < npl) {
#pragma unroll
            for (int ai = 0; ai < 2; ++ai)
#pragma unroll
                for (int m = 0; m < 4; ++m) { const int r = row0 + ai * HALF + m * 16; const float a = sal[wr * 64 + fr + ai * HALF + m * 16]; bf16_t* rowp = P + (size_t)r * ldp + colw;
#pragma unroll
                    for (int bj = 0; bj < 2; ++bj) { const f32x4 v0 = i2f(acc[ai][bj][m][0]) * (s0[bj] * a), v1 = i2f(acc[ai][bj][m][1]) * (s1[bj] * a);
                        u32x4 w; w.x = cvt_pk_bf16(v0[0], v0[1]); w.y = cvt_pk_bf16(v0[2], v0[3]); w.z = cvt_pk_bf16(v1[0], v1[1]); w.w = cvt_pk_bf16(v1[2], v1[3]);
                        *(u32x4*)(rowp + bj * HALF) = w; } }
        } else {
            const int col0 = (u.pn - npl) * BM + wc * 32 + 8 * fq; const float NL2E = -1.4426950408889634f;
            f32x4 b0[2], b1[2];
#pragma unroll
            for (int bj = 0; bj < 2; ++bj) { b0[bj] = *(const PG8_LAS f32x4*)(swl + 256 + bj * HALF) * NL2E; b1[bj] = *(const PG8_LAS f32x4*)(swl + 256 + bj * HALF + 4) * NL2E; }
#pragma unroll
            for (int ai = 0; ai < 2; ++ai)
#pragma unroll
                for (int m = 0; m < 4; ++m) { const int r = row0 + ai * HALF + m * 16; const float a = sal[wr * 64 + fr + ai * HALF + m * 16] * NL2E; unsigned char* rowp = (unsigned char*)Gt + (size_t)r * ldg + col0;
#pragma unroll
                    for (int bj = 0; bj < 2; ++bj) { f32x4 v0 = i2f(acc[ai][bj][m][0]) * (s0[bj] * a) + b0[bj], v1 = i2f(acc[ai][bj][m][1]) * (s1[bj] * a) + b1[bj];
#pragma unroll
                        for (int j = 0; j < 4; ++j) { v0[j] = __builtin_amdgcn_rcpf(__builtin_fmaf(__builtin_amdgcn_exp2f(v0[j]), 1.0f / 255.0f, 1.0f / 255.0f)); v1[j] = __builtin_amdgcn_rcpf(__builtin_fmaf(__builtin_amdgcn_exp2f(v1[j]), 1.0f / 255.0f, 1.0f / 255.0f)); }
                        typedef unsigned u32x2 __attribute__((ext_vector_type(2))); u32x2 w; w.x = 0u; w.y = 0u;
                        w.x = __builtin_amdgcn_cvt_pk_u8_f32(v0[0], 0, w.x); w.x = __builtin_amdgcn_cvt_pk_u8_f32(v0[1], 1, w.x); w.x = __builtin_amdgcn_cvt_pk_u8_f32(v0[2], 2, w.x); w.x = __builtin_amdgcn_cvt_pk_u8_f32(v0[3], 3, w.x);
                        w.y = __builtin_amdgcn_cvt_pk_u8_f32(v1[0], 0, w.y); w.y = __builtin_amdgcn_cvt_pk_u8_f32(v1[1], 1, w.y); w.y = __builtin_amdgcn_cvt_pk_u8_f32(v1[2], 2, w.y); w.y = __builtin_amdgcn_cvt_pk_u8_f32(v1[3], 3, w.y);
                        *(u32x2*)(rowp + bj * HALF) = w; } }
        }
      }
    }
};
struct EpiGLUI8 {
    static constexpr bool PERM = true, AFTER_DRAIN = false, PREF = true;
    bf16_t* Gb; const float* sa; const float* sw;
    __device__ __forceinline__ void prefetch(const Unit& u, int par, PG8_LAS unsigned char* lds, int wid, int lane) const {
        const float* src = (wid < 4) ? sa + u.pm * BM + wid * 64 + lane : sw + (size_t)(u.pn >> 2) * 1024 + (u.pn & 3) * BM + (wid - 4) * 64 + lane;
        __builtin_amdgcn_global_load_lds((const unsigned*)src, (PG8_LAS unsigned*)(lds + STAGE_BYTES + par * 3072 + wid * 256), 4, 0, 0);
    }
    __device__ __forceinline__ void operator()(const i32x4 (&acc)[2][2][4][2], const Unit& u, int wr, int wc, int fr, int fq, PG8_LAS unsigned char* lds, int par) const {
        const int row0 = u.pm * BM + wr * 64 + fr; const int col0 = (u.pn & 3) * HALF + wc * 32 + 8 * fq;
        const PG8_LAS float* sal = (const PG8_LAS float*)(lds + STAGE_BYTES + par * 3072); const PG8_LAS float* swp = sal + 256 + wc * 32 + 8 * fq;
        const f32x4 g0 = *(const PG8_LAS f32x4*)swp, g1 = *(const PG8_LAS f32x4*)(swp + 4), u0 = *(const PG8_LAS f32x4*)(swp + HALF), u1 = *(const PG8_LAS f32x4*)(swp + HALF + 4);
#pragma unroll
        for (int ai = 0; ai < 2; ++ai)
#pragma unroll
            for (int m = 0; m < 4; ++m) { const int r = row0 + ai * HALF + m * 16; const float a = sal[wr * 64 + fr + ai * HALF + m * 16]; bf16_t* rowp = Gb + (size_t)r * 512 + col0;
                const f32x4 ga = i2f(acc[ai][0][m][0]) * (g0 * a), gb = i2f(acc[ai][0][m][1]) * (g1 * a), ua = i2f(acc[ai][1][m][0]) * (u0 * a), ub = i2f(acc[ai][1][m][1]) * (u1 * a);
                f32x4 v0, v1;
#pragma unroll
                for (int j = 0; j < 4; ++j) { v0[j] = ga[j] * sigmoidf_(ga[j]) * ua[j]; v1[j] = gb[j] * sigmoidf_(gb[j]) * ub[j]; }
                u32x4 w; w.x = cvt_pk_bf16(v0[0], v0[1]); w.y = cvt_pk_bf16(v0[2], v0[3]); w.z = cvt_pk_bf16(v1[0], v1[1]); w.w = cvt_pk_bf16(v1[2], v1[3]);
                *(u32x4*)rowp = w; }
    }
};

template <class Epi, class Sched, bool STAMP = false, bool I8 = false>
__device__ __forceinline__ void gemm_phase(PG8_LAS unsigned char* lds, const Gemm g, const Sched& S, const Epi& E, unsigned long long* stamps, int tid) {
    asm volatile("" : "+v"(tid));
    const int wid = __builtin_amdgcn_readfirstlane(tid >> 6), lane = tid & 63, wr = wid >> 2, wc = wid & 3, fr = lane & 15, fq = lane >> 4;
    const int K = g.K, nt = K / BK;
    int ts_lo = 0, ts_hi = 0, nts = 0; const unsigned long long rt_entry = STAMP ? (unsigned long long)wall_clock64() : 0ull;
#define PG8_STAMP() do { if (STAMP && wid == 0 && nts < 64) { const unsigned long long _c = (unsigned long long)clock64(); \
        ts_lo = (lane == nts) ? (int)(unsigned)_c : ts_lo; ts_hi = (lane == nts) ? (int)(unsigned)(_c >> 32) : ts_hi; ++nts; } } while (0)
    PG8_STAMP();
    unsigned voffA[2], voffB[2];
#pragma unroll
    for (int i = 0; i < 2; ++i) { int R, C; stage_rc(tid * 16 + i * 8192, R, C); const int Rb = Epi::PERM ? ((R & ~31) + perm32(R & 31)) : R;
        voffA[i] = (unsigned)(R * K + C) * 2u; voffB[i] = (unsigned)(Rb * K + C) * 2u; }
    const size_t kstep = (size_t)(BK * 2);
    const size_t hstep = (size_t)HALF * K * 2;
    const size_t tstep = 2 * hstep;
    const unsigned ldsw = (unsigned)wid * 1024u;
    const int aoff = lds_byte(wr * 64 + fr, fq * 8), boff = lds_byte(wc * 32 + fr, fq * 8);
#define PG8_SA(b, h) (((b) * 2 + (h)) * HTB)
#define PG8_SB(b, h) ((4 + (b) * 2 + (h)) * HTB)
#define PG8_STAGE(bufoff, gbase, voff) do { _Pragma("unroll") for (int _i = 0; _i < 2; ++_i) \
        __builtin_amdgcn_global_load_lds((const unsigned*)((const char*)(gbase) + (voff)[_i]), (PG8_LAS unsigned*)(lds + (bufoff) + ldsw + _i * 8192), 16, 0, 0); } while (0)
#define PG8_LDA(dst, b, h) do { _Pragma("unroll") for (int m = 0; m < 4; ++m) _Pragma("unroll") for (int k = 0; k < 2; ++k) dst[m][k] = *(const PG8_LAS bf16x8*)(lds + PG8_SA(b, h) + aoff + m * 2048 + k * 1024); } while (0)
#define PG8_LDB(dst, b, h) do { _Pragma("unroll") for (int n = 0; n < 2; ++n) _Pragma("unroll") for (int k = 0; k < 2; ++k) dst[n][k] = *(const PG8_LAS bf16x8*)(lds + PG8_SB(b, h) + boff + n * 2048 + k * 1024); } while (0)
#define PG8_MMA(ai, bj, At, Bt) do { __builtin_amdgcn_s_setprio(1); _Pragma("unroll") for (int m = 0; m < 4; ++m) _Pragma("unroll") for (int n = 0; n < 2; ++n) _Pragma("unroll") for (int k = 0; k < 2; ++k) \
        { if constexpr (I8) acc[ai][bj][m][n] = __builtin_bit_cast(AccT, __builtin_amdgcn_mfma_i32_16x16x64_i8(__builtin_bit_cast(i32x4_t, Bt[n][k]), __builtin_bit_cast(i32x4_t, At[m][k]), __builtin_bit_cast(i32x4_t, acc[ai][bj][m][n]), 0, 0, 0)); \
          else acc[ai][bj][m][n] = __builtin_bit_cast(AccT, __builtin_amdgcn_mfma_f32_16x16x32_bf16(Bt[n][k], At[m][k], __builtin_bit_cast(f32x4, acc[ai][bj][m][n]), 0, 0, 0)); } __builtin_amdgcn_s_setprio(0); } while (0)
#define PG8_WAIT_V(n) asm volatile("s_waitcnt vmcnt(" #n ")" ::: "memory")
#define PG8_WAIT_L(n) asm volatile("s_waitcnt lgkmcnt(" #n ")" ::: "memory")
#define PG8_BAR __builtin_amdgcn_s_barrier()
#define PG8_SCHED __builtin_amdgcn_sched_barrier(0)
    Unit cur, nxt; int ui = 0;
    if (!S.next(0, cur)) return;
    typedef int i32x4_t __attribute__((ext_vector_type(4)));
    typedef typename std::conditional<I8, i32x4_t, f32x4>::type AccT;
    AccT acc[2][2][4][2];
#pragma unroll
    for (int a = 0; a < 2; ++a)
#pragma unroll
        for (int b = 0; b < 2; ++b)
#pragma unroll
            for (int m = 0; m < 4; ++m)
#pragma unroll
                for (int n = 0; n < 2; ++n) acc[a][b][m][n] = (AccT){0, 0, 0, 0};
    bf16x8 At[4][2], B0[2][2], B1[2][2];
    const char* cA = S.baseA(g, cur, tstep); const char* cB = S.baseB(g, cur, tstep);
    S.a_ready(cur);
    PG8_STAGE(PG8_SB(0, 0), cB, voffB); PG8_STAGE(PG8_SA(0, 0), cA, voffA); PG8_STAGE(PG8_SB(0, 1), cB + hstep, voffB); PG8_STAGE(PG8_SA(0, 1), cA + hstep, voffA);
    if (wr == 1) PG8_BAR;
    PG8_WAIT_V(4); PG8_BAR;
    PG8_STAGE(PG8_SB(1, 0), cB + kstep, voffB); PG8_STAGE(PG8_SA(1, 0), cA + kstep, voffA); PG8_STAGE(PG8_SB(1, 1), cB + hstep + kstep, voffB);
    PG8_WAIT_V(6); PG8_BAR;
    PG8_STAMP();
    for (;;) {
        if constexpr (Epi::PREF) E.prefetch(cur, ui & 1, lds, wid, lane);
        const bool has_next = S.next(ui + 1, nxt);
        const char* nA = has_next ? S.baseA(g, nxt, tstep) : cA; const char* nB = has_next ? S.baseB(g, nxt, tstep) : cB;
        for (int t = 0; t < nt; t += 2) {
            const bool last = (t == nt - 2);
            const char* a1 = cA + (size_t)(t + 1) * kstep;
            const char* a2 = last ? nA : cA + (size_t)(t + 2) * kstep; const char* b2 = last ? nB : cB + (size_t)(t + 2) * kstep;
            const char* a3 = a2 + kstep; const char* b3 = b2 + kstep;
            if (last && has_next) S.a_ready(nxt);
            PG8_LDB(B0, 0, 0); PG8_SCHED; PG8_LDA(At, 0, 0); PG8_STAGE(PG8_SA(1, 1), a1 + hstep, voffA);
            PG8_WAIT_L(8); PG8_BAR; PG8_WAIT_L(0); PG8_MMA(0, 0, At, B0); PG8_BAR; PG8_SCHED;
            PG8_LDB(B1, 0, 1); PG8_STAGE(PG8_SB(0, 0), b2, voffB);
            PG8_BAR; PG8_WAIT_L(0); PG8_MMA(0, 1, At, B1); PG8_BAR;
            PG8_LDA(At, 0, 1); PG8_STAGE(PG8_SA(0, 0), a2, voffA);
            PG8_BAR; PG8_WAIT_L(0); PG8_MMA(1, 0, At, B0); PG8_BAR; PG8_SCHED;
            PG8_STAGE(PG8_SB(0, 1), b2 + hstep, voffB);
            PG8_WAIT_V(6); PG8_BAR; PG8_MMA(1, 1, At, B1); PG8_BAR;
            PG8_LDB(B0, 1, 0); PG8_SCHED; PG8_LDA(At, 1, 0); PG8_STAGE(PG8_SA(0, 1), a2 + hstep, voffA);
            PG8_WAIT_L(8); PG8_BAR; PG8_WAIT_L(0); PG8_MMA(0, 0, At, B0); PG8_BAR; PG8_SCHED;
            PG8_LDB(B1, 1, 1); PG8_STAGE(PG8_SB(1, 0), b3, voffB);
            PG8_BAR; PG8_WAIT_L(0); PG8_MMA(0, 1, At, B1); PG8_BAR;
            PG8_LDA(At, 1, 1); PG8_STAGE(PG8_SA(1, 0), a3, voffA);
            PG8_BAR; PG8_WAIT_L(0); PG8_MMA(1, 0, At, B0); PG8_BAR; PG8_SCHED;
            PG8_STAGE(PG8_SB(1, 1), b3 + hstep, voffB);
            PG8_WAIT_V(6); PG8_BAR; PG8_MMA(1, 1, At, B1); PG8_BAR;
        }
        PG8_STAMP();
        if constexpr (!Epi::AFTER_DRAIN) { if constexpr (Epi::PREF) E(acc, cur, wr, wc, fr, fq, lds, ui & 1); else E(acc, cur, wr, wc, fr, fq); S.done(cur); }
        PG8_STAMP();
        if (!has_next) break;
#pragma unroll
        for (int a = 0; a < 2; ++a)
#pragma unroll
            for (int b = 0; b < 2; ++b)
#pragma unroll
                for (int m = 0; m < 4; ++m)
#pragma unroll
                    for (int n = 0; n < 2; ++n) acc[a][b][m][n] = (AccT){0, 0, 0, 0};
        cur = nxt; cA = nA; cB = nB; ++ui;
    }
    PG8_WAIT_V(0);
    if (wr == 0) PG8_BAR;
    PG8_BAR;
    if constexpr (Epi::AFTER_DRAIN) { E.fused(acc, cur, wr, wc, fr, fq, lds, wid, lane); S.done(cur); }
    PG8_STAMP();
    if (STAMP && wid == 0) { stamps[lane] = lane < nts ? (((unsigned long long)(unsigned)ts_hi << 32) | (unsigned)ts_lo) : 0ull;
        if (lane == 62) stamps[62] = rt_entry; if (lane == 63) stamps[63] = (unsigned long long)wall_clock64(); }
#undef PG8_STAMP
#undef PG8_SA
#undef PG8_SB
#undef PG8_STAGE
#undef PG8_LDA
#undef PG8_LDB
#undef PG8_MMA
#undef PG8_WAIT_V
#undef PG8_WAIT_L
#undef PG8_BAR
#undef PG8_SCHED
}
}

#define GAS __attribute__((address_space(1)))
#define LAS __attribute__((address_space(3)))
typedef unsigned short bf16;
#define PIN(x) asm volatile("" : "+v"(x))
#define WS_OPAQUE(p_) ({ unsigned long long w_ = (unsigned long long)(p_); asm volatile("" : "+s"(w_)); (unsigned char*)(GAS unsigned char*)w_; })
typedef unsigned v4u __attribute__((ext_vector_type(4)));
typedef unsigned v2u __attribute__((ext_vector_type(2)));
typedef float f32x4 __attribute__((ext_vector_type(4)));
typedef float f32x16 __attribute__((ext_vector_type(16)));
typedef short bf16x8 __attribute__((ext_vector_type(8)));
typedef short bf16x4 __attribute__((ext_vector_type(4)));

constexpr int NB = 8, SEQ = 8192, T = NB * SEQ, D = 1024, MW = 512, NL = 2;
constexpr int HT = T / 2;
constexpr int N_RWKV = 1792, N_REST = 3584, N_GATE = 3072, N1 = N_RWKV + N_REST + N_GATE;
constexpr int NSLOT_MAX = 2 * T + 32 * 256;
constexpr int NWAVES = 8, NTHR = 512;

constexpr size_t MiB = (size_t)1 << 20;
constexpr size_t WS_CTL = 0, CTL_ZERO_BYTES = 2 * MiB;
constexpr size_t WS_MOD = 1 * MiB;
constexpr size_t WS_WT1 = 2 * MiB;
constexpr size_t WS_WBR = 35 * MiB;
constexpr size_t WS_WO = 41 * MiB;
constexpr size_t WS_LOT = 45 * MiB;
constexpr size_t WS_WR = 46 * MiB;
constexpr size_t WS_AMAX1 = 512 * 1024;
constexpr size_t WS_AMAXE = 640 * 1024;
constexpr size_t WS_W81 = 2 * MiB;
constexpr size_t WS_SW1 = 47 * MiB;
constexpr size_t WS_SWE = 47 * MiB + 128 * 1024;
constexpr size_t WS_H8M = 472 * MiB;
constexpr size_t TAB_SA = 5 * MiB, TAB_XS = 6 * MiB;
constexpr size_t WS_H = 48 * MiB;
constexpr size_t WS_YRWKV = 176 * MiB;
constexpr size_t WS_X2 = 112 * MiB;
constexpr size_t WS_H2 = 336 * MiB;
constexpr size_t WS_R = 240 * MiB;
constexpr size_t WS_PRW = WS_R;
constexpr size_t WS_SI = 464 * MiB;
constexpr size_t WS_E1 = 848 * MiB;
constexpr size_t WS_GT = 912 * MiB;
constexpr size_t WS_PREST = WS_R;
constexpr size_t WS_GATES = 464 * MiB;
constexpr size_t WS_YRET = 656 * MiB;
constexpr size_t WS_YCONV = 688 * MiB;
constexpr size_t WS_MERGED = 720 * MiB;
constexpr size_t WS_KV = 784 * MiB;
constexpr size_t WS_SST = 848 * MiB;
constexpr size_t OUT_WGU = 128 * MiB;
constexpr size_t OUT_WD = 160 * MiB;
constexpr size_t WS_XROWS = 336 * MiB;
constexpr size_t WS_GB = 608 * MiB;
constexpr size_t WS_YM = 744 * MiB;
constexpr size_t WS_TAB = 1016 * MiB;
constexpr size_t TAB_ROWTOK = 0, TAB_SLOTOF = 1 * MiB, TAB_RW = 2 * MiB, TAB_EID = 3 * MiB, TAB_CNT = 4 * MiB, TAB_TILEE = 4 * MiB + 512 * 1024, TAB_NT = TAB_TILEE + 4096;
constexpr size_t WS_END = 1024 * MiB;
constexpr int CW_BAR = 4096;

constexpr int LDS_BYTES = 163840;
constexpr int LDS_MISC = LDS_BYTES - 256;

#define LDS_WAIT() asm volatile("s_waitcnt lgkmcnt(0)" ::: "memory")
#define VM_WAIT() asm volatile("s_waitcnt vmcnt(0)" ::: "memory")

#define XB_TMO      128
#define XB_XCNT(j)  (256  + 64 * (j))
#define XB_XSUB(j)  (1280 + 64 * (j))
#define XB_XGEN(j)  (2304 + 64 * (j))
#define XB_TOP      3328
#define XB_TOPGEN   3392
#define XCD_BAR_WORDS 3456
#define XB_SPIN_CAP (1u << 20)

__device__ __forceinline__ unsigned xb_ld(unsigned* p)              { return __hip_atomic_load(p, __ATOMIC_RELAXED, __HIP_MEMORY_SCOPE_AGENT); }
__device__ __forceinline__ unsigned xb_add(unsigned* p, unsigned v) { return __hip_atomic_fetch_add(p, v, __ATOMIC_RELAXED, __HIP_MEMORY_SCOPE_AGENT); }
__device__ __forceinline__ unsigned xb_xcc_id() { return (unsigned)__builtin_amdgcn_s_getreg((3 << 11) | 20) & 0xFu; }
#define XB_SPIN(cond, bar) do { unsigned _sp = 0; while (cond) { __builtin_amdgcn_s_sleep(1); \
    if ((++_sp & 255u) == 0u) { if (xb_ld(&(bar)[XB_TMO])) break; if (_sp > XB_SPIN_CAP) { atomicAdd(&(bar)[XB_TMO], 1u); break; } } } } while (0)

struct XcdBarrier {
    unsigned* bar; unsigned x;
    volatile LAS unsigned* st;
};
__device__ __forceinline__ XcdBarrier xcd_barrier_post(unsigned* bar, volatile LAS unsigned* st, int tid) {
    XcdBarrier b; b.bar = bar; b.x = xb_xcc_id(); b.st = st;
    if (tid == 0) (void)xb_add(&bar[XB_XCNT(b.x)], 1u);
    return b;
}
__device__ __forceinline__ void xcd_barrier_complete(unsigned* bar, unsigned x, unsigned& nloc, unsigned& nx) {
    const unsigned G = gridDim.x * gridDim.y * gridDim.z;
    unsigned sum, cnt, mine, sp = 0u;
    for (;;) {
        sum = 0u; cnt = 0u; mine = 0u;
#pragma unroll
        for (unsigned j = 0; j < 16; ++j) { const unsigned c = xb_ld(&bar[XB_XCNT(j)]); sum += c; cnt += (c > 0u) ? 1u : 0u; mine = (j == x) ? c : mine; }
        if (sum == G) break;
        __builtin_amdgcn_s_sleep(1);
        if ((++sp & 255u) == 0u) { if (xb_ld(&bar[XB_TMO])) break; if (sp > XB_SPIN_CAP) { atomicAdd(&bar[XB_TMO], 1u); break; } }
    }
    nloc = mine > 0u ? mine : 1u; nx = cnt > 0u ? cnt : 1u;
}
__device__ __forceinline__ void xcd_barrier(const XcdBarrier& b, int tid) {
    asm volatile("s_waitcnt vmcnt(0)" ::: "memory");
    __syncthreads();
    if (tid == 0) {
        unsigned* bar = b.bar;
        __builtin_amdgcn_s_waitcnt(0);
        unsigned nloc = b.st[0], nx = b.st[1];
        if (nloc == 0u) { xcd_barrier_complete(bar, b.x, nloc, nx); b.st[0] = nloc; b.st[1] = nx; }
        const unsigned old = xb_add(&bar[XB_XSUB(b.x)], 1u);
        const unsigned gen = old / nloc;
        if (old + 1u == (gen + 1u) * nloc) {
            __builtin_amdgcn_fence(__ATOMIC_RELEASE, "agent");
            asm volatile("s_waitcnt vmcnt(0)" ::: "memory");
            const unsigned og = xb_add(&bar[XB_TOP], 1u);
            const unsigned tg = og / nx;
            if (og + 1u == (tg + 1u) * nx) xb_add(&bar[XB_TOPGEN], 1u);
            else XB_SPIN(xb_ld(&bar[XB_TOPGEN]) == tg, bar);
            xb_add(&bar[XB_XGEN(b.x)], 1u);
            __builtin_amdgcn_fence(__ATOMIC_ACQUIRE, "agent");
            asm volatile("s_waitcnt vmcnt(0)" ::: "memory");
        } else {
            XB_SPIN(xb_ld(&bar[XB_XGEN(b.x)]) == gen, bar);
            __builtin_amdgcn_fence(__ATOMIC_ACQUIRE, "agent");
            asm volatile("s_waitcnt vmcnt(0)" ::: "memory");
        }
    }
    __syncthreads();
}

__device__ __forceinline__ float bflo(unsigned u) { return __uint_as_float(u << 16); }
__device__ __forceinline__ float bfhi(unsigned u) { return __uint_as_float(u & 0xffff0000u); }
__device__ __forceinline__ unsigned pk2(float lo, float hi) { return pg8::cvt_pk_bf16(lo, hi); }
__device__ __forceinline__ void unpk8(const v4u a, float (&o)[8]) { o[0] = bflo(a.x); o[1] = bfhi(a.x); o[2] = bflo(a.y); o[3] = bfhi(a.y); o[4] = bflo(a.z); o[5] = bfhi(a.z); o[6] = bflo(a.w); o[7] = bfhi(a.w); }
__device__ __forceinline__ v4u pk8(const float (&x)[8]) { v4u o; o.x = pk2(x[0], x[1]); o.y = pk2(x[2], x[3]); o.z = pk2(x[4], x[5]); o.w = pk2(x[6], x[7]); return o; }
__device__ __forceinline__ float sigm(float x) { return __builtin_amdgcn_rcpf(1.0f + __expf(-x)); }
__device__ __forceinline__ float dppf(float x, const int ctrl) { return x; }
#define DPP_F(x, ctrl, rm, bm, bc) __builtin_bit_cast(float, __builtin_amdgcn_update_dpp(0, __builtin_bit_cast(int, (x)), (ctrl), (rm), (bm), (bc)))
__device__ __forceinline__ float sum16(float x) {
    x += DPP_F(x, 0xB1, 0xf, 0xf, false);
    x += DPP_F(x, 0x4E, 0xf, 0xf, false);
    x += DPP_F(x, 0x141, 0xf, 0xf, false);
    x += DPP_F(x, 0x140, 0xf, 0xf, false);
    return x;
}
__device__ __forceinline__ float wave_sum(float x) {
    x = sum16(x);
    x += DPP_F(x, 0x142, 0xa, 0xf, false);
    x += DPP_F(x, 0x143, 0xc, 0xf, false);
    return __builtin_bit_cast(float, __builtin_amdgcn_readlane(__builtin_bit_cast(int, x), 63));
}
__device__ __forceinline__ float xor_lane(float x, int lane, int m) { return __builtin_bit_cast(float, __builtin_amdgcn_ds_bpermute((lane ^ m) << 2, __builtin_bit_cast(int, x))); }
__device__ __forceinline__ float wave_max_pos(float x) {
    x = fmaxf(x, DPP_F(x, 0xB1, 0xf, 0xf, false)); x = fmaxf(x, DPP_F(x, 0x4E, 0xf, 0xf, false)); x = fmaxf(x, DPP_F(x, 0x141, 0xf, 0xf, false)); x = fmaxf(x, DPP_F(x, 0x140, 0xf, 0xf, false));
    x = fmaxf(x, DPP_F(x, 0x142, 0xa, 0xf, false)); x = fmaxf(x, DPP_F(x, 0x143, 0xc, 0xf, false));
    return __builtin_bit_cast(float, __builtin_amdgcn_readlane(__builtin_bit_cast(int, x), 63));
}
__device__ __forceinline__ unsigned q8x4(float a, float b, float c, float d) {
    const int ia = (int)__builtin_rintf(a), ib = (int)__builtin_rintf(b), ic = (int)__builtin_rintf(c), id = (int)__builtin_rintf(d);
    return (unsigned)(ia & 0xff) | ((unsigned)(ib & 0xff) << 8) | ((unsigned)(ic & 0xff) << 16) | ((unsigned)(id & 0xff) << 24);
}
__device__ __forceinline__ float sum8(float x) {
    x += DPP_F(x, 0xB1, 0xf, 0xf, false);
    x += DPP_F(x, 0x4E, 0xf, 0xf, false);
    x += DPP_F(x, 0x141, 0xf, 0xf, false);
    return x;
}

struct Params {
    const void* in[32];
    float* out;
    unsigned char* ws;
    int lo, hi;
};

__device__ __forceinline__ void tr_block(const float* W, int ldsrc, bf16* WT, int ldt, int k0, LAS float* scr, int lane) {
    {   float t[32];
#pragma unroll
        for (int i = 0; i < 32; ++i) { const int kk = 2 * i + (lane >> 5); t[i] = W[(size_t)(k0 + kk) * ldsrc + (lane & 31)]; }
        asm volatile("" ::: "memory");
#pragma unroll
        for (int i = 0; i < 32; ++i) { const int kk = 2 * i + (lane >> 5); scr[kk * 33 + (lane & 31)] = t[i]; } }
    LDS_WAIT(); asm volatile("" ::: "memory");
    const int c = lane & 7;
#pragma unroll
    for (int j = 0; j < 4; ++j) { const int n = (lane >> 3) + 8 * j; const LAS float* s = scr + (8 * c) * 33 + n;
        v4u o; o.x = pk2(s[0 * 33], s[1 * 33]); o.y = pk2(s[2 * 33], s[3 * 33]); o.z = pk2(s[4 * 33], s[5 * 33]); o.w = pk2(s[6 * 33], s[7 * 33]);
        *(v4u*)(WT + (size_t)n * ldt + k0 + 8 * c) = o; }
    LDS_WAIT(); asm volatile("" ::: "memory");
}
__device__ __forceinline__ void tr_block_i8(const float* W, int ldsrc, signed char* WT, int ldt, const unsigned* amax, int k0, LAS float* scr, int lane) {
#pragma unroll 8
    for (int i = 0; i < 32; ++i) { const int kk = 2 * i + (lane >> 5); scr[kk * 33 + (lane & 31)] = W[(size_t)(k0 + kk) * ldsrc + (lane & 31)]; }
    LDS_WAIT(); asm volatile("" ::: "memory");
    const int c = lane & 7;
#pragma unroll
    for (int j = 0; j < 4; ++j) { const int n = (lane >> 3) + 8 * j; const LAS float* s = scr + (8 * c) * 33 + n;
        const float inv = 127.0f / fmaxf(__uint_as_float(amax[n]), 1e-30f);
        v2u o; o.x = q8x4(s[0 * 33] * inv, s[1 * 33] * inv, s[2 * 33] * inv, s[3 * 33] * inv); o.y = q8x4(s[4 * 33] * inv, s[5 * 33] * inv, s[6 * 33] * inv, s[7 * 33] * inv);
        *(v2u*)(WT + (size_t)n * ldt + k0 + 8 * c) = o; }
    LDS_WAIT(); asm volatile("" ::: "memory");
}
__device__ __forceinline__ void amax_cols(const float* W, int ld, int K, int ncols, unsigned* amax  , int mode, int gt, int NT, int& base) {
    const int items = ncols * (K / 128);
    for (int it = (gt - (base % NT) + NT) % NT; it < items; it += NT) { const int col = it % ncols, kc = it / ncols;
        const float* p = W + (size_t)kc * 128 * ld + col; float m = 0.f;
#pragma unroll 16
        for (int k = 0; k < 128; ++k) m = fmaxf(m, fabsf(p[(size_t)k * ld]));
        int row;
        if (mode == 0) row = (col < 2048) ? 1792 + col : (col < 3840) ? col - 2048 : col;
        else if (mode == 1) row = col;
        else row = (col >> 7) * 256 + (col & 127) + (mode == 3 ? 128 : 0);
        atomicMax(amax + row, __float_as_uint(m)); }
    base += items;
}
__device__ __forceinline__ void tr_job(const float* W, int ldsrc, int K, int N, bf16* WT, int ldt, LAS float* scr, int lane, int gw, int NGW, int& base) {
    const int nblk = N / 32, items = (K / 64) * nblk;
    int start = (gw - (base % NGW) + NGW) % NGW;
    for (int it = start; it < items; it += NGW) { const int kb = it / nblk, nb = it % nblk;
        tr_block(W + nb * 32, ldsrc, WT + (size_t)nb * 32 * ldt, ldt, kb * 64, scr, lane); }
    base += items;
}
__device__ __forceinline__ void p0_mixer_weights(const Params& P, LAS float* scr, int lane, int gw, int NGW) {
    unsigned char* ws = WS_OPAQUE(P.ws); int base = 0;
#pragma unroll 1
    for (int l = 0; l < NL; ++l) {
        const float* w_in = (const float*)P.in[8] + (size_t)l * D * 5376;
        const float* w_gate = (const float*)P.in[9] + (size_t)l * D * N_GATE;
        for (int i = 0; i < 3; ++i)
            tr_job((const float*)P.in[23] + (size_t)(l * 3 + i) * MW * D, D, MW, D, (bf16*)(ws + WS_WBR) + (size_t)(l * 3 + i) * D * MW, MW, scr, lane, gw, NGW, base);
        tr_job((const float*)P.in[24] + (size_t)l * D * D, D, D, D, (bf16*)(ws + WS_WO) + (size_t)l * D * D, D, scr, lane, gw, NGW, base);
        bf16* lot = (bf16*)(ws + WS_LOT) + (size_t)l * 131072;
        tr_job((const float*)P.in[14] + (size_t)l * 64 * MW, MW, 64, MW, lot, 64, scr, lane, gw, NGW, base);
        tr_job((const float*)P.in[16] + (size_t)l * 64 * MW, MW, 64, MW, lot + 32768, 64, scr, lane, gw, NGW, base);
        tr_job((const float*)P.in[17] + (size_t)l * 128 * MW, MW, 128, MW, lot + 65536, 128, scr, lane, gw, NGW, base);
    }
}
__device__ __forceinline__ void p0_router_weights(const Params& P, int tid, int c, int G) {
    bf16* Wr = (bf16*)(P.ws + WS_WR);
    for (int i = c * NTHR + tid; i < NL * 256 * 1024; i += G * NTHR) {
        const int l = i >> 18, n = (i >> 10) & 255, k = i & 1023; const int nn = (n >= 64) ? n - 64 : n;
        float w = 0.f;
        if (nn < 4) w = ((const float*)P.in[25])[((size_t)l * D + k) * 4 + nn]; else if (nn < 36) w = ((const float*)P.in[27])[((size_t)l * D + k) * 32 + nn - 4];
        const unsigned hi = pk2(w, 0.f) & 0xffffu; const float lo = w - __uint_as_float(hi << 16);
        Wr[i] = (n < 36) ? (bf16)hi : (n >= 64 && n < 100) ? (bf16)(pk2(lo, 0.f) & 0xffffu) : (bf16)0;
    }
}
__device__ __forceinline__ void quant_strip(const float* src, int ld, signed char* dst, float* sw, LAS unsigned char* lds, int tid, int lane, int wave) {
    LAS float* strip = (LAS float*)lds;
    LAS float* red = strip + 1024 * 33;
    __syncthreads();
    {   float t[64];
#pragma unroll
        for (int i = 0; i < 64; ++i) { const int k = (wave * 64 + i) * 2 + (lane >> 5); t[i] = src[(size_t)k * ld + (lane & 31)]; }
        asm volatile("" ::: "memory");
#pragma unroll
        for (int i = 0; i < 64; ++i) { const int k = (wave * 64 + i) * 2 + (lane >> 5); strip[k * 33 + (lane & 31)] = t[i]; } }
    __syncthreads();
    { const int col = tid & 31, part = tid >> 5; float m = 0.f;
#pragma unroll 8
      for (int k = 0; k < 64; ++k) m = fmaxf(m, fabsf(strip[(part * 64 + k) * 33 + col]));
      red[part * 32 + col] = m; }
    __syncthreads();
    if (tid < 32) { float m = 0.f;
#pragma unroll
        for (int p = 0; p < 16; ++p) m = fmaxf(m, red[p * 32 + tid]);
        red[512 + tid] = fmaxf(m, 1e-30f); }
    __syncthreads();
    { const int n = tid & 31, kq = tid >> 5; const float am = red[512 + n], inv = 127.0f / am;
      signed char* d = dst + (size_t)n * 1024 + kq * 64;
#pragma unroll
      for (int q = 0; q < 4; ++q) { const LAS float* s = strip + (kq * 64 + q * 16) * 33 + n; v4u o;
          o.x = q8x4(s[0 * 33] * inv, s[1 * 33] * inv, s[2 * 33] * inv, s[3 * 33] * inv); o.y = q8x4(s[4 * 33] * inv, s[5 * 33] * inv, s[6 * 33] * inv, s[7 * 33] * inv);
          o.z = q8x4(s[8 * 33] * inv, s[9 * 33] * inv, s[10 * 33] * inv, s[11 * 33] * inv); o.w = q8x4(s[12 * 33] * inv, s[13 * 33] * inv, s[14 * 33] * inv, s[15 * 33] * inv);
          *(v4u*)(d + q * 16) = o; }
      if (kq == 0) sw[n] = am * (1.0f / 127.0f); }
}
__device__ __forceinline__ void p_quant_wt1(const Params& P, int l, LAS unsigned char* lds, int tid, int lane, int wave, int c, int G) {
    unsigned char* ws = WS_OPAQUE(P.ws);
    const float* w_in = (const float*)P.in[8] + (size_t)l * D * 5376; const float* w_gate = (const float*)P.in[9] + (size_t)l * D * N_GATE;
    signed char* w8 = (signed char*)(ws + WS_W81) + (size_t)l * N1 * D; float* sw = (float*)(ws + WS_SW1) + l * N1;
    for (int sidx = c; sidx < N1 / 32; sidx += G) { const int n0 = sidx * 32;
        const float* src; int ld;
        if (n0 < N_RWKV) { src = w_in + 2048 + n0; ld = 5376; } else if (n0 < N_RWKV + 2048) { src = w_in + (n0 - N_RWKV); ld = 5376; } else if (n0 < N_RWKV + N_REST) { src = w_in + n0; ld = 5376; } else { src = w_gate + (n0 - N_RWKV - N_REST); ld = N_GATE; }
        quant_strip(src, ld, w8 + (size_t)n0 * D, sw + n0, lds, tid, lane, wave); }
    __syncthreads();
}
__device__ __forceinline__ void p_expert_weights(const Params& P, int l, int part, LAS unsigned char* lds, int tid, int lane, int wave, int c, int G) {
    unsigned char* ws = WS_OPAQUE(P.ws);
    const float* wg = (const float*)P.in[29] + (size_t)l * 32 * D * MW;
    const float* wu = (const float*)P.in[30] + (size_t)l * 32 * D * MW;
    const float* wd = (const float*)P.in[31] + (size_t)l * 32 * MW * D;
    signed char* Wgu = (signed char*)P.out + OUT_WGU; bf16* Wd = (bf16*)((unsigned char*)P.out + OUT_WD); float* swe = (float*)(ws + WS_SWE);
    for (int sidx = part * 512 + c; sidx < part * 512 + 512; sidx += G) {
        const int e = sidx >> 5, which = (sidx >> 4) & 1, nb = sidx & 15, n0 = nb * 32;
        const int drow0 = (n0 / 128) * 256 + (n0 % 128) + (which ? 128 : 0);
        quant_strip((which ? wu : wg) + (size_t)e * D * MW + n0, MW, Wgu + (size_t)e * D * D + (size_t)drow0 * D, swe + e * 1024 + drow0, lds, tid, lane, wave);
    }
    __syncthreads();
    {   LAS float* scr = (LAS float*)(lds + wave * 8448); const int gw = c * NWAVES + wave, NGW = G * NWAVES;
        for (int it = part * 4096 + gw; it < part * 4096 + 4096; it += NGW) { const int e = it / 256, q = it % 256, kb = q / 32, nb = q % 32, n0 = nb * 32;
            tr_block(wd + (size_t)e * MW * D + n0, D, Wd + (size_t)e * D * MW + (size_t)n0 * MW, MW, kb * 64, scr, lane); } }
}
__device__ __forceinline__ void p0_mod(const Params& P, LAS unsigned char* lds, int tid, int c, int G) {
    LAS float* sc = (LAS float*)lds;
    LAS float* red = sc + 8192;
    const float* cin = (const float*)P.in[1]; const float* w_ada = (const float*)P.in[6]; const float* b_ada = (const float*)P.in[7];
    float* mod = (float*)(P.ws + WS_MOD);
    __syncthreads();
    for (int i = tid; i < 8192; i += NTHR) { const float cv = cin[i]; sc[i] = cv * sigm(cv); }
    __syncthreads();
    for (int it = c; it < 192; it += G) {
        const int l = it / 96, nb = it % 96;
        const int colL = tid & 63, ks = tid >> 6, col = nb * 64 + colL;
        const float* wp = w_ada + ((size_t)l * D + ks * 128) * 6144 + col;
        float a0 = 0.f, a1 = 0.f, a2 = 0.f, a3 = 0.f, a4 = 0.f, a5 = 0.f, a6 = 0.f, a7 = 0.f;
        for (int k0 = 0; k0 < 128; k0 += 32) {
            float wv[32];
#pragma unroll
            for (int k = 0; k < 32; ++k) wv[k] = wp[(size_t)(k0 + k) * 6144];
            asm volatile("" ::: "memory");
#pragma unroll
            for (int k = 0; k < 32; ++k) PIN(wv[k]);
#pragma unroll
            for (int k = 0; k < 32; ++k) { const LAS float* s = sc + ks * 128 + k0 + k; const float w_ = wv[k];
                a0 += s[0] * w_; a1 += s[1024] * w_; a2 += s[2048] * w_; a3 += s[3072] * w_; a4 += s[4096] * w_; a5 += s[5120] * w_; a6 += s[6144] * w_; a7 += s[7168] * w_; }
        }
        LAS float* rp = red + ks * 512 + colL;
        rp[0] = a0; rp[64] = a1; rp[128] = a2; rp[192] = a3; rp[256] = a4; rp[320] = a5; rp[384] = a6; rp[448] = a7;
        __syncthreads();
        { const int b = tid >> 6; float s = b_ada[l * 6144 + col];
#pragma unroll
          for (int q = 0; q < 8; ++q) s += red[q * 512 + b * 64 + colL];
          mod[((size_t)l * NB + b) * 6144 + col] = s; }
        __syncthreads();
    }
    __syncthreads();
}

template <int MODE>
__device__ __forceinline__ void row_phase(const Params& P, int l, LAS unsigned char* lds, int tid, int lane, int wave, int c, int G) {
    unsigned char* ws = WS_OPAQUE(P.ws);
    const float* mod = (const float*)(ws + WS_MOD);
    bf16* H = (bf16*)(ws + WS_H2);
    const bool combine = (MODE == 2) || (MODE == 0 && l > 0);
    const int lprev = (MODE == 2) ? NL - 1 : l - 1;
    const bool xf32 = (MODE == 0 && l == 0);
    const float* src = (const float*)P.in[0];
    const bf16* srcb = (MODE == 2 || (MODE == 1 && l == NL - 1)) ? (const bf16*)(ws + WS_X2) : (const bf16*)P.out;
    const int* slot_of = (const int*)(ws + WS_TAB + TAB_SLOTOF);
    const float* rwt = (const float*)(ws + WS_TAB + TAB_RW);
    const bf16* YM = (const bf16*)(ws + WS_YM);
    const float* gam = (MODE == 0) ? (const float*)P.in[3] + l * D : (MODE == 1) ? (const float*)P.in[4] + l * D : (const float*)P.in[5];
    for (int ck = c; ck < T / 256; ck += G) {
        const int b = (ck * 256) / SEQ;
        f32x4 gsc[4], shv[4], g2v[4];
        {   const float* mb = mod + ((size_t)l * NB + b) * 6144 + (MODE == 0 ? 0 : 3072);
            const float* g2 = mod + ((size_t)lprev * NB + b) * 6144 + 5120;
#pragma unroll
            for (int j = 0; j < 4; ++j) { const f32x4 g = *((const f32x4*)gam + lane + 64 * j);
                if (MODE == 2) { gsc[j] = g; shv[j] = g; } else { gsc[j] = g * (1.0f + *((const f32x4*)(mb + 1024) + lane + 64 * j)); shv[j] = *((const f32x4*)mb + lane + 64 * j); }
                g2v[j] = combine ? *((const f32x4*)g2 + lane + 64 * j) : g; } }
        const int row0 = ck * 256 + wave;
        f32x4 xn[4]; v2u xnb[4]; v2u y0n[4], y1n[4]; int s0n = 0, s1n = 0; float w0c = 0.f, w1c = 0.f, w0n = 0.f, w1n = 0.f;
        {   if (xf32) { const f32x4* xr = (const f32x4*)(src + (size_t)row0 * D) + lane;
#pragma unroll
                for (int j = 0; j < 4; ++j) xn[j] = xr[64 * j]; }
            else { const v2u* xr = (const v2u*)(srcb + (size_t)row0 * D) + lane;
#pragma unroll
                for (int j = 0; j < 4; ++j) xnb[j] = xr[64 * j]; }
            if (combine) { const int s0 = slot_of[row0 * 2], s1 = slot_of[row0 * 2 + 1]; w0c = rwt[row0 * 2]; w1c = rwt[row0 * 2 + 1];
                const v2u* y0 = (const v2u*)(YM + (size_t)s0 * D) + lane; const v2u* y1 = (const v2u*)(YM + (size_t)s1 * D) + lane;
#pragma unroll
                for (int j = 0; j < 4; ++j) { y0n[j] = y0[64 * j]; y1n[j] = y1[64 * j]; }
                s0n = slot_of[(row0 + 8) * 2]; s1n = slot_of[(row0 + 8) * 2 + 1]; w0n = rwt[(row0 + 8) * 2]; w1n = rwt[(row0 + 8) * 2 + 1]; } }
        for (int i = 0; i < 32; ++i) {
            const int row = row0 + 8 * i;
            f32x4 v[4]; v2u vb[4], ya[4], yb[4];
#pragma unroll
            for (int j = 0; j < 4; ++j) { if (xf32) v[j] = xn[j]; else vb[j] = xnb[j]; ya[j] = y0n[j]; yb[j] = y1n[j]; }
            const float w0 = w0c, w1 = w1c;
            if (i < 31) {
                if (xf32) { const f32x4* xr = (const f32x4*)(src + (size_t)(row + 8) * D) + lane;
#pragma unroll
                    for (int j = 0; j < 4; ++j) xn[j] = xr[64 * j]; }
                else { const v2u* xr = (const v2u*)(srcb + (size_t)(row + 8) * D) + lane;
#pragma unroll
                    for (int j = 0; j < 4; ++j) xnb[j] = xr[64 * j]; }
                if (combine) { const v2u* y0 = (const v2u*)(YM + (size_t)s0n * D) + lane; const v2u* y1 = (const v2u*)(YM + (size_t)s1n * D) + lane;
#pragma unroll
                    for (int j = 0; j < 4; ++j) { y0n[j] = y0[64 * j]; y1n[j] = y1[64 * j]; }
                    w0c = w0n; w1c = w1n;
                    if (i < 30) { s0n = slot_of[(row + 16) * 2]; s1n = slot_of[(row + 16) * 2 + 1]; w0n = rwt[(row + 16) * 2]; w1n = rwt[(row + 16) * 2 + 1]; } }
            }
            asm volatile("" ::: "memory");
            if (!xf32) {
#pragma unroll
                for (int j = 0; j < 4; ++j) { v[j][0] = bflo(vb[j].x); v[j][1] = bfhi(vb[j].x); v[j][2] = bflo(vb[j].y); v[j][3] = bfhi(vb[j].y); } }
            if (combine) {
#pragma unroll
                for (int j = 0; j < 4; ++j) { const v2u a = ya[j], bb = yb[j]; const f32x4 gg = g2v[j];
                    v[j][0] += gg[0] * (w0 * bflo(a.x) + w1 * bflo(bb.x)); v[j][1] += gg[1] * (w0 * bfhi(a.x) + w1 * bfhi(bb.x));
                    v[j][2] += gg[2] * (w0 * bflo(a.y) + w1 * bflo(bb.y)); v[j][3] += gg[3] * (w0 * bfhi(a.y) + w1 * bfhi(bb.y)); }
                if (MODE == 0) { v2u* xo = (v2u*)((bf16*)P.out + (size_t)row * D) + lane;
#pragma unroll
                    for (int j = 0; j < 4; ++j) { v2u o; o.x = pk2(v[j][0], v[j][1]); o.y = pk2(v[j][2], v[j][3]); xo[64 * j] = o; } }
            }
            float ss = 0.f;
#pragma unroll
            for (int j = 0; j < 4; ++j) ss += (v[j][0] * v[j][0] + v[j][1] * v[j][1]) + (v[j][2] * v[j][2] + v[j][3] * v[j][3]);
            ss = wave_sum(ss);
            const float rstd = rsqrtf(ss * (1.0f / D) + 1e-6f);
            if (MODE == 2) {
                f32x4* xo = (f32x4*)(P.out + (size_t)row * D) + lane;
#pragma unroll
                for (int j = 0; j < 4; ++j) xo[64 * j] = v[j] * rstd * gsc[j];
            } else {
                f32x4 h[4];
#pragma unroll
                for (int j = 0; j < 4; ++j) h[j] = v[j] * rstd * gsc[j] + shv[j];
                if (MODE == 1) { v2u* ho = (v2u*)(H + (size_t)row * D) + lane;
#pragma unroll
                    for (int j = 0; j < 4; ++j) { v2u o; o.x = pk2(h[j][0], h[j][1]); o.y = pk2(h[j][2], h[j][3]); ho[64 * j] = o; } }
                float am = 0.f;
#pragma unroll
                for (int j = 0; j < 4; ++j) am = fmaxf(fmaxf(am, fmaxf(fabsf(h[j][0]), fabsf(h[j][1]))), fmaxf(fabsf(h[j][2]), fabsf(h[j][3])));
                am = fmaxf(wave_max_pos(am), 1e-30f);
                const float inv = 127.0f / am;
                unsigned* h8 = (unsigned*)(ws + (MODE == 1 ? WS_H8M : WS_H) + (size_t)row * D) + lane;
#pragma unroll
                for (int j = 0; j < 4; ++j) h8[64 * j] = q8x4(h[j][0] * inv, h[j][1] * inv, h[j][2] * inv, h[j][3] * inv);
                if (lane == 0) ((float*)(ws + WS_TAB + TAB_SA))[row] = am * (1.0f / 127.0f);
            }
        }
    }
    __syncthreads();
}

__device__ __forceinline__ void router_phase(const Params& P, int l, LAS unsigned char* lds, int tid, int c, int G) {
    unsigned char* ws = WS_OPAQUE(P.ws);
    { int* row_tok = (int*)(ws + WS_TAB + TAB_ROWTOK); float* xs = (float*)(ws + WS_TAB + TAB_XS); for (int i = c * NTHR + tid; i < NSLOT_MAX; i += G * NTHR) { row_tok[i] = 0; xs[i] = 0.f; } }
    VM_WAIT(); __syncthreads();
    LAS int* hist = (LAS int*)(lds + 2 * 256 * 36 * 4);
    const float* bg = (const float*)P.in[26] + l * 4; const float* be = (const float*)P.in[28] + l * 32;
    for (int ck = c; ck < T / 256; ck += G) {
        pg8::Gemm g{(const bf16*)(ws + WS_H2), (const bf16*)(ws + WS_WR) + (size_t)l * 256 * D, T, 256, D};
        pg8::OneUnitOrder S{ck}; pg8::EpiRouter E{};
        pg8::gemm_phase<pg8::EpiRouter, pg8::OneUnitOrder>(lds, g, S, E, nullptr, tid);
        if (tid < 32) hist[tid] = 0;
        __syncthreads();
        if (tid < 256) {
            const LAS float* th = (const LAS float*)lds + tid * 36; const LAS float* tl = th + 256 * 36;
            float lg[36];
#pragma unroll
            for (int q = 0; q < 9; ++q) { const f32x4 a = *(const LAS f32x4*)(th + 4 * q), b = *(const LAS f32x4*)(tl + 4 * q); lg[4 * q] = a[0] + b[0]; lg[4 * q + 1] = a[1] + b[1]; lg[4 * q + 2] = a[2] + b[2]; lg[4 * q + 3] = a[3] + b[3]; }
            const float g0 = lg[0] + bg[0], g1 = lg[1] + bg[1], g2 = lg[2] + bg[2], g3 = lg[3] + bg[3];
            int gsel = 0; float gm = g0;
            if (g1 > gm) { gm = g1; gsel = 1; } if (g2 > gm) { gm = g2; gsel = 2; } if (g3 > gm) { gm = g3; gsel = 3; }
            const float den = __expf(g0 - gm) + __expf(g1 - gm) + __expf(g2 - gm) + __expf(g3 - gm);
            const float pgrp = 1.0f / den;
            float el[8];
#pragma unroll
            for (int j = 0; j < 8; ++j) { const float a = gsel == 0 ? lg[4 + j] : gsel == 1 ? lg[12 + j] : gsel == 2 ? lg[20 + j] : lg[28 + j]; el[j] = a + be[gsel * 8 + j]; }
            int i1 = 0; float v1 = el[0];
#pragma unroll
            for (int j = 1; j < 8; ++j) if (el[j] > v1) { v1 = el[j]; i1 = j; }
            int i2 = -1; float v2 = -3.0e38f;
#pragma unroll
            for (int j = 0; j < 8; ++j) if (j != i1 && el[j] > v2) { v2 = el[j]; i2 = j; }
            const float e2 = __expf(v2 - v1), p1 = 1.0f / (1.0f + e2), p2 = e2 * p1;
            const int row = ck * 256 + tid;
            int* eid = (int*)(ws + WS_TAB + TAB_EID); float* rwo = (float*)(ws + WS_TAB + TAB_RW);
            const int e0 = gsel * 8 + i1, e1 = gsel * 8 + i2;
            eid[row * 2] = e0; eid[row * 2 + 1] = e1; rwo[row * 2] = p1 * pgrp; rwo[row * 2 + 1] = p2 * pgrp;
            __hip_atomic_fetch_add(&hist[e0], 1, __ATOMIC_RELAXED, __HIP_MEMORY_SCOPE_WORKGROUP); __hip_atomic_fetch_add(&hist[e1], 1, __ATOMIC_RELAXED, __HIP_MEMORY_SCOPE_WORKGROUP);
        }
        __syncthreads();
        if (tid < 32) ((int*)(ws + WS_TAB + TAB_CNT))[ck * 32 + tid] = hist[tid];
        __syncthreads();
    }
}

__device__ __forceinline__ void moe_slots(const Params& P, LAS unsigned char* lds, int tid, int c, int G) {
    unsigned char* ws = WS_OPAQUE(P.ws);
    const int* cnt = (const int*)(ws + WS_TAB + TAB_CNT); const int* eid = (const int*)(ws + WS_TAB + TAB_EID);
    int* row_tok = (int*)(ws + WS_TAB + TAB_ROWTOK); int* slot_of = (int*)(ws + WS_TAB + TAB_SLOTOF);
    LAS int* tot = (LAS int*)lds; LAS int* bef = tot + 32; LAS int* ps = bef + 32; LAS int* eb = ps + 64;
    for (int ck = c; ck < T / 256; ck += G) {
        __syncthreads();
        { const int e_ = tid & 31, part = tid >> 5; int t = 0, b = 0; int cv[16];
#pragma unroll
          for (int k2 = 0; k2 < 16; ++k2) cv[k2] = cnt[(part * 16 + k2) * 32 + e_];
          asm volatile("" ::: "memory");
#pragma unroll
          for (int k2 = 0; k2 < 16; ++k2) PIN(cv[k2]);
#pragma unroll
          for (int k2 = 0; k2 < 16; ++k2) { const int k = part * 16 + k2; const int v = cv[k2]; t += v; b += (k < ck) ? v : 0; }
          LAS int* pt = eb + 512; pt[tid] = t; pt[512 + tid] = b; }
        eb[tid] = eid[ck * 512 + tid];
        __syncthreads();
        if (tid < 32) { const LAS int* pt = eb + 512; int t = 0, b = 0;
#pragma unroll
          for (int p = 0; p < 16; ++p) { t += pt[p * 32 + tid]; b += pt[512 + p * 32 + tid]; }
          tot[tid] = t; bef[tid] = b; }
        __syncthreads();
        if (tid == 0) { int s = 0; for (int e = 0; e < 32; ++e) { ps[e] = s; s += (tot[e] + 255) & ~255; } ps[32] = s; }
        __syncthreads();
        const int e = eb[tid]; int rank = 0;
        {   LAS int* wcnt = eb + 1536;
            const int wv_ = tid >> 6;
#pragma unroll 4
            for (int ev = 0; ev < 32; ++ev) { const unsigned long long m = __builtin_amdgcn_ballot_w64(e == ev);
                const int below = (int)__builtin_amdgcn_mbcnt_hi((unsigned)(m >> 32), __builtin_amdgcn_mbcnt_lo((unsigned)m, 0u));
                if (e == ev) rank = below;
                if ((tid & 63) == 0) wcnt[wv_ * 32 + ev] = __popcll(m); }
            __syncthreads();
            for (int w2 = 0; w2 < wv_; ++w2) rank += wcnt[w2 * 32 + e];
        }
        const int slot = ps[e] + bef[e] + rank;
        row_tok[slot] = (ck * 512 + tid) >> 1; slot_of[ck * 512 + tid] = slot;
        __syncthreads();
        eb[tid] = slot;
        __syncthreads();
        { const unsigned char* Hh = ws + WS_H8M; unsigned char* X = ws + WS_XROWS; const int lane = tid & 63, wv = tid >> 6;
          const float* sa = (const float*)(ws + WS_TAB + TAB_SA); float* xs = (float*)(ws + WS_TAB + TAB_XS);
          for (int i0 = 0; i0 < 32; i0 += 8) {
              v4u a[8]; float sc[8];
#pragma unroll
              for (int k = 0; k < 8; ++k) { const int tl = wv + 8 * (i0 + k); a[k] = *((const v4u*)(Hh + (size_t)(ck * 256 + tl) * D) + lane); sc[k] = sa[ck * 256 + tl]; }
              asm volatile("" ::: "memory");
#pragma unroll
              for (int k = 0; k < 8; ++k) { const int tl = wv + 8 * (i0 + k); const int s0 = eb[2 * tl], s1 = eb[2 * tl + 1];
                  *((v4u*)(X + (size_t)s0 * D) + lane) = a[k]; *((v4u*)(X + (size_t)s1 * D) + lane) = a[k];
                  if (lane == 0) { xs[s0] = sc[k]; xs[s1] = sc[k]; } } } }
        if (ck == 0) {
            int* tile_e = (int*)(ws + WS_TAB + TAB_TILEE);
            if (tid <= 32) tile_e[tid] = ps[tid] >> 8;
            if (tid == 0) *(int*)(ws + WS_TAB + TAB_NT) = ps[32] >> 8;
        }
    }
    __syncthreads();
}
__device__ __forceinline__ void moe_gather(const Params& P, int lane, int gw, int NGW) {
    unsigned char* ws = WS_OPAQUE(P.ws);
    const int nslots = *(const int*)(ws + WS_TAB + TAB_NT) * 256; const int* row_tok = (const int*)(ws + WS_TAB + TAB_ROWTOK);
    const bf16* H = (const bf16*)(ws + WS_H); bf16* X = (bf16*)(ws + WS_XROWS);
    for (int s = gw; s < nslots; s += NGW) { const int t = row_tok[s];
        const v4u* sp = (const v4u*)(H + (size_t)t * D) + lane; v4u* dp = (v4u*)(X + (size_t)s * D) + lane;
        const v4u a = sp[0], b = sp[64]; dp[0] = a; dp[64] = b; }
}

constexpr int R1_AW = 0, R1_AA = 4608, R1_AG = 9216, R1_LW = 17920, R1_LSTR = 1040, R1_LA = R1_LW + 32 * R1_LSTR, R1_LG = R1_LA + 32 * R1_LSTR;
#define R1_SYNC() do { asm volatile("s_waitcnt lgkmcnt(0)" ::: "memory"); __builtin_amdgcn_s_barrier(); asm volatile("" ::: "memory"); } while (0)
__device__ __forceinline__ void rwkv_prep(const Params& P, int l, LAS unsigned char* lds, int tid, int lane, int wave, int c, int G) {
    unsigned char* ws = WS_OPAQUE(P.ws);
    const bf16* PR = (const bf16*)(ws + WS_PRW);
    bf16* SI = (bf16*)(ws + WS_SI); bf16* E1 = (bf16*)(ws + WS_E1); bf16* GT = (bf16*)(ws + WS_GT);
    const bf16* lot = (const bf16*)(ws + WS_LOT) + (size_t)l * 131072;
    const float* mu = (const float*)P.in[12] + l * N_RWKV;
    const float* w0 = (const float*)P.in[13] + l * MW; const float* a0 = (const float*)P.in[15] + l * MW;
    const float* k_k = (const float*)P.in[18] + l * MW; const float* k_a = (const float*)P.in[19] + l * MW; const float* r_k = (const float*)P.in[20] + l * MW;
    float p_mr[8], p_mk[8], p_mv[8], p_w0[8], p_a0[8], p_kk[8], p_ka[8], p_rk[8];
#pragma unroll
    for (int j = 0; j < 8; ++j) { const int ch = lane * 8 + j; p_mr[j] = mu[ch]; p_mk[j] = mu[512 + ch]; p_mv[j] = mu[1024 + ch]; p_w0[j] = w0[ch]; p_a0[j] = a0[ch]; p_kk[j] = k_k[ch]; p_ka[j] = k_a[ch]; p_rk[j] = r_k[ch]; }
    for (int it = c; it < NB * (SEQ / 32); it += G) {
        const int b = it / (SEQ / 32), t0 = (it % (SEQ / 32)) * 32;
        R1_SYNC();
        {
            const int tok = tid >> 4, cg = tid & 15, t = t0 + tok;
            const bf16* cur = PR + ((size_t)(b * SEQ + t)) * N_RWKV + 1536 + cg * 16;
            const v4u c0 = *(const v4u*)cur, c1 = *(const v4u*)(cur + 8);
            v4u p0 = (v4u){0u, 0u, 0u, 0u}, p1 = p0;
            if (t > 0) { p0 = *(const v4u*)(cur - N_RWKV); p1 = *(const v4u*)(cur - N_RWKV + 8); }
            const float* mp = mu + 1536 + cg * 16;
            float x[16];
            const unsigned cw[8] = {c0.x, c0.y, c0.z, c0.w, c1.x, c1.y, c1.z, c1.w}, pw[8] = {p0.x, p0.y, p0.z, p0.w, p1.x, p1.y, p1.z, p1.w};
#pragma unroll
            for (int j = 0; j < 8; ++j) { const float a = bflo(cw[j]), bq = bfhi(cw[j]), pa = bflo(pw[j]), pb = bfhi(pw[j]);
                x[2 * j] = a + mp[2 * j] * (pa - a); x[2 * j + 1] = bq + mp[2 * j + 1] * (pb - bq); }
            LAS unsigned char* dst;
            if (cg < 4) {
#pragma unroll
                for (int j = 0; j < 16; ++j) { const float e = __expf(2.0f * x[j]); x[j] = 1.0f - 2.0f * __builtin_amdgcn_rcpf(e + 1.0f); }
                dst = lds + R1_AW + tok * 144 + cg * 32;
            } else if (cg < 8) { dst = lds + R1_AA + tok * 144 + (cg - 4) * 32;
            } else {
#pragma unroll
                for (int j = 0; j < 16; ++j) x[j] = sigm(x[j]);
                dst = lds + R1_AG + tok * 272 + (cg - 8) * 32;
            }
            v4u o0, o1; o0.x = pk2(x[0], x[1]); o0.y = pk2(x[2], x[3]); o0.z = pk2(x[4], x[5]); o0.w = pk2(x[6], x[7]);
            o1.x = pk2(x[8], x[9]); o1.y = pk2(x[10], x[11]); o1.z = pk2(x[12], x[13]); o1.w = pk2(x[14], x[15]);
            *(LAS v4u*)dst = o0; *(LAS v4u*)(dst + 16) = o1;
        }
        R1_SYNC();
        {
            const int r = lane & 31, hh = lane >> 5;
#pragma unroll
            for (int which = 0; which < 3; ++which) {
                const int KL = (which == 2) ? 128 : 64;
                const bf16* lo = lot + (which == 0 ? 0 : which == 1 ? 32768 : 65536);
                const LAS unsigned char* at = lds + (which == 0 ? R1_AW : which == 1 ? R1_AA : R1_AG) + r * (which == 2 ? 272 : 144) + hh * 16;
                LAS unsigned char* outp = lds + (which == 0 ? R1_LW : which == 1 ? R1_LA : R1_LG);
#pragma unroll
                for (int blk = 0; blk < 2; ++blk) {
                    f32x16 acc;
#pragma unroll
                    for (int q = 0; q < 16; ++q) acc[q] = 0.f;
                    const bf16* arow = lo + (size_t)(wave * 64 + blk * 32 + r) * KL + hh * 8;
#pragma unroll
                    for (int s = 0; s < KL / 16; ++s) {
                        const bf16x8 af = *(const bf16x8*)(arow + s * 16);
                        const bf16x8 bfr = *(const LAS bf16x8*)(at + s * 32);
                        acc = __builtin_amdgcn_mfma_f32_32x32x16_bf16(af, bfr, acc, 0, 0, 0);
                    }
#pragma unroll
                    for (int q4 = 0; q4 < 4; ++q4) { v2u o; o.x = pk2(acc[4 * q4], acc[4 * q4 + 1]); o.y = pk2(acc[4 * q4 + 2], acc[4 * q4 + 3]);
                        *(LAS v2u*)(outp + r * R1_LSTR + (wave * 64 + blk * 32 + 8 * q4 + 4 * hh) * 2) = o; }
                }
            }
        }
        R1_SYNC();
        v4u nx[6];
        { const int t = t0 + wave; const bf16* cur = PR + ((size_t)(b * SEQ + t)) * N_RWKV + lane * 8;
          nx[0] = *(const v4u*)cur; nx[1] = *(const v4u*)(cur + 512); nx[2] = *(const v4u*)(cur + 1024);
          if (t > 0) { nx[3] = *(const v4u*)(cur - N_RWKV); nx[4] = *(const v4u*)(cur - N_RWKV + 512); nx[5] = *(const v4u*)(cur - N_RWKV + 1024); } else { nx[3] = (v4u){0u, 0u, 0u, 0u}; nx[4] = nx[3]; nx[5] = nx[3]; } }
#pragma unroll 1
        for (int q = 0; q < 4; ++q) {
            const int tok = wave + 8 * q, t = t0 + tok, c0 = lane * 8, head = lane >> 3;
            const v4u cr = nx[0], ck = nx[1], cv = nx[2], pr = nx[3], pk = nx[4], pv = nx[5];
            if (q < 3) { const bf16* cur = PR + ((size_t)(b * SEQ + t + 8)) * N_RWKV + c0;
                nx[0] = *(const v4u*)cur; nx[1] = *(const v4u*)(cur + 512); nx[2] = *(const v4u*)(cur + 1024);
                nx[3] = *(const v4u*)(cur - N_RWKV); nx[4] = *(const v4u*)(cur - N_RWKV + 512); nx[5] = *(const v4u*)(cur - N_RWKV + 1024); }
            const v4u lw = *(const LAS v4u*)(lds + R1_LW + tok * R1_LSTR + c0 * 2), la = *(const LAS v4u*)(lds + R1_LA + tok * R1_LSTR + c0 * 2), lg = *(const LAS v4u*)(lds + R1_LG + tok * R1_LSTR + c0 * 2);
            const unsigned crw[4] = {cr.x, cr.y, cr.z, cr.w}, ckw[4] = {ck.x, ck.y, ck.z, ck.w}, cvw[4] = {cv.x, cv.y, cv.z, cv.w};
            const unsigned prw[4] = {pr.x, pr.y, pr.z, pr.w}, pkw[4] = {pk.x, pk.y, pk.z, pk.w}, pvw[4] = {pv.x, pv.y, pv.z, pv.w};
            const unsigned lww[4] = {lw.x, lw.y, lw.z, lw.w}, law[4] = {la.x, la.y, la.z, la.w}, lgw[4] = {lg.x, lg.y, lg.z, lg.w};
            float rr[8], ww[8], kt[8], vv[8], kk[8], aa[8], gg[8];
            float skk = 0.f, bon = 0.f;
#pragma unroll
            for (int j = 0; j < 8; ++j) {
                const int wi = j >> 1; const bool hi = j & 1;
                const float r_c = hi ? bfhi(crw[wi]) : bflo(crw[wi]), r_p = hi ? bfhi(prw[wi]) : bflo(prw[wi]);
                const float k_c = hi ? bfhi(ckw[wi]) : bflo(ckw[wi]), k_p = hi ? bfhi(pkw[wi]) : bflo(pkw[wi]);
                const float v_c = hi ? bfhi(cvw[wi]) : bflo(cvw[wi]), v_p = hi ? bfhi(pvw[wi]) : bflo(pvw[wi]);
                const float r = r_c + p_mr[j] * (r_p - r_c), k = k_c + p_mk[j] * (k_p - k_c), v = v_c + p_mv[j] * (v_p - v_c);
                const float lwv = hi ? bfhi(lww[wi]) : bflo(lww[wi]), lav = hi ? bfhi(law[wi]) : bflo(law[wi]), lgv = hi ? bfhi(lgw[wi]) : bflo(lgw[wi]);
                const float w = __expf(-0.6065306597126334f * sigm(p_w0[j] + lwv));
                const float a = sigm(p_a0[j] + lav);
                const float kkv = k * p_kk[j];
                const float ktv = k * (1.0f + (a - 1.0f) * p_ka[j]);
                skk += kkv * kkv; bon += r * ktv * p_rk[j];
                rr[j] = r; ww[j] = w; kt[j] = ktv; vv[j] = v; kk[j] = kkv; aa[j] = a; gg[j] = lgv;
            }
            skk = sum8(skk); bon = sum8(bon);
            const float inv = rsqrtf(fmaxf(skk, 1e-12f));
            bf16* so = SI + (((size_t)(b * 8 + head)) * SEQ + t) * 384 + (lane & 7) * 8;
            v4u o;
            o.x = pk2(rr[0], rr[1]); o.y = pk2(rr[2], rr[3]); o.z = pk2(rr[4], rr[5]); o.w = pk2(rr[6], rr[7]); *(v4u*)(so) = o;
            o.x = pk2(ww[0], ww[1]); o.y = pk2(ww[2], ww[3]); o.z = pk2(ww[4], ww[5]); o.w = pk2(ww[6], ww[7]); *(v4u*)(so + 64) = o;
            o.x = pk2(kt[0], kt[1]); o.y = pk2(kt[2], kt[3]); o.z = pk2(kt[4], kt[5]); o.w = pk2(kt[6], kt[7]); *(v4u*)(so + 128) = o;
            o.x = pk2(vv[0], vv[1]); o.y = pk2(vv[2], vv[3]); o.z = pk2(vv[4], vv[5]); o.w = pk2(vv[6], vv[7]); *(v4u*)(so + 192) = o;
#pragma unroll
            for (int j = 0; j < 8; ++j) { kk[j] *= inv; aa[j] *= kk[j]; }
            o.x = pk2(kk[0], kk[1]); o.y = pk2(kk[2], kk[3]); o.z = pk2(kk[4], kk[5]); o.w = pk2(kk[6], kk[7]); *(v4u*)(so + 256) = o;
            o.x = pk2(aa[0], aa[1]); o.y = pk2(aa[2], aa[3]); o.z = pk2(aa[4], aa[5]); o.w = pk2(aa[6], aa[7]); *(v4u*)(so + 320) = o;
            const size_t eo = ((size_t)(b * SEQ + t)) * MW + c0;
            o.x = pk2(bon * vv[0], bon * vv[1]); o.y = pk2(bon * vv[2], bon * vv[3]); o.z = pk2(bon * vv[4], bon * vv[5]); o.w = pk2(bon * vv[6], bon * vv[7]); *(v4u*)(E1 + eo) = o;
            o.x = pk2(gg[0], gg[1]); o.y = pk2(gg[2], gg[3]); o.z = pk2(gg[4], gg[5]); o.w = pk2(gg[6], gg[7]); *(v4u*)(GT + eo) = o;
        }
    }
    R1_SYNC();
}

constexpr int SC_TB = 32, SC_STEP = 336  , SC_BUF = SC_TB * SC_STEP * 4  , SC_NBUF = 3;
__device__ __forceinline__ void sc_load(const bf16* blk, int tl, v4u (&rg)[6]) {
#pragma unroll
    for (int p = 0; p < 6; ++p) rg[p] = *(const v4u*)(blk + (size_t)(tl + 256 * p) * 8);
}
__device__ __forceinline__ void sc_store(LAS float* buf, int tl, int quarter, const v4u (&rg)[6]) {
#pragma unroll
    for (int p = 0; p < 6; ++p) {
        const int ck = tl + 256 * p, step = ck / 48, cw = ck % 48, q = cw >> 3, j0 = (cw & 7) * 8;
        int off;
        if (q == 3) { const int jj = j0 - 16 * quarter; if (jj < 0 || jj >= 16) continue; off = 320 + jj; }
        else { const int slot = (q == 0) ? 4 : (q == 1) ? 1 : (q == 2) ? 3 : (q == 4) ? 0 : 2; off = slot * 64 + j0; }
        LAS float* d = buf + step * SC_STEP + off;
        const v4u w = rg[p];
        *(LAS f32x4*)d = (f32x4){bflo(w.x), bfhi(w.x), bflo(w.y), bfhi(w.y)};
        *(LAS f32x4*)(d + 4) = (f32x4){bflo(w.z), bfhi(w.z), bflo(w.w), bfhi(w.w)};
    }
}
__device__ __forceinline__ void rwkv_scan(const Params& P, LAS unsigned char* lds, int tid, int lane, int wave, int c, int G) {
    unsigned char* ws = WS_OPAQUE(P.ws);
    const bf16* SI = (const bf16*)(ws + WS_SI); bf16* O = (bf16*)(ws + WS_YRWKV);
    constexpr int NBLK = SEQ / SC_TB;
    for (int it = c; it < 256; it += G) {
        const int x = it & 7, y = it >> 3, bh = x * 8 + (y >> 2), quarter = y & 3;
        const bf16* sib = SI + (size_t)bh * SEQ * 384;
        const int b = bh >> 3, h = bh & 7;
        __syncthreads();
        if (wave >= 4) {
            const int tl = tid - 256; v4u rg[6];
            sc_load(sib, tl, rg); sc_store((LAS float*)(lds), tl, quarter, rg);
            sc_load(sib + (size_t)SC_TB * 384, tl, rg); sc_store((LAS float*)(lds + SC_BUF), tl, quarter, rg);
            sc_load(sib + (size_t)2 * SC_TB * 384, tl, rg);
            __syncthreads();
            for (int n = 0; n < NBLK; ++n) {
                if (n + 2 < NBLK) { sc_store((LAS float*)(lds + ((n + 2) % SC_NBUF) * SC_BUF), tl, quarter, rg);
                    if (n + 3 < NBLK) sc_load(sib + (size_t)(n + 3) * SC_TB * 384, tl, rg); }
                __syncthreads();
            }
        } else {
            typedef float f2 __attribute__((ext_vector_type(2)));
            const int kq = lane & 15, rg_ = lane >> 4, row = quarter * 16 + wave * 4 + rg_;
            f2 sA = {0.f, 0.f}, sB = {0.f, 0.f}; float yk = 0.f;
            __syncthreads();
            const LAS float* sp0 = (const LAS float*)lds;
            f32x4 kh = *(const LAS f32x4*)(sp0 + 4 * kq), w = *(const LAS f32x4*)(sp0 + 64 + 4 * kq), bb = *(const LAS f32x4*)(sp0 + 128 + 4 * kq);
            f32x4 kt = *(const LAS f32x4*)(sp0 + 192 + 4 * kq), r = *(const LAS f32x4*)(sp0 + 256 + 4 * kq); float v = sp0[320 + wave * 4 + rg_];
            const LAS float* sp1 = sp0 + SC_STEP;
            f32x4 kh_1 = *(const LAS f32x4*)(sp1 + 4 * kq), w_1 = *(const LAS f32x4*)(sp1 + 64 + 4 * kq), bb_1 = *(const LAS f32x4*)(sp1 + 128 + 4 * kq);
            f32x4 kt_1 = *(const LAS f32x4*)(sp1 + 192 + 4 * kq), r_1 = *(const LAS f32x4*)(sp1 + 256 + 4 * kq); float v_1 = sp1[320 + wave * 4 + rg_];
            for (int n = 0; n < NBLK; ++n) {
                const LAS float* buf = (const LAS float*)(lds + (n % SC_NBUF) * SC_BUF);
                const LAS float* nbuf = (const LAS float*)(lds + ((n + 1) % SC_NBUF) * SC_BUF);
#pragma unroll 4
                for (int st = 0; st < SC_TB; ++st) {
                    const LAS float* sp = (st >= SC_TB - 2) ? nbuf + (st - (SC_TB - 2)) * SC_STEP : buf + (st + 2) * SC_STEP;
                    const f32x4 kh_n = *(const LAS f32x4*)(sp + 4 * kq), w_n = *(const LAS f32x4*)(sp + 64 + 4 * kq), bb_n = *(const LAS f32x4*)(sp + 128 + 4 * kq);
                    const f32x4 kt_n = *(const LAS f32x4*)(sp + 192 + 4 * kq), r_n = *(const LAS f32x4*)(sp + 256 + 4 * kq); const float v_n = sp[320 + wave * 4 + rg_];
                    asm volatile("" ::: "memory");
                    f2 t = sA * (f2){kh[0], kh[1]}; t = sB * (f2){kh[2], kh[3]} + t;
                    float sk = sum16(t[0] + t[1]);
                    const f2 nsk = {-sk, -sk}, vv = {v, v};
                    f2 uA = vv * (f2){kt[0], kt[1]}, uB = vv * (f2){kt[2], kt[3]};
                    uA = nsk * (f2){bb[0], bb[1]} + uA; uB = nsk * (f2){bb[2], bb[3]} + uB;
                    sA = sA * (f2){w[0], w[1]} + uA; sB = sB * (f2){w[2], w[3]} + uB;
                    f2 ty = sA * (f2){r[0], r[1]}; ty = sB * (f2){r[2], r[3]} + ty;
                    const float y = sum16(ty[0] + ty[1]);
                    yk = ((st & 15) == kq) ? y : yk;
                    if ((st & 15) == 15) {
                        const int t_ = n * SC_TB + (st & 16) + kq;
                        O[((size_t)(b * SEQ + t_)) * MW + h * 64 + row] = (bf16)(pk2(yk, 0.f) & 0xffffu);
                    }
                    kh = kh_1; w = w_1; bb = bb_1; kt = kt_1; r = r_1; v = v_1;
                    kh_1 = kh_n; w_1 = w_n; bb_1 = bb_n; kt_1 = kt_n; r_1 = r_n; v_1 = v_n;
                }
                __syncthreads();
            }
        }
    }
    __syncthreads();
}

__device__ __forceinline__ void rwkv_post(const Params& P, int l, int tid, int c, int G) {
    unsigned char* ws = WS_OPAQUE(P.ws);
    bf16* O = (bf16*)(ws + WS_YRWKV); const bf16* E1 = (const bf16*)(ws + WS_E1); const bf16* GT = (const bf16*)(ws + WS_GT);
    const float* gn = (const float*)P.in[21] + l * MW;
    for (size_t i = (size_t)c * NTHR + tid; i < (size_t)T * 64; i += (size_t)G * NTHR) {
        const int c0 = (int)(i & 63) * 8; const size_t off = (i >> 6) * MW + c0;
        const v4u ov = *(const v4u*)(O + off), ev = *(const v4u*)(E1 + off), gv = *(const v4u*)(GT + off);
        float o[8] = {bflo(ov.x), bfhi(ov.x), bflo(ov.y), bfhi(ov.y), bflo(ov.z), bfhi(ov.z), bflo(ov.w), bfhi(ov.w)};
        const float e[8] = {bflo(ev.x), bfhi(ev.x), bflo(ev.y), bfhi(ev.y), bflo(ev.z), bfhi(ev.z), bflo(ev.w), bfhi(ev.w)};
        const float g[8] = {bflo(gv.x), bfhi(gv.x), bflo(gv.y), bfhi(gv.y), bflo(gv.z), bfhi(gv.z), bflo(gv.w), bfhi(gv.w)};
        float s = 0.f;
#pragma unroll
        for (int j = 0; j < 8; ++j) s += o[j];
        const float mean = sum8(s) * (1.0f / 64.0f);
        float q = 0.f;
#pragma unroll
        for (int j = 0; j < 8; ++j) { o[j] -= mean; q += o[j] * o[j]; }
        const float rstd = rsqrtf(sum8(q) * (1.0f / 64.0f) + 64e-5f);
#pragma unroll
        for (int j = 0; j < 8; ++j) o[j] = (o[j] * rstd * gn[c0 + j] + e[j]) * g[j];
        v4u w; w.x = pk2(o[0], o[1]); w.y = pk2(o[2], o[3]); w.z = pk2(o[4], o[5]); w.w = pk2(o[6], o[7]);
        *(v4u*)(O + off) = w;
    }
}

constexpr int RT_STR = 272;
constexpr int RT_TILE = 128 * RT_STR;
__device__ __forceinline__ float ret_log2gamma(int h) { return __log2f(1.0f - exp2f(-5.0f - (float)h)); }
__device__ __forceinline__ void rot8(const v4u a, const v4u b, float pos, int d0, float scale, float (&o1)[8], float (&o2)[8]) {
    const unsigned aw[4] = {a.x, a.y, a.z, a.w}, bw[4] = {b.x, b.y, b.z, b.w};
#pragma unroll
    for (int j = 0; j < 8; ++j) {
        const float f = exp2f(-(float)(d0 + j) * (13.287712379549449f / 64.0f)) * 0.15915494309189535f;
        float rev = pos * f; rev = rev - floorf(rev);
        const float sn = __builtin_amdgcn_sinf(rev), cs = __builtin_amdgcn_cosf(rev);
        const float x1 = (j & 1) ? bfhi(aw[j >> 1]) : bflo(aw[j >> 1]), x2 = (j & 1) ? bfhi(bw[j >> 1]) : bflo(bw[j >> 1]);
        o1[j] = (x1 * cs - x2 * sn) * scale; o2[j] = (x1 * sn + x2 * cs) * scale;
    }
}
#define RT_SYNC() do { asm volatile("s_waitcnt lgkmcnt(0)" ::: "memory"); __builtin_amdgcn_s_barrier(); asm volatile("" ::: "memory"); } while (0)
struct RotLd { v4u a[2], b[2]; int pos[2]; };
__device__ __forceinline__ void rot_load(RotLd& r, const bf16* src, const int* pos, int tid, bool rowmajor) {
#pragma unroll
    for (int i = 0; i < 2; ++i) { const int p = tid + NTHR * i; const int j = rowmajor ? (p >> 3) : (p & 127), d0 = (rowmajor ? (p & 7) : (p >> 7)) * 8;
        const bf16* rp = src + (size_t)j * N_REST + d0; r.a[i] = *(const v4u*)rp; r.b[i] = *(const v4u*)(rp + 64); r.pos[i] = pos[j]; }
}
__device__ __forceinline__ void rot_store_rows(const RotLd& r, float scale, LAS unsigned char* dst, int tid) {
#pragma unroll
    for (int i = 0; i < 2; ++i) { const int p = tid + NTHR * i, j = p >> 3, d0 = (p & 7) * 8;
        float o1[8], o2[8]; rot8(r.a[i], r.b[i], (float)r.pos[i], d0, scale, o1, o2);
        v4u w1, w2; w1.x = pk2(o1[0], o1[1]); w1.y = pk2(o1[2], o1[3]); w1.z = pk2(o1[4], o1[5]); w1.w = pk2(o1[6], o1[7]);
        w2.x = pk2(o2[0], o2[1]); w2.y = pk2(o2[2], o2[3]); w2.z = pk2(o2[4], o2[5]); w2.w = pk2(o2[6], o2[7]);
        *(LAS v4u*)(dst + j * RT_STR + d0 * 2) = w1; *(LAS v4u*)(dst + j * RT_STR + (64 + d0) * 2) = w2; }
}
__device__ __forceinline__ void rot_store_cols(const RotLd& r, float l2g, LAS unsigned char* dst, int tid) {
#pragma unroll
    for (int i = 0; i < 2; ++i) { const int p = tid + NTHR * i, j = p & 127, d0 = (p >> 7) * 8;
        float o1[8], o2[8]; rot8(r.a[i], r.b[i], (float)r.pos[i], d0, 0.08838834764831845f * __builtin_amdgcn_exp2f(l2g * (float)(127 - j)), o1, o2);
#pragma unroll
        for (int q = 0; q < 8; ++q) { *(LAS bf16*)(dst + (d0 + q) * RT_STR + j * 2) = (bf16)(pk2(o1[q], 0.f) & 0xffffu); *(LAS bf16*)(dst + (64 + d0 + q) * RT_STR + j * 2) = (bf16)(pk2(o2[q], 0.f) & 0xffffu); } }
}
__device__ __forceinline__ void vt_load(v4u (&r)[4], const bf16* src, int tid) {
#pragma unroll
    for (int i = 0; i < 4; ++i) { const int p = tid + NTHR * i, j = p & 127, v0 = (p >> 7) * 8; r[i] = *(const v4u*)(src + (size_t)j * N_REST + v0); }
}
__device__ __forceinline__ void vt_store(const v4u (&r)[4], LAS unsigned char* dst, int tid) {
#pragma unroll
    for (int i = 0; i < 4; ++i) { const int p = tid + NTHR * i, j = p & 127, v0 = (p >> 7) * 8; const unsigned aw[4] = {r[i].x, r[i].y, r[i].z, r[i].w};
#pragma unroll
        for (int q = 0; q < 8; ++q) *(LAS bf16*)(dst + (v0 + q) * RT_STR + j * 2) = (bf16)((q & 1) ? (aw[q >> 1] >> 16) : (aw[q >> 1] & 0xffffu)); }
}
__device__ __forceinline__ void ret_kv(const Params& P, int half, LAS unsigned char* lds, int tid, int lane, int wave, int c, int G) {
    unsigned char* ws = WS_OPAQUE(P.ws);
    const bf16* PR = (const bf16*)(ws + WS_PREST); bf16* KV = (bf16*)(ws + WS_KV);
    const int* positions = (const int*)P.in[2];
    LAS unsigned char* KT = lds; LAS unsigned char* VT = lds + RT_TILE;
    RotLd kld; v4u vld[4];
    if (c < 1024) { const int bl = c >> 8, h = (c >> 6) & 3, ch = c & 63; const size_t row0 = (size_t)bl * SEQ + ch * 128;
        rot_load(kld, PR + row0 * N_REST + 512 + h * 128, positions + (size_t)(half * 4 + bl) * SEQ + ch * 128, tid, false); vt_load(vld, PR + row0 * N_REST + 1024 + h * 128, tid); }
    for (int it = c; it < 1024; it += G) {
        const int h = (it >> 6) & 3;
        const float l2g = ret_log2gamma(h);
        RT_SYNC();
        rot_store_cols(kld, l2g, KT, tid); vt_store(vld, VT, tid);
        if (it + G < 1024) { const int in_ = it + G, bl = in_ >> 8, hn = (in_ >> 6) & 3, ch = in_ & 63; const size_t row0 = (size_t)bl * SEQ + ch * 128;
            rot_load(kld, PR + row0 * N_REST + 512 + hn * 128, positions + (size_t)(half * 4 + bl) * SEQ + ch * 128, tid, false); vt_load(vld, PR + row0 * N_REST + 1024 + hn * 128, tid); }
        RT_SYNC();
        const int fr = lane & 15, g = lane >> 4;
        bf16x8 af[4];
#pragma unroll
        for (int s = 0; s < 4; ++s) af[s] = *(const LAS bf16x8*)(VT + (wave * 16 + fr) * RT_STR + (32 * s + 8 * g) * 2);
        bf16* kvo = KV + (size_t)it * 16384 + (size_t)(wave * 16 + fr) * 128 + 4 * g;
#pragma unroll
        for (int db = 0; db < 8; ++db) {
            f32x4 acc = (f32x4){0.f, 0.f, 0.f, 0.f};
#pragma unroll
            for (int s = 0; s < 4; ++s) { const bf16x8 bfr = *(const LAS bf16x8*)(KT + (db * 16 + fr) * RT_STR + (32 * s + 8 * g) * 2);
                acc = __builtin_amdgcn_mfma_f32_16x16x32_bf16(bfr, af[s], acc, 0, 0, 0); }
            { v2u o; o.x = pk2(acc[0], acc[1]); o.y = pk2(acc[2], acc[3]); *(v2u*)(kvo + db * 16) = o; }
        }
    }
    __syncthreads();
}
__device__ __forceinline__ void ret_state(const Params& P, int tid, int c, int G) {
    unsigned char* ws = WS_OPAQUE(P.ws);
    const bf16* KV = (const bf16*)(ws + WS_KV); bf16* SST = (bf16*)(ws + WS_SST);
    for (int gid = c * NTHR + tid; gid < 16 * 8192; gid += G * NTHR) {
        const int chain = gid >> 13, e = (gid & 8191) * 2, h = chain & 3;
        const float dc = exp2f(128.0f * ret_log2gamma(h));
        float s0 = 0.f, s1 = 0.f;
        const size_t off0 = (size_t)chain * 64 * 16384 + e;
        unsigned cur[16], nxt[16];
#pragma unroll
        for (int k = 0; k < 16; ++k) cur[k] = *(const unsigned*)(KV + off0 + (size_t)k * 16384);
#pragma unroll
        for (int b = 0; b < 4; ++b) {
            if (b < 3) {
#pragma unroll
                for (int k = 0; k < 16; ++k) nxt[k] = *(const unsigned*)(KV + off0 + (size_t)((b + 1) * 16 + k) * 16384); }
            asm volatile("" : "+v"(s0), "+v"(s1) :: "memory");
#pragma unroll
            for (int k = 0; k < 16; ++k) { *(unsigned*)(SST + off0 + (size_t)(b * 16 + k) * 16384) = pk2(s0, s1); s0 = s0 * dc + bflo(cur[k]); s1 = s1 * dc + bfhi(cur[k]); }
#pragma unroll
            for (int k = 0; k < 16; ++k) cur[k] = nxt[k];
        }
    }
}
__device__ __forceinline__ void ret_out(const Params& P, int l, int half, LAS unsigned char* lds, int tid, int lane, int wave, int c, int G) {
    unsigned char* ws = WS_OPAQUE(P.ws);
    const bf16* PR = (const bf16*)(ws + WS_PREST); const bf16* SST = (const bf16*)(ws + WS_SST); bf16* YR = (bf16*)(ws + WS_YRET);
    const int* positions = (const int*)P.in[2];
    const float* gn = (const float*)P.in[11] + l * MW;
    LAS unsigned char* QL = lds; LAS unsigned char* KL = lds + RT_TILE; LAS unsigned char* VT = lds + 2 * RT_TILE; LAS unsigned char* ST = lds + 3 * RT_TILE;
    RotLd qld, kld; v4u vld[4], sld[4];
    if (c < 1024) { const int bl = c >> 8, h = (c >> 6) & 3, ch = c & 63; const size_t row0 = (size_t)bl * SEQ + ch * 128; const int* pos = positions + (size_t)(half * 4 + bl) * SEQ + ch * 128;
        rot_load(qld, PR + row0 * N_REST + h * 128, pos, tid, true); rot_load(kld, PR + row0 * N_REST + 512 + h * 128, pos, tid, true); vt_load(vld, PR + row0 * N_REST + 1024 + h * 128, tid);
#pragma unroll
        for (int i = 0; i < 4; ++i) sld[i] = *(const v4u*)(SST + (size_t)c * 16384 + (size_t)(tid + NTHR * i) * 8); }
    for (int it = c; it < 1024; it += G) {
        const int bl = it >> 8, h = (it >> 6) & 3, ch = it & 63;
        const size_t row0 = (size_t)bl * SEQ + ch * 128;
        const float l2g = ret_log2gamma(h);
        RT_SYNC();
        rot_store_rows(qld, 1.0f, QL, tid); rot_store_rows(kld, 0.08838834764831845f, KL, tid); vt_store(vld, VT, tid);
#pragma unroll
        for (int i = 0; i < 4; ++i) { const int p = tid + NTHR * i; *(LAS v4u*)(ST + (p >> 4) * RT_STR + (p & 15) * 16) = sld[i]; }
        if (it + G < 1024) { const int in_ = it + G, bn = in_ >> 8, hn = (in_ >> 6) & 3, cn = in_ & 63; const size_t rn = (size_t)bn * SEQ + cn * 128; const int* pos = positions + (size_t)(half * 4 + bn) * SEQ + cn * 128;
            rot_load(qld, PR + rn * N_REST + hn * 128, pos, tid, true); rot_load(kld, PR + rn * N_REST + 512 + hn * 128, pos, tid, true); vt_load(vld, PR + rn * N_REST + 1024 + hn * 128, tid);
#pragma unroll
            for (int i = 0; i < 4; ++i) sld[i] = *(const v4u*)(SST + (size_t)in_ * 16384 + (size_t)(tid + NTHR * i) * 8); }
        RT_SYNC();
        const int fr = lane & 15, g = lane >> 4;
        bf16x8 qf[4];
#pragma unroll
        for (int s = 0; s < 4; ++s) qf[s] = *(const LAS bf16x8*)(QL + (wave * 16 + fr) * RT_STR + (32 * s + 8 * g) * 2);
        f32x4 acc[8];
#pragma unroll
        for (int vb = 0; vb < 8; ++vb) { acc[vb] = (f32x4){0.f, 0.f, 0.f, 0.f};
#pragma unroll
            for (int s = 0; s < 4; ++s) { const bf16x8 a = *(const LAS bf16x8*)(ST + (vb * 16 + fr) * RT_STR + (32 * s + 8 * g) * 2);
                acc[vb] = __builtin_amdgcn_mfma_f32_16x16x32_bf16(a, qf[s], acc[vb], 0, 0, 0); } }
        const int il = wave * 16 + fr;
        const float xi = exp2f(l2g * (float)(il + 1));
#pragma unroll
        for (int vb = 0; vb < 8; ++vb) acc[vb] *= xi;
        const bf16* gp = PR + (row0 + il) * N_REST + 1536 + h * 128 + 4 * g;
        const float* gnp = gn + h * 128 + 4 * g;
        v2u gvl[8]; f32x4 gml[8];
#pragma unroll
        for (int vb = 0; vb < 8; ++vb) { gvl[vb] = *(const v2u*)(gp + vb * 16); gml[vb] = *(const f32x4*)(gnp + vb * 16); }
        asm volatile("" ::: "memory");
        for (int s2 = 0; s2 <= (wave >> 1); ++s2) {
            f32x4 p0 = (f32x4){0.f, 0.f, 0.f, 0.f}, p1 = p0;
            const int jb0 = 2 * s2, jb1 = 2 * s2 + 1;
#pragma unroll
            for (int s = 0; s < 4; ++s) { const bf16x8 a = *(const LAS bf16x8*)(KL + (jb0 * 16 + fr) * RT_STR + (32 * s + 8 * g) * 2);
                p0 = __builtin_amdgcn_mfma_f32_16x16x32_bf16(a, qf[s], p0, 0, 0, 0); }
            if (jb1 <= wave) {
#pragma unroll
                for (int s = 0; s < 4; ++s) { const bf16x8 a = *(const LAS bf16x8*)(KL + (jb1 * 16 + fr) * RT_STR + (32 * s + 8 * g) * 2);
                    p1 = __builtin_amdgcn_mfma_f32_16x16x32_bf16(a, qf[s], p1, 0, 0, 0); }
            }
#pragma unroll
            for (int r = 0; r < 4; ++r) { const int d0 = il - (jb0 * 16 + 4 * g + r), d1 = il - (jb1 * 16 + 4 * g + r);
                p0[r] = d0 >= 0 ? p0[r] * exp2f(l2g * (float)d0) : 0.f; p1[r] = d1 >= 0 ? p1[r] * exp2f(l2g * (float)d1) : 0.f; }
            v4u pw; pw.x = pk2(p0[0], p0[1]); pw.y = pk2(p0[2], p0[3]); pw.z = pk2(p1[0], p1[1]); pw.w = pk2(p1[2], p1[3]);
            const bf16x8 pf = __builtin_bit_cast(bf16x8, pw);
#pragma unroll
            for (int vb = 0; vb < 8; ++vb) {
                const LAS unsigned char* vp = VT + (vb * 16 + fr) * RT_STR + (32 * s2 + 4 * g) * 2;
                const v2u lo = *(const LAS v2u*)vp, hi = *(const LAS v2u*)(vp + 32);
                const v4u aw = (v4u){lo.x, lo.y, hi.x, hi.y};
                acc[vb] = __builtin_amdgcn_mfma_f32_16x16x32_bf16(__builtin_bit_cast(bf16x8, aw), pf, acc[vb], 0, 0, 0);
            }
        }
        float s = 0.f;
#pragma unroll
        for (int vb = 0; vb < 8; ++vb) s += (acc[vb][0] + acc[vb][1]) + (acc[vb][2] + acc[vb][3]);
        s += xor_lane(s, lane, 16); s += xor_lane(s, lane, 32);
        const float mean = s * (1.0f / 128.0f);
        float q = 0.f;
#pragma unroll
        for (int vb = 0; vb < 8; ++vb) { acc[vb] -= mean; q += (acc[vb][0] * acc[vb][0] + acc[vb][1] * acc[vb][1]) + (acc[vb][2] * acc[vb][2] + acc[vb][3] * acc[vb][3]); }
        q += xor_lane(q, lane, 16); q += xor_lane(q, lane, 32);
        const float rstd = rsqrtf(q * (1.0f / 128.0f) + 1e-5f);
        bf16* yp = YR + (row0 + il) * MW + h * 128 + 4 * g;
#pragma unroll
        for (int vb = 0; vb < 8; ++vb) { PIN(gvl[vb]); PIN(gml[vb]); }
#pragma unroll
        for (int vb = 0; vb < 8; ++vb) { const v2u gv = gvl[vb]; const f32x4 gm = gml[vb];
            const float g0 = bflo(gv.x), g1 = bfhi(gv.x), g2 = bflo(gv.y), g3 = bfhi(gv.y);
            const float y0 = acc[vb][0] * rstd * gm[0] * (g0 * sigm(g0)), y1 = acc[vb][1] * rstd * gm[1] * (g1 * sigm(g1));
            const float y2 = acc[vb][2] * rstd * gm[2] * (g2 * sigm(g2)), y3 = acc[vb][3] * rstd * gm[3] * (g3 * sigm(g3));
            v2u o; o.x = pk2(y0, y1); o.y = pk2(y2, y3); *(v2u*)(yp + vb * 16) = o; }
    }
    __syncthreads();
}
__device__ __forceinline__ void conv_phase(const Params& P, int l, int tid, int c, int G) {
    unsigned char* ws = WS_OPAQUE(P.ws);
    const bf16* PR = (const bf16*)(ws + WS_PREST); bf16* YC = (bf16*)(ws + WS_YCONV);
    const float* cw = (const float*)P.in[22] + l * 3 * MW;
    for (int i = c * NTHR + tid; i < HT * 4; i += G * NTHR) {
        const int c0 = (i & 63) * 8; const size_t row0 = (size_t)(i >> 6) * 16; const int t0 = (int)(row0 & (SEQ - 1));
        const bf16* rp = PR + row0 * N_REST + 2048 + c0;
        float w0[8], w1[8], w2[8];
#pragma unroll
        for (int j = 0; j < 8; ++j) { w0[j] = cw[c0 + j]; w1[j] = cw[MW + c0 + j]; w2[j] = cw[2 * MW + c0 + j]; }
        v4u hb[4], cb[4], gb[4], hn[4], cn[4], gn[4]; v4u ph0 = {0u, 0u, 0u, 0u}, pc0 = ph0, ph1 = ph0, pc1 = ph0;
        if (t0 > 0) { ph0 = *(const v4u*)(rp - 2 * (size_t)N_REST); pc0 = *(const v4u*)(rp - 2 * (size_t)N_REST + 1024); ph1 = *(const v4u*)(rp - (size_t)N_REST); pc1 = *(const v4u*)(rp - (size_t)N_REST + 1024); }
#pragma unroll
        for (int k = 0; k < 4; ++k) { const bf16* q = rp + (size_t)k * N_REST; hb[k] = *(const v4u*)q; cb[k] = *(const v4u*)(q + 1024); gb[k] = *(const v4u*)(q + 512); }
        float um2[8], um1[8];
        { float a[8], b2[8]; unpk8(ph0, a); unpk8(pc0, b2);
#pragma unroll
          for (int j = 0; j < 8; ++j) um2[j] = a[j] * b2[j];
          unpk8(ph1, a); unpk8(pc1, b2);
#pragma unroll
          for (int j = 0; j < 8; ++j) um1[j] = a[j] * b2[j]; }
#pragma unroll
        for (int b = 0; b < 4; ++b) {
            if (b < 3) {
#pragma unroll
                for (int k = 0; k < 4; ++k) { const bf16* q = rp + (size_t)((b + 1) * 4 + k) * N_REST; hn[k] = *(const v4u*)q; cn[k] = *(const v4u*)(q + 1024); gn[k] = *(const v4u*)(q + 512); } }
            asm volatile("" ::: "memory");
#pragma unroll
            for (int k = 0; k < 4; ++k) { PIN(hb[k]); PIN(cb[k]); PIN(gb[k]); }
#pragma unroll
            for (int k = 0; k < 4; ++k) { float hv[8], cv[8], bg[8], u[8], y[8]; unpk8(hb[k], hv); unpk8(cb[k], cv); unpk8(gb[k], bg);
#pragma unroll
                for (int j = 0; j < 8; ++j) { u[j] = hv[j] * cv[j]; y[j] = bg[j] * (w0[j] * um2[j] + w1[j] * um1[j] + w2[j] * u[j]); um2[j] = um1[j]; um1[j] = u[j]; }
                *(v4u*)(YC + (row0 + b * 4 + k) * MW + c0) = pk8(y); }
#pragma unroll
            for (int k = 0; k < 4; ++k) { hb[k] = hn[k]; cb[k] = cn[k]; gb[k] = gn[k]; }
        }
    }
}

constexpr int CK = 32, CK_NCH = SEQ / CK;
#ifndef CKREP
#define CKREP 0
#endif
constexpr size_t WS_CM = 464 * MiB, WS_CN = 528 * MiB, WS_CS = 592 * MiB;
constexpr size_t WS_CWX = 112 * MiB, WS_CUX = 144 * MiB, WS_CAX = 656 * MiB, WS_CRX = 976 * MiB;
constexpr int CK_ITEM = 67072;
constexpr int CK_RAW = 0, CK_LC = 24576, CK_AT = 33024, CK_BT = 37632, CK_KT = 42240, CK_RT = 46848, CK_BHT = 51456, CK_KHT = 56576, CK_VT = 61696, CK_GC = 66816;
constexpr int CK_AAB = 0, CK_AAK = 4096, CK_ARB = 6656, CK_ARK = 9216, CK_GT = 11776, CK_UTT = 11776, CK_WT = 20224, CK_WTT = 24832, CK_EX = 29952;
constexpr size_t WS_A8 = 688 * MiB;
constexpr int CK_FA = 33024, CK_FL = 51456;
constexpr int CK_RS = 144, CK_TS = 80, CK_GS = 132;

__device__ __forceinline__ bf16x8 ld_frag(const LAS unsigned char* p) { return *(const LAS bf16x8*)p; }
__device__ __forceinline__ bf16x8 ld_frag2(const LAS unsigned char* p0, const LAS unsigned char* p1) { const v2u a = *(const LAS v2u*)p0, b = *(const LAS v2u*)p1; const v4u w = (v4u){a.x, a.y, b.x, b.y}; return __builtin_bit_cast(bf16x8, w); }
__device__ __forceinline__ unsigned short bf1(float x) { return (unsigned short)(pk2(x, 0.f) & 0xffffu); }

__device__ __forceinline__ void rwkv_lora_in(const Params& P, int l, int tid, int c, int G) {
    unsigned char* ws = WS_OPAQUE(P.ws);
    const bf16* PR = (const bf16*)(ws + WS_PRW); bf16* A8 = (bf16*)(ws + WS_A8); const float* mu = (const float*)P.in[12] + l * N_RWKV + 1536;
    const int cg = tid & 15;
    const f32x4 mq[4] = {*(const f32x4*)(mu + cg * 16), *(const f32x4*)(mu + cg * 16 + 4), *(const f32x4*)(mu + cg * 16 + 8), *(const f32x4*)(mu + cg * 16 + 12)};
    for (int i0 = c * NTHR + tid; i0 < T * 16; i0 += 4 * G * NTHR) {
        v4u ca[4][2], pa[4][2];
#pragma unroll
        for (int k = 0; k < 4; ++k) { const int i = i0 + k * G * NTHR; const int row = i >> 4, t = row & (SEQ - 1);
            if (i < T * 16) { const bf16* cur = PR + (size_t)row * N_RWKV + 1536 + cg * 16;
#pragma unroll
                for (int q = 0; q < 2; ++q) { ca[k][q] = *(const v4u*)(cur + 8 * q); pa[k][q] = (t > 0) ? *(const v4u*)(cur - N_RWKV + 8 * q) : (v4u){0u, 0u, 0u, 0u}; } }
            else { ca[k][0] = ca[k][1] = pa[k][0] = pa[k][1] = (v4u){0u, 0u, 0u, 0u}; } }
        asm volatile("" ::: "memory");
#pragma unroll
        for (int k = 0; k < 4; ++k) { PIN(ca[k][0]); PIN(ca[k][1]); PIN(pa[k][0]); PIN(pa[k][1]); }
#pragma unroll
        for (int k = 0; k < 4; ++k) { const int i = i0 + k * G * NTHR; const int row = i >> 4;
            float x[16];
#pragma unroll
            for (int q = 0; q < 2; ++q) { float a[8], p[8]; unpk8(ca[k][q], a); unpk8(pa[k][q], p);
                const f32x4 m0 = mq[2 * q], m1 = mq[2 * q + 1];
#pragma unroll
                for (int j = 0; j < 8; ++j) { float v = a[j] + (j < 4 ? m0[j] : m1[j - 4]) * (p[j] - a[j]);
                    if (cg < 4) { const float e = __expf(2.0f * v); v = 1.0f - 2.0f * __builtin_amdgcn_rcpf(e + 1.0f); } else if (cg >= 8) v = sigm(v);
                    x[8 * q + j] = v; } }
            float lo8[8], hi8[8];
#pragma unroll
            for (int j = 0; j < 8; ++j) { lo8[j] = x[j]; hi8[j] = x[8 + j]; }
            if (i < T * 16) { *(v4u*)(A8 + (size_t)row * 256 + cg * 16) = pk8(lo8); *(v4u*)(A8 + (size_t)row * 256 + cg * 16 + 8) = pk8(hi8); } }
    }
}
struct FeLd { v4u lc[4], lp[4], rc[3], rp[3]; };
__device__ __forceinline__ void fe_load(FeLd& f, const bf16* PR, int b, int h, int t0, int tq) {
    const int tok = tq >> 3, g8 = tq & 7, t = t0 + tok;
    const bf16* row = PR + ((size_t)b * SEQ + t) * N_RWKV;
#pragma unroll
    for (int i = 0; i < 4; ++i) f.lc[i] = *(const v4u*)(row + 1536 + g8 * 32 + i * 8);
#pragma unroll
    for (int i = 0; i < 3; ++i) f.rc[i] = *(const v4u*)(row + i * 512 + 64 * h + g8 * 8);
    if (t > 0) {
#pragma unroll
        for (int i = 0; i < 4; ++i) f.lp[i] = *(const v4u*)(row - N_RWKV + 1536 + g8 * 32 + i * 8);
#pragma unroll
        for (int i = 0; i < 3; ++i) f.rp[i] = *(const v4u*)(row - N_RWKV + i * 512 + 64 * h + g8 * 8);
    } else {
#pragma unroll
        for (int i = 0; i < 4; ++i) f.lp[i] = (v4u){0u, 0u, 0u, 0u};
#pragma unroll
        for (int i = 0; i < 3; ++i) f.rp[i] = (v4u){0u, 0u, 0u, 0u};
    }
}
__device__ __forceinline__ void fe_load_rows(FeLd& f, const bf16* PR, int b, int h, int t0, int tq) {
    const int tok = tq >> 3, g8 = tq & 7, t = t0 + tok; const bf16* row = PR + ((size_t)b * SEQ + t) * N_RWKV;
#pragma unroll
    for (int i = 0; i < 3; ++i) f.rc[i] = *(const v4u*)(row + i * 512 + 64 * h + g8 * 8);
}
__device__ __forceinline__ void fe_load_prev(FeLd& f, const bf16* PR, int b, int h, int t0, int tq) {
    const int tok = tq >> 3, g8 = tq & 7, t = t0 + tok; const bf16* row = PR + ((size_t)b * SEQ + t) * N_RWKV;
#pragma unroll
    for (int i = 0; i < 3; ++i) f.rp[i] = (t > 0) ? *(const v4u*)(row - N_RWKV + i * 512 + 64 * h + g8 * 8) : (v4u){0u, 0u, 0u, 0u};
}
__device__ __forceinline__ void fe_load_lora(FeLd& f, const bf16* A8, int b, int t0, int tq) {
#pragma unroll
    for (int i = 0; i < 4; ++i) { const int p = tq + 256 * i; f.lc[i] = *(const v4u*)(A8 + ((size_t)b * SEQ + t0 + (p >> 5)) * 256 + (p & 31) * 8); }
}
#define CK_SYNC() do { asm volatile("s_waitcnt lgkmcnt(0)" ::: "memory"); __builtin_amdgcn_s_barrier(); asm volatile("" ::: "memory"); } while (0)
template <bool ZMODE>
__device__ __forceinline__ void rwkv_chunk(const Params& P, int l, int hb, LAS unsigned char* lds, int tid, int lane, int wave, int c, int G) {
    unsigned char* ws = WS_OPAQUE(P.ws);
    const bf16* PR = (const bf16*)(ws + WS_PRW); const bf16* lot = (const bf16*)(ws + WS_LOT) + (size_t)l * 131072;
    const float* mu = (const float*)P.in[12] + l * N_RWKV;
    const float* pw0 = (const float*)P.in[13] + l * MW; const float* pa0 = (const float*)P.in[15] + l * MW; const float* pkk = (const float*)P.in[18] + l * MW; const float* pka = (const float*)P.in[19] + l * MW; const float* prk = (const float*)P.in[20] + l * MW;
    bf16* Mo = (bf16*)(ws + WS_CM); bf16* No = (bf16*)(ws + WS_CN); const bf16* SS = (const bf16*)(ws + WS_CS);
    bf16* E1 = (bf16*)(ws + WS_E1); bf16* GTg = (bf16*)(ws + WS_GT); bf16* YO = (bf16*)(ws + WS_YRWKV);
    const float* gn = (const float*)P.in[21] + l * MW;
    constexpr int IPW = ZMODE ? 4 : 2, NPR = 8192 / IPW;
    const int ib = ZMODE ? (wave >> 1) : (wave >> 2), W4RAW = ZMODE ? (wave & 1) : (wave & 3), w4 = ZMODE ? (wave & 1) : ((W4RAW + 2 * ib) & 3);
    LAS unsigned char* L = lds + ib * (ZMODE ? CK_ITEM / 2 : CK_ITEM);
    LAS float* PT = (LAS float*)(lds + 2 * CK_ITEM);
    if (!ZMODE) { const int a = tid >> 6, i8 = (tid & 63) * 8;
        const float* srcp = (a == 0) ? mu : (a == 1) ? mu + 512 : (a == 2) ? mu + 1024 : (a == 3) ? pw0 : (a == 4) ? pa0 : (a == 5) ? pkk : (a == 6) ? pka : prk;
        const f32x4 p0 = *(const f32x4*)(srcp + i8), p1 = *(const f32x4*)(srcp + i8 + 4);
        *(LAS f32x4*)(PT + a * 512 + i8) = p0; *(LAS f32x4*)(PT + a * 512 + i8 + 4) = p1; }
    else if (tid < 128) { const int a = tid >> 6, i8 = (tid & 63) * 8; const float* srcp = a ? gn : mu + 1024;
        const f32x4 p0 = *(const f32x4*)(srcp + i8), p1 = *(const f32x4*)(srcp + i8 + 4); *(LAS f32x4*)(PT + 1024 + a * 512 + i8) = p0; *(LAS f32x4*)(PT + 1024 + a * 512 + i8 + 4) = p1; }
#define Z_LOAD(ITEM, LN) do { if (w4 < 2) { const int r_ = (LN) & 31, h_ = (LN) >> 5; \
        const bf16* pp_ = (const bf16*)(ws + (hb ? WS_CAX : WS_CWX)) + (size_t)(ITEM) * 2048 + r_ * 64 + h_ * 8; const bf16* sp_ = SS + (size_t)(ITEM) * 4096 + (32 * w4 + r_) * 64 + h_ * 8; \
        const bf16* qp_ = (const bf16*)(ws + (hb ? WS_CRX : WS_CUX)) + (size_t)(ITEM) * 2048 + r_ * 64 + 32 * w4 + 4 * h_; \
        _Pragma("unroll") for (int s_ = 0; s_ < 4; ++s_) { fe.lc[s_] = *(const v4u*)(pp_ + s_ * 16); fe.lp[s_] = *(const v4u*)(sp_ + s_ * 16); } \
        const v2u q0_ = *(const v2u*)qp_, q1_ = *(const v2u*)(qp_ + 8), q2_ = *(const v2u*)(qp_ + 16), q3_ = *(const v2u*)(qp_ + 24); \
        fe.rc[0] = (v4u){q0_.x, q0_.y, q1_.x, q1_.y}; fe.rc[1] = (v4u){q2_.x, q2_.y, q3_.x, q3_.y}; } } while (0)
    FeLd fe;
    if (c < NPR) { const int item0 = c * IPW + ib, tq = (W4RAW << 6) | lane, b0 = hb * 4 + (item0 >> 11), h0 = (item0 >> 8) & 7, t00 = (item0 & 255) * CK;
        if (!ZMODE) { fe_load_rows(fe, PR, b0, h0, t00, tq); fe_load_prev(fe, PR, b0, h0, t00, tq); fe_load_lora(fe, (const bf16*)(ws + WS_A8), b0, t00, tq); }
        else { Z_LOAD(item0, lane); } }
    bf16x8 lf[8];
#define CK_LOAD_LF(HD, LN) do { const int which_ = (w4 < 2) ? w4 : 2, KL_ = (w4 < 2) ? 64 : 128; const bf16* lo_ = lot + (which_ == 0 ? 0 : which_ == 1 ? 32768 : 65536); \
        _Pragma("unroll") for (int i = 0; i < 8; ++i) { const int blk_ = (w4 < 2) ? (i >> 2) : (w4 - 2), s__ = (w4 < 2) ? (i & 3) : i; lf[i] = *(const bf16x8*)(lo_ + (size_t)((HD) * 64 + blk_ * 32 + ((LN) & 31)) * KL_ + ((LN) >> 5) * 8 + s__ * 16); } } while (0)
    if (!ZMODE && c < NPR) { const int item0 = c * IPW + ib; CK_LOAD_LF((item0 >> 8) & 7, lane); }
    for (int pr = c; pr < NPR; pr += G) {
        int lane_ = lane; asm volatile("" : "+v"(lane_));
        const int r32 = lane_ & 31, hh = lane_ >> 5, t256 = (W4RAW << 6) | lane_;
        const int item = pr * IPW + ib, bhl = item >> 8, ch = item & 255, b = hb * 4 + (bhl >> 3), h = bhl & 7;
        CK_SYNC();
        const int itn = (pr + G) * IPW + ib, bn = hb * 4 + (itn >> 11), hn = (itn >> 8) & 7, tn0 = (itn & 255) * CK;
        float f_r[8], f_kt[8], f_v[8], f_kh[8], f_b[8];
        if (!ZMODE) {
            const int tok = t256 >> 3, g8 = t256 & 7;
            const v4u q_rc = fe.rc[0], q_rp = fe.rp[0], q_kc = fe.rc[1], q_kp = fe.rp[1], q_vc = fe.rc[2], q_vp = fe.rp[2];
            for (int rpf_ = 0; rpf_ < 1 + ((CKREP >> 3) & 1); ++rpf_) {
#pragma unroll
            for (int i = 0; i < 4; ++i) { const int p = t256 + 256 * i, row = p >> 5, col = (p & 31) * 8;
                *(LAS v4u*)(L + CK_FA + ((col < 64) ? row * 144 + col * 2 : (col < 128) ? 4608 + row * 144 + (col - 64) * 2 : 9216 + row * 272 + (col - 128) * 2)) = fe.lc[i]; }
            CK_SYNC();
            {
                const int which = (w4 < 2) ? w4 : 2, KL = (w4 < 2) ? 64 : 128;
                const bf16* lo = lot + (which == 0 ? 0 : which == 1 ? 32768 : 65536);
                const LAS unsigned char* at = L + CK_FA + (which == 0 ? 0 : which == 1 ? 4608 : 9216) + r32 * (which == 2 ? 272 : 144) + hh * 16;
                LAS unsigned char* outp = L + CK_FL + which * 4608;
                if (w4 < 2) {
#pragma unroll
                    for (int blk = 0; blk < 2; ++blk) {
                        f32x16 acc;
#pragma unroll
                        for (int q = 0; q < 16; ++q) acc[q] = 0.f;
#pragma unroll
                        for (int s_ = 0; s_ < 4; ++s_) acc = __builtin_amdgcn_mfma_f32_32x32x16_bf16(lf[blk * 4 + s_], ld_frag(at + s_ * 32), acc, 0, 0, 0);
#pragma unroll
                        for (int q4 = 0; q4 < 4; ++q4) { v2u o; o.x = pk2(acc[4 * q4], acc[4 * q4 + 1]); o.y = pk2(acc[4 * q4 + 2], acc[4 * q4 + 3]);
                            *(LAS v2u*)(outp + r32 * 144 + (blk * 32 + 8 * q4 + 4 * hh) * 2) = o; }
                    }
                } else {
                    const int blk = w4 - 2;
                    f32x16 acc;
#pragma unroll
                    for (int q = 0; q < 16; ++q) acc[q] = 0.f;
#pragma unroll
                    for (int s_ = 0; s_ < 8; ++s_) acc = __builtin_amdgcn_mfma_f32_32x32x16_bf16(lf[s_], ld_frag(at + s_ * 32), acc, 0, 0, 0);
#pragma unroll
                    for (int q4 = 0; q4 < 4; ++q4) { v2u o; o.x = pk2(acc[4 * q4], acc[4 * q4 + 1]); o.y = pk2(acc[4 * q4 + 2], acc[4 * q4 + 3]);
                        *(LAS v2u*)(outp + r32 * 144 + (blk * 32 + 8 * q4 + 4 * hh) * 2) = o; }
                }
            }
            CK_SYNC();
            {
                const int ch0 = h * 64 + g8 * 8, t = ch * CK + tok;
                float lwv[8], lav[8], lgv[8];
                unpk8(*(const LAS v4u*)(L + CK_FL + tok * 144 + g8 * 16), lwv); unpk8(*(const LAS v4u*)(L + CK_FL + 4608 + tok * 144 + g8 * 16), lav); unpk8(*(const LAS v4u*)(L + CK_FL + 9216 + tok * 144 + g8 * 16), lgv);
                float rr_[8], rp_[8], kc_[8], kp_[8], vc_[8], vp_[8];
                unpk8(q_rc, rr_); unpk8(q_rp, rp_); unpk8(q_kc, kc_); unpk8(q_kp, kp_); unpk8(q_vc, vc_); unpk8(q_vp, vp_);
                float rr[8], ww[8], kt[8], vv[8], kk[8], aa[8];
                float skk = 0.f, bon = 0.f;
#pragma unroll
                for (int q = 0; q < 2; ++q) {
                    const LAS float* pt = PT + ch0 + 4 * q;
                    const f32x4 mr = *(const LAS f32x4*)pt, mk = *(const LAS f32x4*)(pt + 512), mv = *(const LAS f32x4*)(pt + 1024), w0v = *(const LAS f32x4*)(pt + 1536),
                        a0v = *(const LAS f32x4*)(pt + 2048), kkp = *(const LAS f32x4*)(pt + 2560), kap = *(const LAS f32x4*)(pt + 3072), rkp = *(const LAS f32x4*)(pt + 3584);
#pragma unroll
                    for (int jj = 0; jj < 4; ++jj) { const int j = 4 * q + jj;
                        const float r = rr_[j] + mr[jj] * (rp_[j] - rr_[j]), k = kc_[j] + mk[jj] * (kp_[j] - kc_[j]), v = vc_[j] + mv[jj] * (vp_[j] - vc_[j]);
                        const float w = (-0.6065306597126334f * 1.4426950408889634f) * sigm(w0v[jj] + lwv[j]);
                        const float a = sigm(a0v[jj] + lav[j]);
                        const float kkv = k * kkp[jj], ktv = k * (1.0f + (a - 1.0f) * kap[jj]);
                        skk += kkv * kkv; bon += r * ktv * rkp[jj];
                        rr[j] = r; ww[j] = w; kt[j] = ktv; vv[j] = v; kk[j] = kkv; aa[j] = a; }
                }
                skk = sum8(skk); bon = sum8(bon);
                const float inv = rsqrtf(fmaxf(skk, 1e-12f));
                LAS unsigned char* ro = L + CK_RAW + tok * 768 + g8 * 16;
                { LAS float* lw = (LAS float*)(L + CK_LC) + (tok + 1) * 64 + g8 * 8;
                  *(LAS f32x4*)lw = (f32x4){ww[0], ww[1], ww[2], ww[3]}; *(LAS f32x4*)(lw + 4) = (f32x4){ww[4], ww[5], ww[6], ww[7]}; }
#pragma unroll
                for (int j = 0; j < 8; ++j) { f_r[j] = rr[j]; f_kt[j] = kt[j]; f_v[j] = vv[j]; kk[j] *= inv; aa[j] *= kk[j]; vv[j] *= bon; f_kh[j] = kk[j]; f_b[j] = aa[j]; }
                const size_t eo = ((size_t)b * SEQ + t) * MW + ch0;
                *(v4u*)(E1 + eo) = pk8(vv); *(v4u*)(GTg + eo) = pk8(lgv);
            }
            }
        } else {
        }
        CK_SYNC();
        v2u e1v[4], gtv[4];
        if (ZMODE && w4 < 2) {
            const size_t tg_ = (size_t)b * SEQ + (size_t)ch * CK + r32;
#pragma unroll
            for (int q4 = 0; q4 < 4; ++q4) { const int vch = h * 64 + 32 * w4 + 8 * q4 + 4 * hh; e1v[q4] = *(const v2u*)(E1 + tg_ * MW + vch); gtv[q4] = *(const v2u*)(GTg + tg_ * MW + vch); }
        }
        if (!ZMODE) {
        for (int rp_ = 0; rp_ < 1 + (CKREP & 1); ++rp_) {
        if (w4 == 0) {
            LAS float* lc = (LAS float*)(L + CK_LC); float a = 0.f; lc[lane_] = 0.f;
#pragma unroll 8
            for (int t = 0; t < CK; ++t) { a += lc[(t + 1) * 64 + lane_]; lc[(t + 1) * 64 + lane_] = a; }
            *(LAS float*)(L + CK_GC + lane_ * 4) = exp2f(a);
        }
        CK_SYNC();
        {
            const int t = t256 >> 3, k0 = (t256 & 7) * 8;
            const LAS float* lc = (const LAS float*)(L + CK_LC);
            float at[8], bt[8], kt[8], rt[8], bh[8], kh[8], gcv[8];
            { const f32x4 g0_ = *(const LAS f32x4*)(L + CK_GC + k0 * 4), g1_ = *(const LAS f32x4*)(L + CK_GC + k0 * 4 + 16); gcv[0] = g0_[0]; gcv[1] = g0_[1]; gcv[2] = g0_[2]; gcv[3] = g0_[3]; gcv[4] = g1_[0]; gcv[5] = g1_[1]; gcv[6] = g1_[2]; gcv[7] = g1_[3]; }
#pragma unroll
            for (int j = 0; j < 8; ++j) {
                const float lp = lc[t * 64 + k0 + j], lt = lc[(t + 1) * 64 + k0 + j];
                const float ep = __builtin_amdgcn_exp2f(lp), en = __builtin_amdgcn_exp2f(-lt), et = __builtin_amdgcn_exp2f(lt), ec = gcv[j] * en;
                const float r_ = f_r[j], k_ = f_kt[j], h_ = f_kh[j], b_ = f_b[j];
                at[j] = -h_ * ep; bt[j] = b_ * en; kt[j] = k_ * en; rt[j] = r_ * et; bh[j] = b_ * ec; kh[j] = k_ * ec;
            }
            v4u o;
            o.x = pk2(rt[0], rt[1]); o.y = pk2(rt[2], rt[3]); o.z = pk2(rt[4], rt[5]); o.w = pk2(rt[6], rt[7]); *(LAS v4u*)(L + CK_RT + t * CK_RS + k0 * 2) = o;
#pragma unroll
            for (int j = 0; j < 8; ++j) *(LAS unsigned short*)(L + CK_VT + (k0 + j) * CK_TS + t * 2) = bf1(f_v[j]);
            if (!ZMODE) {
                o.x = pk2(at[0], at[1]); o.y = pk2(at[2], at[3]); o.z = pk2(at[4], at[5]); o.w = pk2(at[6], at[7]); *(LAS v4u*)(L + CK_AT + t * CK_RS + k0 * 2) = o;
                o.x = pk2(bt[0], bt[1]); o.y = pk2(bt[2], bt[3]); o.z = pk2(bt[4], bt[5]); o.w = pk2(bt[6], bt[7]); *(LAS v4u*)(L + CK_BT + t * CK_RS + k0 * 2) = o;
                o.x = pk2(kt[0], kt[1]); o.y = pk2(kt[2], kt[3]); o.z = pk2(kt[4], kt[5]); o.w = pk2(kt[6], kt[7]); *(LAS v4u*)(L + CK_KT + t * CK_RS + k0 * 2) = o;
#pragma unroll
                for (int j = 0; j < 8; ++j) { *(LAS unsigned short*)(L + CK_BHT + (k0 + j) * CK_TS + t * 2) = bf1(bh[j]); *(LAS unsigned short*)(L + CK_KHT + (k0 + j) * CK_TS + t * 2) = bf1(kh[j]); }
            }
        }
        CK_SYNC();
        }
        for (int rp_ = 0; rp_ < 1 + ((CKREP >> 1) & 1); ++rp_) {
        {
            const LAS unsigned char* xa = L + ((w4 < 2) ? CK_AT : CK_RT) + r32 * CK_RS + hh * 16;
            const LAS unsigned char* yb = L + ((w4 & 1) ? CK_KT : CK_BT) + r32 * CK_RS + hh * 16;
            f32x16 acc;
#pragma unroll
            for (int q = 0; q < 16; ++q) acc[q] = 0.f;
#pragma unroll
            for (int s = 0; s < 4; ++s) acc = __builtin_amdgcn_mfma_f32_32x32x16_bf16(ld_frag(xa + s * 32), ld_frag(yb + s * 32), acc, 0, 0, 0);
            const int i = r32, tb = 4 * hh - ((w4 < 2) ? 0 : -1);
            if (w4 == 0) { LAS float* db = (LAS float*)(L + CK_AAB + (2 * hh) * 256 + i * 8);
#pragma unroll
                for (int q = 0; q < 16; ++q) { const int tq_ = (q & 3) + 8 * (q >> 2); db[(tq_ >> 1) * 64 + (tq_ & 1)] = (i < tq_ + tb) ? acc[q] : 0.f; }
            } else { LAS unsigned short* db = (LAS unsigned short*)(L + (w4 == 1 ? CK_AAK : w4 == 2 ? CK_ARB : CK_ARK) + (4 * hh) * CK_TS + i * 2);
#pragma unroll
                for (int q = 0; q < 16; ++q) { const int tq_ = (q & 3) + 8 * (q >> 2); db[tq_ * (CK_TS / 2)] = bf1((i < tq_ + tb) ? acc[q] : 0.f); }
            }
        }
        CK_SYNC();
        if (w4 < 2) {
            f32x16 acc;
#pragma unroll
            for (int q = 0; q < 16; ++q) acc[q] = 0.f;
#pragma unroll
            for (int s = 0; s < 2; ++s) acc = __builtin_amdgcn_mfma_f32_32x32x16_bf16(ld_frag(L + CK_AAK + r32 * CK_TS + s * 32 + hh * 16), ld_frag(L + CK_VT + (32 * w4 + r32) * CK_TS + s * 32 + hh * 16), acc, 0, 0, 0);
#pragma unroll
            for (int q = 0; q < 16; ++q) { const int t = (q & 3) + 8 * (q >> 2) + 4 * hh; *(LAS float*)(L + CK_GT + (32 * w4 + r32) * CK_GS + t * 4) = acc[q]; }
        }
        CK_SYNC();
        }
        for (int rp_ = 0; rp_ < 1 + ((CKREP >> 2) & 1); ++rp_)
        if (w4 < 2 && (rp_ == 0 || w4 == 0)) {
            float x[CK];
            if (w4 == 0) {
#pragma unroll
                for (int t = 0; t < CK; ++t) x[t] = __uint_as_float(((unsigned)*(const LAS unsigned short*)(L + CK_AT + t * CK_RS + lane_ * 2)) << 16);
            } else {
#pragma unroll
                for (int t = 0; t < CK; ++t) x[t] = *(const LAS float*)(L + CK_GT + lane_ * CK_GS + t * 4);
            }
#pragma unroll
            for (int t = 0; t < CK; t += 4) {
                asm volatile("" ::: "memory");
                typedef float f32x2 __attribute__((ext_vector_type(2)));
                f32x2 a01 = {x[t], x[t + 1]}, a23 = {x[t + 2], x[t + 3]};
                const LAS unsigned char* pr0 = L + CK_AAB + (t >> 1) * 256;
#pragma unroll
                for (int i4 = 0; i4 < t / 4; ++i4) {
                    const f32x4 p0 = *(const LAS f32x4*)(pr0 + i4 * 32), p1 = *(const LAS f32x4*)(pr0 + i4 * 32 + 16);
                    const f32x4 q0 = *(const LAS f32x4*)(pr0 + 256 + i4 * 32), q1 = *(const LAS f32x4*)(pr0 + 256 + i4 * 32 + 16);
                    const float x0 = x[i4 * 4], x1 = x[i4 * 4 + 1], x2 = x[i4 * 4 + 2], x3 = x[i4 * 4 + 3];
                    a01 += (f32x2){p0[0], p0[1]} * (f32x2){x0, x0}; a23 += (f32x2){q0[0], q0[1]} * (f32x2){x0, x0};
                    a01 += (f32x2){p0[2], p0[3]} * (f32x2){x1, x1}; a23 += (f32x2){q0[2], q0[3]} * (f32x2){x1, x1};
                    a01 += (f32x2){p1[0], p1[1]} * (f32x2){x2, x2}; a23 += (f32x2){q1[0], q1[1]} * (f32x2){x2, x2};
                    a01 += (f32x2){p1[2], p1[3]} * (f32x2){x3, x3}; a23 += (f32x2){q1[2], q1[3]} * (f32x2){x3, x3}; }
                const f32x4 e0 = *(const LAS f32x4*)(pr0 + t * 8), f0 = *(const LAS f32x4*)(pr0 + 256 + t * 8), f1 = *(const LAS f32x4*)(pr0 + 256 + t * 8 + 16);
                float a0 = a01[0], a1 = a01[1], a2 = a23[0], a3 = a23[1];
                x[t] = a0;
                a1 += e0[1] * a0; x[t + 1] = a1;
                a2 += f0[0] * a0; a2 += f0[2] * a1; x[t + 2] = a2;
                a3 += f0[1] * a0; a3 += f0[3] * a1; a3 += f1[1] * a2; x[t + 3] = a3;
            }
            LAS unsigned char* tp = L + (w4 == 0 ? CK_WTT : CK_UTT) + lane_ * CK_TS;
#pragma unroll
            for (int q = 0; q < 4; ++q) { v4u o; o.x = pk2(x[8 * q], x[8 * q + 1]); o.y = pk2(x[8 * q + 2], x[8 * q + 3]); o.z = pk2(x[8 * q + 4], x[8 * q + 5]); o.w = pk2(x[8 * q + 6], x[8 * q + 7]); *(LAS v4u*)(tp + q * 16) = o; }
        }
        CK_SYNC();
        }
        if (!ZMODE) {
            if (pr + G < NPR) { fe_load_rows(fe, PR, bn, hn, tn0, t256); fe_load_prev(fe, PR, bn, hn, tn0, t256); fe_load_lora(fe, (const bf16*)(ws + WS_A8), bn, tn0, t256); CK_LOAD_LF(hn, lane_); }
            {   const int blk = w4 & 1;
                f32x16 pq;
#pragma unroll
                for (int q = 0; q < 16; ++q) pq[q] = 0.f;
                const LAS unsigned char* arb = L + CK_ARB + r32 * CK_TS + hh * 16;
                if (w4 < 2) {
#pragma unroll
                    for (int s = 0; s < 2; ++s) pq = __builtin_amdgcn_mfma_f32_32x32x16_bf16(ld_frag(L + CK_WTT + (32 * blk + r32) * CK_TS + s * 32 + hh * 16), ld_frag(arb + s * 32), pq, 0, 0, 0);
                    bf16* po = (bf16*)(ws + (hb ? WS_CAX : WS_CWX)) + (size_t)item * 2048 + r32 * 64 + 32 * blk + 4 * hh;
#pragma unroll
                    for (int q4 = 0; q4 < 4; ++q4) { const v2u rv = *(const LAS v2u*)(L + CK_RT + r32 * CK_RS + (32 * blk + 8 * q4 + 4 * hh) * 2);
                        v2u o; o.x = pk2(pq[4 * q4] + bflo(rv.x), pq[4 * q4 + 1] + bfhi(rv.x)); o.y = pk2(pq[4 * q4 + 2] + bflo(rv.y), pq[4 * q4 + 3] + bfhi(rv.y)); *(v2u*)(po + 8 * q4) = o; }
                } else {
                    const LAS unsigned char* ark = L + CK_ARK + r32 * CK_TS + hh * 16;
#pragma unroll
                    for (int s = 0; s < 2; ++s) { pq = __builtin_amdgcn_mfma_f32_32x32x16_bf16(ld_frag(L + CK_UTT + (32 * blk + r32) * CK_TS + s * 32 + hh * 16), ld_frag(arb + s * 32), pq, 0, 0, 0);
                        pq = __builtin_amdgcn_mfma_f32_32x32x16_bf16(ld_frag(L + CK_VT + (32 * blk + r32) * CK_TS + s * 32 + hh * 16), ld_frag(ark + s * 32), pq, 0, 0, 0); }
                    bf16* qo = (bf16*)(ws + (hb ? WS_CRX : WS_CUX)) + (size_t)item * 2048 + r32 * 64 + 32 * blk + 4 * hh;
#pragma unroll
                    for (int q4 = 0; q4 < 4; ++q4) { v2u o; o.x = pk2(pq[4 * q4], pq[4 * q4 + 1]); o.y = pk2(pq[4 * q4 + 2], pq[4 * q4 + 3]); *(v2u*)(qo + 8 * q4) = o; }
                }
            }
            for (int rp7_ = 0; rp7_ < 1 + ((CKREP >> 4) & 1); ++rp7_) {
            const int kb1 = w4 >> 1, kb2 = w4 & 1;
            const LAS unsigned char* bha = L + CK_BHT + (32 * kb1 + r32) * CK_TS + hh * 16;
            const LAS unsigned char* kha = L + CK_KHT + (32 * kb1 + r32) * CK_TS + hh * 16;
            f32x16 am, an;
#pragma unroll
            for (int q = 0; q < 16; ++q) { am[q] = 0.f; an[q] = 0.f; }
#pragma unroll
            for (int s = 0; s < 2; ++s) {
                const bf16x8 fb = ld_frag(bha + s * 32);
                am = __builtin_amdgcn_mfma_f32_32x32x16_bf16(ld_frag(L + CK_WTT + (32 * kb2 + r32) * CK_TS + s * 32 + hh * 16), fb, am, 0, 0, 0);
                an = __builtin_amdgcn_mfma_f32_32x32x16_bf16(fb, ld_frag(L + CK_UTT + (32 * kb2 + r32) * CK_TS + s * 32 + hh * 16), an, 0, 0, 0);
                an = __builtin_amdgcn_mfma_f32_32x32x16_bf16(ld_frag(kha + s * 32), ld_frag(L + CK_VT + (32 * kb2 + r32) * CK_TS + s * 32 + hh * 16), an, 0, 0, 0);
            }
            const float gc = *(const LAS float*)(L + CK_GC + (32 * kb2 + r32) * 4);
            bf16* mo = Mo + (size_t)item * 4096; bf16* no = No + (size_t)item * 4096;
#pragma unroll
            for (int q4 = 0; q4 < 4; ++q4) { float mv[4];
#pragma unroll
                for (int e = 0; e < 4; ++e) { const int kr = 8 * q4 + 4 * hh + e;
                    mv[e] = am[4 * q4 + e] + ((kb1 == kb2 && kr == r32) ? gc : 0.f); }
                v2u o; o.x = pk2(mv[0], mv[1]); o.y = pk2(mv[2], mv[3]);
                *(v2u*)(mo + (32 * kb1 + r32) * 64 + 32 * kb2 + 8 * q4 + 4 * hh) = o; }
#pragma unroll
            for (int q4 = 0; q4 < 4; ++q4) { v2u o; o.x = pk2(an[4 * q4], an[4 * q4 + 1]); o.y = pk2(an[4 * q4 + 2], an[4 * q4 + 3]);
                *(v2u*)(no + (32 * kb2 + r32) * 64 + 32 * kb1 + 8 * q4 + 4 * hh) = o; }
            }
        } else {
            float s1 = 0.f, s2 = 0.f; f32x16 yt;
            const int vt = w4;
            if (w4 < 2) {
#pragma unroll
                for (int q4 = 0; q4 < 4; ++q4) { const unsigned qx = (q4 & 1) ? fe.rc[q4 >> 1].z : fe.rc[q4 >> 1].x, qy = (q4 & 1) ? fe.rc[q4 >> 1].w : fe.rc[q4 >> 1].y;
                    yt[4 * q4] = bflo(qx); yt[4 * q4 + 1] = bfhi(qx); yt[4 * q4 + 2] = bflo(qy); yt[4 * q4 + 3] = bfhi(qy); }
#pragma unroll
                for (int s = 0; s < 4; ++s) yt = __builtin_amdgcn_mfma_f32_32x32x16_bf16(__builtin_bit_cast(bf16x8, fe.lp[s]), __builtin_bit_cast(bf16x8, fe.lc[s]), yt, 0, 0, 0);
                if (pr + G < NPR) Z_LOAD(itn, lane_);
#pragma unroll
                for (int q = 0; q < 16; ++q) { s1 += yt[q]; s2 += yt[q] * yt[q]; }
                s1 += xor_lane(s1, lane_, 32); s2 += xor_lane(s2, lane_, 32);
                if (hh == 0) { *(LAS float*)(L + CK_EX + (vt * 32 + r32) * 8) = s1; *(LAS float*)(L + CK_EX + (vt * 32 + r32) * 8 + 4) = s2; }
            }
            CK_SYNC();
            if (w4 < 2) {
                const float o1 = *(const LAS float*)(L + CK_EX + ((vt ^ 1) * 32 + r32) * 8), o2 = *(const LAS float*)(L + CK_EX + ((vt ^ 1) * 32 + r32) * 8 + 4);
                const float mean = (s1 + o1) * (1.0f / 64.0f), var = (s2 + o2) * (1.0f / 64.0f) - mean * mean, rstd = rsqrtf(fmaxf(var, 0.f) + 64e-5f);
                const size_t tg = (size_t)b * SEQ + (size_t)ch * CK + r32;
#pragma unroll
                for (int q4 = 0; q4 < 4; ++q4) { const int vch = h * 64 + 32 * vt + 8 * q4 + 4 * hh;
                    const v2u ev = e1v[q4], gv = gtv[q4]; const f32x4 gm = *(const LAS f32x4*)(PT + 1536 + vch);
                    const float y0 = ((yt[4 * q4] - mean) * rstd * gm[0] + bflo(ev.x)) * bflo(gv.x), y1 = ((yt[4 * q4 + 1] - mean) * rstd * gm[1] + bfhi(ev.x)) * bfhi(gv.x);
                    const float y2 = ((yt[4 * q4 + 2] - mean) * rstd * gm[2] + bflo(ev.y)) * bflo(gv.y), y3 = ((yt[4 * q4 + 3] - mean) * rstd * gm[3] + bfhi(ev.y)) * bfhi(gv.y);
                    v2u o; o.x = pk2(y0, y1); o.y = pk2(y2, y3); *(v2u*)(YO + tg * MW + vch) = o; }
            }
        }
    }
    CK_SYNC();
}

constexpr int YS_MROW = 136, YS_CHUNK = 64 * YS_MROW + 16 * YS_MROW  , YS_ROUND = 4 * YS_CHUNK  ;
__device__ __forceinline__ void ys_issue(const unsigned char* rbase, const unsigned (&goff)[6], int ll, v4u (&rg)[6]) {
#pragma unroll
    for (int j = 0; j < 6; ++j) if (j < 5 || ll + 448 * 5 < 2560) rg[j] = *(const v4u*)(rbase + goff[j]);
}
__device__ __forceinline__ void ys_write(LAS unsigned char* buf, const unsigned (&loff)[6], int ll, const v4u (&rg)[6]) {
#pragma unroll
    for (int j = 0; j < 6; ++j) if (j < 5 || ll + 448 * 5 < 2560) *(LAS v4u*)(buf + loff[j]) = rg[j];
}
__device__ __forceinline__ void rwkv_state(const Params& P, LAS unsigned char* lds, int tid, int lane, int wave, int c, int G) {
    unsigned char* ws = WS_OPAQUE(P.ws);
    const bf16* Mo = (const bf16*)(ws + WS_CM); const bf16* No = (const bf16*)(ws + WS_CN); bf16* SS = (bf16*)(ws + WS_CS);
    constexpr int NR = CK_NCH / 4;
    for (int wi = c; wi < 128; wi += G) {
        const int vs = (wi >> 3) & 3, bhl = (wi & 7) + 8 * (wi >> 5);
        const size_t ibase = (size_t)bhl * 256 * 4096;
        __syncthreads();
        if (wave != 0) {
            const int ll = tid - 64;
            unsigned goff[6], loff[6];
#pragma unroll
            for (int j = 0; j < 6; ++j) { const int Pp = ll + 448 * j, cr = Pp / 640, p = Pp - cr * 640, q = p - 512;
                goff[j] = (unsigned)(cr * 8192) + ((p < 512) ? (unsigned)(p * 16) : (unsigned)(WS_CN - WS_CM) + (unsigned)(((16 * vs + (q >> 3)) * 64 + (q & 7) * 8) * 2));
                loff[j] = (unsigned)(cr * YS_CHUNK) + ((p < 512) ? (unsigned)((p >> 3) * YS_MROW + (p & 7) * 16) : (unsigned)(64 * YS_MROW + (q >> 3) * YS_MROW + (q & 7) * 16)); }
            const unsigned char* mb = (const unsigned char*)(Mo + ibase);
            v4u r0[6], r1[6], r2[6], r3[6];
            ys_issue(mb, goff, ll, r0); ys_issue(mb + 32768, goff, ll, r1); ys_issue(mb + 2 * 32768, goff, ll, r2); ys_issue(mb + 3 * 32768, goff, ll, r3);
            ys_write(lds, loff, ll, r0); ys_issue(mb + 4 * 32768, goff, ll, r0);
            asm volatile("s_waitcnt lgkmcnt(0)" ::: "memory"); __builtin_amdgcn_s_barrier(); asm volatile("" ::: "memory");
            for (int r = 0; r < NR; r += 4) {
#define YS_STEP(RR, REG) do { const int rr_ = r + (RR); if (rr_ + 1 < NR) { ys_write(lds + ((rr_ + 1) % 3) * YS_ROUND, loff, ll, REG); if (rr_ + 5 < NR) ys_issue(mb + (size_t)(rr_ + 5) * 32768, goff, ll, REG); } \
                    asm volatile("s_waitcnt lgkmcnt(0)" ::: "memory"); __builtin_amdgcn_s_barrier(); asm volatile("" ::: "memory"); } while (0)
                YS_STEP(0, r1); YS_STEP(1, r2); YS_STEP(2, r3); YS_STEP(3, r0);
#undef YS_STEP
            }
        } else {
            const int fr = lane & 15, g = lane >> 4;
            f32x4 st[4];
#pragma unroll
            for (int kt = 0; kt < 4; ++kt) st[kt] = (f32x4){0.f, 0.f, 0.f, 0.f};
            bf16x8 sel[2];
#pragma unroll
            for (int p = 0; p < 2; ++p) { const bool on = (g == 2 * p + (fr >> 3)); const int e = fr & 7; v4u w = {0u, 0u, 0u, 0u};
                const unsigned one = (e & 1) ? 0x3f800000u : 0x00003f80u;
                if (on) { if ((e >> 1) == 0) w.x = one; else if ((e >> 1) == 1) w.y = one; else if ((e >> 1) == 2) w.z = one; else w.w = one; }
                sel[p] = __builtin_bit_cast(bf16x8, w); }
            asm volatile("" ::: "memory"); __builtin_amdgcn_s_barrier(); asm volatile("" ::: "memory");
            for (int r = 0; r < NR; ++r) {
                const LAS unsigned char* rb = lds + (r % 3) * YS_ROUND;
                bf16x8 mf[4][4][2], nb[4][2];
#pragma unroll
                for (int cr = 0; cr < 4; ++cr) { const LAS unsigned char* cb = rb + cr * YS_CHUNK;
#pragma unroll
                    for (int m = 0; m < 2; ++m) { const LAS unsigned char* np = cb + 64 * YS_MROW + fr * YS_MROW + (32 * m + 8 * g) * 2; nb[cr][m] = ld_frag2(np, np + 8); }
#pragma unroll
                    for (int kt = 0; kt < 4; ++kt) {
#pragma unroll
                        for (int s = 0; s < 2; ++s) { const LAS unsigned char* mp = cb + (16 * kt + fr) * YS_MROW + (32 * s + 4 * g) * 2; mf[cr][kt][s] = ld_frag2(mp, mp + 32); } } }
                asm volatile("" ::: "memory");
#pragma unroll
                for (int cr = 0; cr < 4; ++cr) {
                    const int ch = r * 4 + cr;
                    bf16* so = SS + ibase + (size_t)ch * 4096 + (16 * vs + fr) * 64 + 4 * g;
                    bf16x8 bfr[2];
#pragma unroll
                    for (int s = 0; s < 2; ++s) { v4u w; w.x = pk2(st[2 * s][0], st[2 * s][1]); w.y = pk2(st[2 * s][2], st[2 * s][3]); w.z = pk2(st[2 * s + 1][0], st[2 * s + 1][1]); w.w = pk2(st[2 * s + 1][2], st[2 * s + 1][3]); bfr[s] = __builtin_bit_cast(bf16x8, w); }
                    { const v4u w0 = __builtin_bit_cast(v4u, bfr[0]), w1 = __builtin_bit_cast(v4u, bfr[1]);
                      *(v2u*)(so) = (v2u){w0.x, w0.y}; *(v2u*)(so + 16) = (v2u){w0.z, w0.w}; *(v2u*)(so + 32) = (v2u){w1.x, w1.y}; *(v2u*)(so + 48) = (v2u){w1.z, w1.w}; }
#pragma unroll
                    for (int kt = 0; kt < 4; ++kt) {
                        f32x4 a = __builtin_amdgcn_mfma_f32_16x16x32_bf16(sel[kt & 1], nb[cr][kt >> 1], (f32x4){0.f, 0.f, 0.f, 0.f}, 0, 0, 0);
#pragma unroll
                        for (int s = 0; s < 2; ++s) a = __builtin_amdgcn_mfma_f32_16x16x32_bf16(mf[cr][kt][s], bfr[s], a, 0, 0, 0);
                        st[kt] = a;
                    }
                }
                asm volatile("s_waitcnt lgkmcnt(0)" ::: "memory"); __builtin_amdgcn_s_barrier(); asm volatile("" ::: "memory");
            }
        }
    }
    __syncthreads();
}

#ifndef MK_MULTI
#define MK_MULTI 0
#endif
#ifndef ONLYMASK
#define ONLYMASK 0x7ffff
#endif
#define EN(k) (((ONLYMASK) >> (k)) & 1)
#ifndef BARREP
#define BARREP 0
#endif
#ifndef REPMASK
#define REPMASK 0
#endif
#ifndef REPSUB
#define REPSUB 1
#endif
#define NREP(k) (1 + (((REPMASK) >> (k)) & 1))
#ifndef DUPSUB
#define DUPSUB -1
#endif
constexpr int NSUB = (DUPSUB >= 0) ? 4 : 3;
constexpr bool ZMERGE = (DUPSUB < 0);
constexpr int N_PHASES = 1 + NL * (3 + 2 * NSUB - (ZMERGE ? 3 : 0) + 2 * 6 + 4) + 1;

__global__ void __launch_bounds__(NTHR, 2) __attribute__((amdgpu_waves_per_eu(2, 2))) fwd_kernel(Params P) {
    extern __shared__ __attribute__((aligned(16))) unsigned char lds_raw[];
    LAS unsigned char* lds = (LAS unsigned char*)lds_raw;
    const int G0 = gridDim.x, c0 = blockIdx.x;
    unsigned char* ws0 = P.ws;
    const int wave0 = __builtin_amdgcn_readfirstlane(threadIdx.x >> 6);
    if (threadIdx.x < 64) ((LAS unsigned*)(lds + LDS_MISC))[threadIdx.x] = 0u;
    __syncthreads();
    XcdBarrier bar = xcd_barrier_post((unsigned*)(ws0 + WS_CTL) + CW_BAR, (volatile LAS unsigned*)(lds + LDS_MISC), (int)threadIdx.x);
    int ph = 0; const int lo = P.lo, hi = P.hi; bool run;
#define PH_BEGIN (run = (ph >= lo && ph < hi), ++ph, run)
#define PH_LOCALS int lane; asm volatile("v_mbcnt_lo_u32_b32 %0, -1, 0\n\tv_mbcnt_hi_u32_b32 %0, -1, %0" : "=v"(lane));     int wave = wave0; asm volatile("" : "+s"(wave)); const int tid = wave * 64 + lane; \
    int G = G0, c = c0; asm volatile("" : "+s"(G), "+s"(c)); const int gw = c * NWAVES + wave, NGW = G * NWAVES; unsigned char* ws = WS_OPAQUE(ws0); (void)lane; (void)gw; (void)NGW; (void)ws;
#define PH_END do { if (run && ph < hi) { int bl_; asm volatile("v_mbcnt_lo_u32_b32 %0, -1, 0\n\tv_mbcnt_hi_u32_b32 %0, -1, %0" : "=v"(bl_)); xcd_barrier(bar, wave0 * 64 + bl_); if (BARREP) xcd_barrier(bar, wave0 * 64 + bl_); } } while (0)

    if (PH_BEGIN) if constexpr (EN(0)) { PH_LOCALS for (int rep_ = 0; rep_ < ((true) ? NREP(0) : 1); ++rep_) { p0_mixer_weights(P, (LAS float*)(lds + wave * 8448), lane, gw, NGW); p0_router_weights(P, tid, c, G); p0_mod(P, lds, tid, c, G); } } PH_END;

    for (int l = 0; l < NL; ++l) {
        if (PH_BEGIN) if constexpr (EN(1)) { PH_LOCALS for (int rep_ = 0; rep_ < ((l == 0) ? NREP(1) : 1); ++rep_) { row_phase<0>(P, l, lds, tid, lane, wave, c, G); p_quant_wt1(P, l, lds, tid, lane, wave, c, G); } } PH_END;
        if (PH_BEGIN) if constexpr (EN(2)) { PH_LOCALS for (int rep_ = 0; rep_ < ((true) ? NREP(2) : 1); ++rep_) {
            pg8::Gemm g{(const bf16*)(ws + WS_H), (const bf16*)(ws + WS_W81 + (size_t)l * N1 * D), T, N_RWKV, D / 2}; pg8::StaticOrder S; S.init(T, N_RWKV, G, c);
            pg8::EpiPlainI8 E{(bf16*)(ws + WS_PRW), N_RWKV, (const float*)(ws + WS_TAB + TAB_SA), (const float*)(ws + WS_SW1) + l * N1};
            pg8::gemm_phase<pg8::EpiPlainI8, pg8::StaticOrder, false, true>(lds, g, S, E, nullptr, tid);
        } } PH_END;
        if (PH_BEGIN) if constexpr (EN(3)) { PH_LOCALS rwkv_lora_in(P, l, tid, c, G); } PH_END;
        for (int hb = 0; hb < 2; ++hb)
            for (int s2 = 0; s2 < NSUB; ++s2) { const int sub = (DUPSUB >= 0 && s2 > DUPSUB) ? s2 - 1 : s2;
                if (ZMERGE && sub == 2) continue;
                if (PH_BEGIN) if constexpr (EN(4)) { PH_LOCALS for (int rep_ = 0; rep_ < ((sub == REPSUB) ? NREP(4) : 1); ++rep_) {
                    if (sub == 1) {
                        const bool helper = (G > 128 && c >= 128);
                        if (!helper) rwkv_state(P, lds, tid, lane, wave, c, G);
                        if ((helper || G <= 128) && !(DUPSUB >= 0 && s2 == DUPSUB + 1)) p_expert_weights(P, l, hb, lds, tid, lane, wave, helper ? c - 128 : c, helper ? G - 128 : G); }
                    else if (sub == 2) rwkv_chunk<true>(P, l, hb, lds, tid, lane, wave, c, G);
                    else { if (ZMERGE && hb == 1) rwkv_chunk<true>(P, l, 0, lds, tid, lane, wave, c, G); rwkv_chunk<false>(P, l, hb, lds, tid, lane, wave, c, G); } } } PH_END;
            }

        for (int half = 0; half < 2; ++half) {
#define B2_BODY(HALF) do { \
                pg8::Gemm g{(const bf16*)(ws + WS_H + (size_t)(HALF) * HT * D), (const bf16*)(ws + WS_W81 + ((size_t)l * N1 + N_RWKV) * D), HT, N_REST + N_GATE, D / 2}; \
                pg8::StaticOrder S; S.init(HT, N_REST + N_GATE, G, c); \
                pg8::EpiB2I8 E{(bf16*)(ws + WS_PREST), N_REST, N_REST / 256, (bf16*)(ws + WS_GATES), N_GATE, (const float*)P.in[10] + (size_t)l * N_GATE, \
                               (const float*)(ws + WS_TAB + TAB_SA) + (size_t)(HALF) * HT, (const float*)(ws + WS_SW1) + l * N1 + N_RWKV}; \
                for (int rep_ = 0; rep_ < NREP(5); ++rep_) pg8::gemm_phase<pg8::EpiB2I8, pg8::StaticOrder, false, true>(lds, g, S, E, nullptr, tid); } while (0)
            if (!(ZMERGE && half == 1)) { if (PH_BEGIN) if constexpr (EN(5)) { PH_LOCALS
                if (ZMERGE && half == 0) rwkv_chunk<true>(P, l, 1, lds, tid, lane, wave, c, G);
                B2_BODY(half);
            } PH_END; }
            if (PH_BEGIN) if constexpr (EN(6)) { PH_LOCALS for (int rep_ = 0; rep_ < ((true) ? NREP(6) : 1); ++rep_) { ret_kv(P, half, lds, tid, lane, wave, c, G); conv_phase(P, l, tid, c, G); } } PH_END;
            if (PH_BEGIN) if constexpr (EN(7)) { PH_LOCALS for (int rep_ = 0; rep_ < ((true) ? NREP(7) : 1); ++rep_) { ret_state(P, tid, c, G); } } PH_END;
            if (PH_BEGIN) if constexpr (EN(8)) { PH_LOCALS for (int rep_ = 0; rep_ < ((true) ? NREP(8) : 1); ++rep_) { ret_out(P, l, half, lds, tid, lane, wave, c, G); } } PH_END;
            if (PH_BEGIN) if constexpr (EN(9)) { PH_LOCALS for (int rep_ = 0; rep_ < ((true) ? NREP(9) : 1); ++rep_) {
                pg8::Gemm g{(const bf16*)(ws + WS_YRET), (const bf16*)(ws + WS_WBR) + (size_t)(l * 3) * D * MW, HT, D, MW};
                pg8::MergeOrder S; S.T.init(HT, D, G, c); S.Y0 = (const bf16*)(ws + WS_YRET); S.Y1 = (const bf16*)(ws + WS_YRWKV) + (size_t)half * HT * MW; S.Y2 = (const bf16*)(ws + WS_YCONV);
                S.W = (const bf16*)(ws + WS_WBR) + (size_t)(l * 3) * D * MW;
                pg8::EpiMerge E{(bf16*)(ws + WS_MERGED), (const bf16*)(ws + WS_GATES), N_GATE, (unsigned)((size_t)HT * D * 2)};
                pg8::gemm_phase<pg8::EpiMerge, pg8::MergeOrder>(lds, g, S, E, nullptr, tid);
            } } PH_END;
            if (PH_BEGIN) if constexpr (EN(10)) { PH_LOCALS for (int rep_ = 0; rep_ < ((l == 0) ? NREP(10) : 1); ++rep_) {
                pg8::Gemm g{(const bf16*)(ws + WS_MERGED), (const bf16*)(ws + WS_WO) + (size_t)l * D * D, HT, D, D}; pg8::StaticOrder S; S.init(HT, D, G, c);
                const void* xin = (l == 0) ? (const void*)((const float*)P.in[0] + (size_t)half * HT * D) : (const void*)((const bf16*)P.out + (size_t)half * HT * D);
                bf16* xout = ((l == NL - 1) ? (bf16*)(ws + WS_X2) : (bf16*)P.out) + (size_t)half * HT * D;
                pg8::EpiWo E{xin, xout, (const float*)(ws + WS_MOD) + (size_t)l * NB * 6144 + 2048, 6144, half * HT, SEQ, l == 0};
                pg8::gemm_phase<pg8::EpiWo, pg8::StaticOrder>(lds, g, S, E, nullptr, tid);
            } if (ZMERGE && half == 0) { B2_BODY(1); } } PH_END;
        }
        if (PH_BEGIN) if constexpr (EN(11)) { PH_LOCALS for (int rep_ = 0; rep_ < ((true) ? NREP(11) : 1); ++rep_) { row_phase<1>(P, l, lds, tid, lane, wave, c, G); router_phase(P, l, lds, tid, c, G); } } PH_END;
        if (PH_BEGIN) if constexpr (EN(12)) { PH_LOCALS for (int rep_ = 0; rep_ < ((true) ? NREP(12) : 1); ++rep_) { moe_slots(P, lds, tid, c, G); } } PH_END;
        if (PH_BEGIN) if constexpr (EN(14)) { PH_LOCALS for (int rep_ = 0; rep_ < ((true) ? NREP(14) : 1); ++rep_) {
            pg8::Gemm g{(const bf16*)(ws + WS_XROWS), (const bf16*)((const unsigned char*)P.out + OUT_WGU), 0, 0, D / 2};
            pg8::moe_build_units((LAS int*)(lds + 131072 + 8192), (const int*)(ws + WS_TAB + TAB_TILEE), G, c, tid); __syncthreads();
            pg8::MoeOrder S{(const LAS int*)(lds + 131072 + 8192)};
            pg8::EpiGLUI8 E{(bf16*)(ws + WS_GB), (const float*)(ws + WS_TAB + TAB_XS), (const float*)(ws + WS_SWE)};
#ifdef STAGM
            if ((STAGSELM) & 1) { for (int i_ = 0; i_ < STAGM; ++i_) __builtin_amdgcn_s_sleep(127); }
#endif
            pg8::gemm_phase<pg8::EpiGLUI8, pg8::MoeOrder, false, true>(lds, g, S, E, nullptr, tid);
        } } PH_END;
        if (PH_BEGIN) if constexpr (EN(15)) { PH_LOCALS for (int rep_ = 0; rep_ < ((true) ? NREP(15) : 1); ++rep_) {
            pg8::Gemm g{(const bf16*)(ws + WS_GB), (const bf16*)((const unsigned char*)P.out + OUT_WD), 0, 0, MW};
            pg8::moe_build_units((LAS int*)(lds + 131072 + 8192), (const int*)(ws + WS_TAB + TAB_TILEE), G, c, tid); __syncthreads();
            pg8::MoeOrder S{(const LAS int*)(lds + 131072 + 8192)};
            pg8::EpiPlain E{(bf16*)(ws + WS_YM), D, 4};
#ifdef STAGM
            if ((STAGSELM) & 1) { for (int i_ = 0; i_ < STAGM; ++i_) __builtin_amdgcn_s_sleep(127); }
#endif
            pg8::gemm_phase<pg8::EpiPlain, pg8::MoeOrder>(lds, g, S, E, nullptr, tid);
        } } PH_END;
    }
    if (PH_BEGIN) if constexpr (EN(16)) { PH_LOCALS row_phase<2>(P, 0, lds, tid, lane, wave, c, G); }
}

#ifdef DBG_SRC
#ifndef DBG_N
#define DBG_N (T * D)
#endif
__global__ void dbg_dump(const unsigned short* src, float* out) {
    for (size_t i = (size_t)blockIdx.x * blockDim.x + threadIdx.x; i < (size_t)T * D; i += (size_t)gridDim.x * blockDim.x) { float v = 0.f; if (i < (size_t)(DBG_N)) { v = __uint_as_float(((unsigned)src[i]) << 16); v = (v - v == 0.f) ? v : 10000.0f; } out[i] = v; }
}
#endif
extern "C" void kernel_launch(void* const* d_in, const int* in_sizes, int n_in, void* d_out, int out_size, void* d_ws, size_t ws_size, hipStream_t stream) {
    static int grid = 0;
    if (grid == 0) {
        if (n_in != 32 || out_size != T * D || ws_size < WS_END) { fprintf(stderr, "kernel_launch: unexpected problem (n_in %d out %d ws %zu)\n", n_in, out_size, ws_size); grid = -1; return; }
        int dev = 0, cus = 0, per_cu = 0;
        if (hipGetDevice(&dev) != hipSuccess || hipDeviceGetAttribute(&cus, hipDeviceAttributeMultiprocessorCount, dev) != hipSuccess) { grid = -1; return; }
        if (hipFuncSetAttribute((const void*)fwd_kernel, hipFuncAttributeMaxDynamicSharedMemorySize, LDS_BYTES) != hipSuccess) { fprintf(stderr, "kernel_launch: hipFuncSetAttribute failed\n"); grid = -1; return; }
        if (hipOccupancyMaxActiveBlocksPerMultiprocessor(&per_cu, (const void*)fwd_kernel, NTHR, LDS_BYTES) != hipSuccess || per_cu < 1) { fprintf(stderr, "kernel_launch: occupancy query says %d\n", per_cu); }
        grid = cus > 0 ? cus : 256;
    }
    if (grid < 0) return;
    if (hipMemsetAsync((char*)d_ws + WS_CTL, 0, CTL_ZERO_BYTES, stream) != hipSuccess) return;
    Params p{};
    for (int i = 0; i < 32; ++i) p.in[i] = d_in[i];
    p.out = (float*)d_out; p.ws = (unsigned char*)d_ws;
#if MK_MULTI
    for (int ph = 0; ph < N_PHASES; ++ph) { p.lo = ph; p.hi = ph + 1; hipLaunchKernelGGL(fwd_kernel, dim3(grid), dim3(NTHR), LDS_BYTES, stream, p); }
#else
    p.lo = 0; p.hi = N_PHASES;
#ifdef DBG_STOP
    p.hi = DBG_STOP;
#endif
#ifdef DBG_SPLIT
    p.hi = DBG_SPLIT;
    hipLaunchKernelGGL(fwd_kernel, dim3(grid), dim3(NTHR), LDS_BYTES, stream, p);
    hipMemsetAsync((char*)d_ws + WS_CTL, 0, 65536, stream);
    p.lo = DBG_SPLIT; p.hi = DBG_STOP;
#endif
    hipLaunchKernelGGL(fwd_kernel, dim3(grid), dim3(NTHR), LDS_BYTES, stream, p);
#ifdef DBG_SRC
    hipLaunchKernelGGL(dbg_dump, dim3(2048), dim3(256), 0, stream, (const unsigned short*)((const char*)d_ws + (size_t)(DBG_SRC) * MiB), (float*)d_out);
#endif
#endif
}
```
